# Optimizing an MI355X kernel written in HIP

```python
import jax, jax.numpy as jnp
from jax import lax
import numpy as np

D_MODEL = 1024
BATCH = 4
SEQ = 8192
DEPTH = 2

N_EVEN = (DEPTH + 1) // 2
N_ODD = DEPTH // 2
RMS_EPS = 1e-6
D_CONV = D_MODEL // 2
CONV_WIDTH = 3
D_POOL = D_MODEL // 2
POOL_WINDOWS = (2, 4, 8, 16)
POOL_GROUPS = len(POOL_WINDOWS)
POOL_GC = D_POOL // POOL_GROUPS
MAX_WIN = max(POOL_WINDOWS)
MIX_IN = 3 * D_CONV + D_POOL
MIX_OUT = D_CONV + D_POOL
HEAD_SIZE = 64
RWKV_HEADS = D_MODEL // HEAD_SIZE
DECAY_LORA = 64
AAA_LORA = 64
GATE_LORA = 160
LNX_EPS = 1e-5 * HEAD_SIZE
D_FF = 2816
N_EXPERTS = 8
TOP_K = 2

kernel_name = 'hybrid_conv_pool_rwkv7_moe'


def rmsnorm(x, g):
    xf = x.astype(jnp.float32)
    y = xf * lax.rsqrt(jnp.mean(xf * xf, axis=-1, keepdims=True) + RMS_EPS)
    return (y * g.astype(jnp.float32)).astype(x.dtype)


def short_conv(u, w):
    S = u.shape[1]
    up = jnp.pad(u, ((0, 0), (CONV_WIDTH - 1, 0), (0, 0)))
    return up[:, 0:S] * w[0] + up[:, 1:S + 1] * w[1] + up[:, 2:S + 2] * w[2]


def multiscale_pool(u, w_pool, scale):
    S = u.shape[1]
    uf = u.astype(jnp.float32)
    cs = jnp.pad(jnp.cumsum(uf, axis=1), ((0, 0), (MAX_WIN, 0), (0, 0)))
    pos = jnp.arange(S)
    outs = []
    for gi, win in enumerate(POOL_WINDOWS):
        sl = slice(gi * POOL_GC, (gi + 1) * POOL_GC)
        total = cs[:, MAX_WIN:MAX_WIN + S, sl] - cs[:, MAX_WIN - win:MAX_WIN - win + S, sl]
        cnt = jnp.minimum(pos + 1, win).astype(jnp.float32)[None, :, None]
        outs.append(total / cnt - uf[:, :, sl])
    p = jnp.stack(outs, axis=2)
    y = jnp.einsum('bsgc,gcd->bsgd', p, w_pool.astype(jnp.float32)).reshape(uf.shape)
    return (y * scale.astype(jnp.float32)).astype(u.dtype)


def conv_pool_mix(h, w_in, conv_w, pool_w, pool_scale, w_out):
    z = h @ w_in
    b_gate, c_gate, v_conv, v_pool = jnp.split(z, [D_CONV, 2 * D_CONV, 3 * D_CONV], axis=-1)
    y_conv = b_gate * short_conv(c_gate * v_conv, conv_w)
    y_pool = multiscale_pool(v_pool, pool_w, pool_scale)
    return jnp.concatenate([y_conv, y_pool], axis=-1) @ w_out


def rwkv7_mix(h, mu, w_r, w_k, w_v, w_o, w0, w1, w2, a0, a1, a2, g1, g2, k_k, k_a, r_k, ln_g, ln_b):
    B, S, D = h.shape
    f32 = jnp.float32
    h_prev = jnp.pad(h, ((0, 0), (1, 0), (0, 0)))[:, :S]
    xx = h_prev - h
    xr, xw, xk, xv, xa, xg = [h + xx * mu[i] for i in range(6)]
    r = xr @ w_r
    k = xk @ w_k
    v = xv @ w_v
    w_log = -jax.nn.softplus(-(w0 + jnp.tanh(xw @ w1) @ w2).astype(f32)) - 0.5
    decay = jnp.exp(-jnp.exp(w_log))
    a = jax.nn.sigmoid((a0 + (xa @ a1) @ a2).astype(f32))
    g = jax.nn.sigmoid(xg @ g1) @ g2

    def heads(t):
        return t.astype(f32).reshape(B, S, RWKV_HEADS, HEAD_SIZE)

    kk = heads(k * k_k)
    kk = kk / jnp.maximum(jnp.sqrt(jnp.sum(kk * kk, axis=-1, keepdims=True)), 1e-12)
    k = k.astype(f32) * (1.0 + (a - 1.0) * k_a.astype(f32))
    rh, wh, kh, vh, ah = heads(r), heads(decay), heads(k), heads(v), heads(a)

    def to_seq(t):
        return jnp.moveaxis(t, 1, 0)

    def step(state, inp):
        r_t, w_t, k_t, v_t, kk_t, a_t = inp
        sa = jnp.einsum('bhij,bhj->bhi', state, -kk_t)
        state = (state * w_t[:, :, None, :] + sa[..., None] * (kk_t * a_t)[:, :, None, :]
                 + v_t[..., None] * k_t[:, :, None, :])
        y_t = jnp.einsum('bhij,bhj->bhi', state, r_t)
        return state, y_t

    state0 = jnp.zeros((B, RWKV_HEADS, HEAD_SIZE, HEAD_SIZE), f32)
    _, ys = lax.scan(step, state0, (to_seq(rh), to_seq(wh), to_seq(kh), to_seq(vh), to_seq(kk), to_seq(ah)))
    y = jnp.moveaxis(ys, 0, 1)
    mean = jnp.mean(y, axis=-1, keepdims=True)
    var = jnp.mean(jnp.square(y - mean), axis=-1, keepdims=True)
    yn = ((y - mean) * lax.rsqrt(var + LNX_EPS)).reshape(B, S, D) * ln_g.astype(f32) + ln_b.astype(f32)
    bonus = (jnp.sum(rh * kh * r_k.astype(f32), axis=-1, keepdims=True) * vh).reshape(B, S, D)
    out = ((yn + bonus) * g.astype(f32)).astype(h.dtype) @ w_o
    return out


def swiglu(t, wg, wu, wd):
    return (jax.nn.silu(t @ wg) * (t @ wu)) @ wd


def moe_swiglu(h, router, wg, wu, wd):
    B, S, D = h.shape
    t = h.reshape(B * S, D)
    logits = (t @ router).astype(jnp.float32)
    top_val, top_idx = lax.top_k(logits, TOP_K)
    top_w = jax.nn.softmax(top_val, axis=-1)
    combine = jnp.sum(top_w[..., None] * jax.nn.one_hot(top_idx, N_EXPERTS, dtype=jnp.float32), axis=1)
    out = jnp.zeros((B * S, D), jnp.float32)
    for e in range(N_EXPERTS):
        out = out + combine[:, e:e + 1] * swiglu(t, wg[e], wu[e], wd[e]).astype(jnp.float32)
    return out.reshape(B, S, D).astype(h.dtype)


def setup_inputs(seed: int = 0) -> dict:
    key = jax.random.key(seed)
    ks = iter(jax.random.split(key, 40))

    def nrm(shape, scale):
        return jax.random.normal(next(ks), shape, jnp.float32) * scale

    def gain(shape):
        return 1.0 + nrm(shape, 0.05)

    D, F, E = D_MODEL, D_FF, N_EXPERTS
    return {
        'x': nrm((BATCH, SEQ, D), 1.0),
        'c': nrm((BATCH, D), 1.0),
        'ada_w': nrm((DEPTH, D, 6 * D), 0.02),
        'ada_b': nrm((DEPTH, 6 * D), 0.02),
        'norm_g': gain((DEPTH, 4, D)),
        'mix_w_in': nrm((N_EVEN, D, MIX_IN), D ** -0.5),
        'conv_w': nrm((N_EVEN, CONV_WIDTH, D_CONV), CONV_WIDTH ** -0.5),
        'pool_w': nrm((N_EVEN, POOL_GROUPS, POOL_GC, POOL_GC), POOL_GC ** -0.5),
        'pool_scale': gain((N_EVEN, D_POOL)),
        'mix_w_out': nrm((N_EVEN, MIX_OUT, D), MIX_OUT ** -0.5),
        'ffn_w_gate': nrm((N_EVEN, D, F), D ** -0.5),
        'ffn_w_up': nrm((N_EVEN, D, F), D ** -0.5),
        'ffn_w_down': nrm((N_EVEN, F, D), F ** -0.5),
        'rwkv_mu': jax.random.uniform(next(ks), (N_ODD, 6, D), jnp.float32),
        'rwkv_w_r': nrm((N_ODD, D, D), D ** -0.5),
        'rwkv_w_k': nrm((N_ODD, D, D), D ** -0.5),
        'rwkv_w_v': nrm((N_ODD, D, D), D ** -0.5),
        'rwkv_w_o': nrm((N_ODD, D, D), D ** -0.5),
        'rwkv_w0': nrm((N_ODD, D), 0.5),
        'rwkv_w1': nrm((N_ODD, D, DECAY_LORA), D ** -0.5),
        'rwkv_w2': nrm((N_ODD, DECAY_LORA, D), DECAY_LORA ** -0.5),
        'rwkv_a0': nrm((N_ODD, D), 0.1),
        'rwkv_a1': nrm((N_ODD, D, AAA_LORA), D ** -0.5),
        'rwkv_a2': nrm((N_ODD, AAA_LORA, D), AAA_LORA ** -0.5),
        'rwkv_g1': nrm((N_ODD, D, GATE_LORA), D ** -0.5),
        'rwkv_g2': nrm((N_ODD, GATE_LORA, D), GATE_LORA ** -0.5),
        'rwkv_k_k': gain((N_ODD, D)),
        'rwkv_k_a': gain((N_ODD, D)),
        'rwkv_r_k': nrm((N_ODD, RWKV_HEADS, HEAD_SIZE), 0.1),
        'rwkv_ln_g': gain((N_ODD, D)),
        'rwkv_ln_b': nrm((N_ODD, D), 0.02),
        'moe_router': nrm((N_ODD, D, E), D ** -0.5),
        'moe_w_gate': nrm((N_ODD, E, D, F), D ** -0.5),
        'moe_w_up': nrm((N_ODD, E, D, F), D ** -0.5),
        'moe_w_down': nrm((N_ODD, E, F, D), F ** -0.5),
    }


def reference(x, c, ada_w, ada_b, norm_g, mix_w_in, conv_w, pool_w, pool_scale, mix_w_out,
              ffn_w_gate, ffn_w_up, ffn_w_down, rwkv_mu, rwkv_w_r, rwkv_w_k, rwkv_w_v, rwkv_w_o,
              rwkv_w0, rwkv_w1, rwkv_w2, rwkv_a0, rwkv_a1, rwkv_a2, rwkv_g1, rwkv_g2,
              rwkv_k_k, rwkv_k_a, rwkv_r_k, rwkv_ln_g, rwkv_ln_b,
              moe_router, moe_w_gate, moe_w_up, moe_w_down):
    cond = jax.nn.silu(c)
    for layer in range(DEPTH):
        mod = cond @ ada_w[layer] + ada_b[layer]
        sh_m, sc_m, gt_m, sh_f, sc_f, gt_f = [m[:, None, :] for m in jnp.split(mod, 6, axis=-1)]
        g_pre_m, g_post_m, g_pre_f, g_post_f = norm_g[layer]
        i = layer // 2
        h = rmsnorm(x, g_pre_m) * (1 + sc_m) + sh_m
        if layer % 2 == 0:
            y = conv_pool_mix(h, mix_w_in[i], conv_w[i], pool_w[i], pool_scale[i], mix_w_out[i])
        else:
            y = rwkv7_mix(h, rwkv_mu[i], rwkv_w_r[i], rwkv_w_k[i], rwkv_w_v[i], rwkv_w_o[i],
                          rwkv_w0[i], rwkv_w1[i], rwkv_w2[i], rwkv_a0[i], rwkv_a1[i], rwkv_a2[i],
                          rwkv_g1[i], rwkv_g2[i], rwkv_k_k[i], rwkv_k_a[i], rwkv_r_k[i],
                          rwkv_ln_g[i], rwkv_ln_b[i])
        x = x + gt_m * rmsnorm(y, g_post_m)
        h = rmsnorm(x, g_pre_f) * (1 + sc_f) + sh_f
        if layer % 2 == 0:
            y = swiglu(h, ffn_w_gate[i], ffn_w_up[i], ffn_w_down[i])
        else:
            y = moe_swiglu(h, moe_router[i], moe_w_gate[i], moe_w_up[i], moe_w_down[i])
        x = x + gt_f * rmsnorm(y, g_post_f)
    return x
```

```cpp
#include <hip/hip_runtime.h>
#include <cstdio>
#include <cstdint>

#ifndef N_LAUNCH_MODE
#define N_LAUNCH_MODE 0
#endif

#define LAS __attribute__((address_space(3)))
#define GAS __attribute__((address_space(1)))
typedef unsigned short bf16_t;
typedef short bf16x8 __attribute__((ext_vector_type(8)));
typedef float f32x4 __attribute__((ext_vector_type(4)));
typedef float f32x2 __attribute__((ext_vector_type(2)));
typedef unsigned u32x4 __attribute__((ext_vector_type(4)));
typedef unsigned u32x2 __attribute__((ext_vector_type(2)));

constexpr int D = 1024, BATCH = 4, SEQ = 8192, T = BATCH * SEQ, FF = 2816, FH = FF / 2, NE = 8, NH = 16, HS = 64;
constexpr int MIXIN = 2048, DCONV = 512, DPOOL = 512;
constexpr int ZLD = 1536;
constexpr float RMS_EPS = 1e-6f, LNX_EPS = 64e-5f;
constexpr int NWAVES = 8, NTHREADS = 512;
constexpr int MOE_MAXROWS = 2 * T + NE * 256;
constexpr int H2ROWS = BATCH * (SEQ + 1);

constexpr size_t MiB = 1u << 20;
constexpr size_t WS_CTL = 0, CTL_ZERO_BYTES = 256 * 1024;
constexpr size_t WS_MOD = 1 * MiB;
constexpr size_t WS_TOKE = 2 * MiB;
constexpr size_t WS_TOKW = WS_TOKE + (size_t)T * 8;
constexpr size_t WS_TOKLI = WS_TOKW + (size_t)T * 8;
constexpr size_t WS_TOKSLOT = WS_TOKLI + (size_t)T * 8;
constexpr size_t WS_CNT = WS_TOKSLOT + (size_t)T * 8;
constexpr size_t WS_ROWIDX = WS_CNT + 8192;
constexpr size_t WS_TILEE = WS_ROWIDX + (size_t)MOE_MAXROWS * 4;
static_assert(WS_TILEE + 4096 <= 4 * MiB, "route tables");
constexpr size_t WS_WIN = 4 * MiB, WS_WOUTE = 8 * MiB, WS_WFGU = 10 * MiB, WS_WFD = 21 * MiB, WS_WRKV = 26 * MiB + 512 * 1024, WS_WLOR = 32 * MiB + 512 * 1024, WS_WL2 = 504 * MiB, WS_WO = 493 * MiB;
constexpr size_t WS_WMGU = 4 * MiB, WS_WMD0 = 48 * MiB, WS_WMD1 = 70 * MiB;
constexpr size_t WS_H = 44 * MiB, WS_Z = 172 * MiB, WS_A2 = 300 * MiB, WS_HFF = 172 * MiB, WS_Y0 = 364 * MiB;
constexpr size_t WS_H2 = 44 * MiB, WS_XR = 109 * MiB, WS_XK = 173 * MiB, WS_XV = 237 * MiB, WS_R = 301 * MiB, WS_K = 365 * MiB, WS_V = 429 * MiB, WS_LACT = 4 * MiB, WS_WLOG = 109 * MiB, WS_AA = 173 * MiB, WS_GG = 237 * MiB, WS_Y1 = 173 * MiB;
constexpr size_t WS_XH = 495 * MiB;
constexpr int LACT_LD = 2048, LACT_W = 384;
constexpr size_t WS_BSC = 495 * MiB, WS_SEG = 497 * MiB;
constexpr size_t WS_H3 = 446 * MiB, WS_HM = 264 * MiB, WS_Y2 = 132 * MiB, WS_END = 510 * MiB;
static_assert(WS_H2 + (size_t)H2ROWS * D * 2 <= WS_XR, "h2");
static_assert(WS_HM + (size_t)MOE_MAXROWS * FH * 2 <= WS_H3, "hm");
static_assert(WS_Y2 + (size_t)MOE_MAXROWS * D * 2 <= WS_HM, "y2");
constexpr int CW_MOE_NM = 64;
constexpr int CW_BAR = 4096;

__device__ __forceinline__ unsigned f2bf(float f) { unsigned u = __builtin_bit_cast(unsigned, f); return (u + 0x7fffu + ((u >> 16) & 1u)) >> 16; }
typedef __bf16 bf16x2_hw __attribute__((ext_vector_type(2)));
typedef float f32x2_hw __attribute__((ext_vector_type(2)));
__device__ __forceinline__ unsigned pk2(float lo, float hi) { f32x2_hw v = {lo, hi}; return __builtin_bit_cast(unsigned, __builtin_convertvector(v, bf16x2_hw)); }
__device__ __forceinline__ float bflo(unsigned w) { return __builtin_bit_cast(float, w << 16); }
__device__ __forceinline__ float bfhi(unsigned w) { return __builtin_bit_cast(float, w & 0xffff0000u); }
__device__ __forceinline__ float bf1(bf16_t b) { return __builtin_bit_cast(float, (unsigned)b << 16); }
template <int CTRL> __device__ __forceinline__ float dppf(float v) { return __builtin_bit_cast(float, __builtin_amdgcn_update_dpp(0, __builtin_bit_cast(int, v), CTRL, 0xF, 0xF, true)); }
__device__ __forceinline__ float sum8_dpp(float v) { v += dppf<0xB1>(v); v += dppf<0x4E>(v); v += dppf<0x141>(v); return v; }
__device__ __forceinline__ float wave_sum(float v) { v = sum8_dpp(v); v += dppf<0x140>(v); v += __shfl_xor(v, 16); v += __shfl_xor(v, 32); return v; }
__device__ __forceinline__ float sigmoidf_(float x) { return __builtin_amdgcn_rcpf(1.0f + __expf(-x)); }
__device__ __forceinline__ float siluf_(float x) { return x * __builtin_amdgcn_rcpf(1.0f + __expf(-x)); }
__device__ __forceinline__ float tanhf_(float x) { const float e = __expf(-2.0f * fabsf(x)); const float t = (1.0f - e) * __builtin_amdgcn_rcpf(1.0f + e); return x < 0.f ? -t : t; }
__device__ __forceinline__ float softplusf_(float z) { return fmaxf(z, 0.f) + log1pf(__expf(-fabsf(z))); }

namespace pg8 {
constexpr int BM = 256, BK = 64, HALF = 128, HTB = HALF * BK * 2, STAGE_BYTES = 8 * HTB, NXCD = 8, WGM = 8;
__host__ __device__ __forceinline__ int lds_byte(int r, int c) { const int st = (r >> 4) * 2 + (c >> 5), rr = r & 15, cc = c & 31, ob = rr * 64 + cc * 2; return st * 1024 + (ob ^ (((ob >> 9) & 1) << 5)); }
__host__ __device__ __forceinline__ void stage_rc(int b, int& R, int& C) { const int st = b / 1024, sb = b % 1024, swz = sb ^ (((sb >> 9) & 1) << 5); R = (st >> 1) * 16 + swz / 64; C = (st & 1) * 32 + (swz % 64) / 2; }
__host__ __device__ __forceinline__ int perm32(int rho) { const int n = rho >> 4, i = rho & 15; return 8 * (i >> 2) + 4 * n + (i & 3); }

struct Unit { int pm, pn; };
enum { EM_BF16 = 0, EM_SWIGLU = 1, EM_RKVL = 2, EM_LORA2 = 3, EM_MOE2 = 4, EM_MIXIN = 5 };
struct GemmDesc {
    const bf16_t* A; const bf16_t* Bt;
    int lda, K, nM, nN;
    int a_bt, a_bx;
    int a_pn_split, a_pn_coloff;
    int a_pn_div; long a_pn_stride;
    int pn_bias;
    const int* rowidx;
    const int* tile_e; long b_estride;
    int mode;
    bf16_t* o0; bf16_t* o1; bf16_t* o2; int ldc;
    const float* p0;
    const float* p1;
    int flag;
};
__device__ __forceinline__ size_t a_off_bytes(const GemmDesc& g, const Unit& u) {
    size_t rows = (size_t)u.pm * BM; if (g.a_bt) rows += (size_t)(u.pm / g.a_bt) * g.a_bx;
    size_t o = rows * (size_t)g.lda; if (u.pn >= g.a_pn_split) o += g.a_pn_coloff; o += (size_t)(u.pn / g.a_pn_div) * (size_t)g.a_pn_stride; return o * 2;
}
__device__ __forceinline__ size_t b_off_bytes(const GemmDesc& g, const Unit& u) {
    size_t o = (size_t)u.pn * BM * (size_t)g.K; if (g.tile_e) o += (size_t)__builtin_amdgcn_readfirstlane(g.tile_e[u.pm]) * (size_t)g.b_estride; return o * 2;
}
struct StaticOrder {
    int nM, nN, nwg, G, c;
    __device__ void init(int nM_, int nN_, int G_, int c_) { nM = nM_; nN = nN_; nwg = nM * nN; G = G_; c = c_; }
    __device__ bool next(int i, Unit& u) const {
        const long L = (long)i * G + c; if (L >= nwg) return false;
        int wgid = (int)L; { const int q = nwg / NXCD, r = nwg % NXCD, xcd = wgid % NXCD, off = wgid / NXCD; wgid = (xcd < r ? xcd * (q + 1) : r * (q + 1) + (xcd - r) * q) + off; }
        const int nig = WGM * nN, gid = wgid / nig, fm = gid * WGM, gsz = (nM - fm) < WGM ? (nM - fm) : WGM;
        u.pm = fm + ((wgid % nig) % gsz); u.pn = (wgid % nig) / gsz; return true;
    }
};
typedef __bf16 bf16x2_t_ __attribute__((ext_vector_type(2)));
__device__ __forceinline__ unsigned cvt_pk_bf16(float lo, float hi) { f32x2 v = {lo, hi}; bf16x2_t_ b = __builtin_convertvector(v, bf16x2_t_); return __builtin_bit_cast(unsigned, b); }

__device__ __forceinline__ unsigned dpp_x8(unsigned x) { return (unsigned)__builtin_amdgcn_update_dpp(0, (int)x, 0x128, 0xF, 0xF, true); }
__device__ __forceinline__ float dpp_x8f(float x) { return __builtin_bit_cast(float, dpp_x8(__builtin_bit_cast(unsigned, x))); }
template <int ACT, int AI_LO, int AI_HI>
__device__ __forceinline__ void store_tiles(const f32x4 (&acc)[2][2][4][2], bf16_t* bq, int ldc, int colw, int fr, int fq, const float* bias, int climit = 1 << 30) {
    const bool lo = fr < 8;
    const int chA = lo ? fq : 4 + fq, chB = lo ? 4 + fq : fq;
    bf16_t* pA = bq + (size_t)(fr & 7) * ldc + chA * 8;
    bf16_t* pB = bq + (size_t)(8 + (fr & 7)) * ldc + chB * 8;
    const bool okA = (ACT != 1) || (colw + chA * 8 < climit), okB = (ACT != 1) || (colw + chB * 8 < climit);
    f32x4 bb[2][2];
    int cls[2];
#pragma unroll
    for (int bj = 0; bj < 2; ++bj) {
        const int col = colw + bj * 32 + 8 * fq;
        bb[bj][0] = (f32x4){0.f, 0.f, 0.f, 0.f}; bb[bj][1] = bb[bj][0];
        if (ACT >= 2) { bb[bj][0] = *(const f32x4*)(bias + col); bb[bj][1] = *(const f32x4*)(bias + col + 4); }
        cls[bj] = (ACT == 1) ? (col < 64 ? 0 : (col < 128 ? 1 : (col < 288 ? 2 : 3))) : 0;
    }
#pragma unroll
    for (int ai = AI_LO; ai < AI_HI; ++ai)
#pragma unroll
        for (int m = 0; m < 4; ++m) {
            u32x4 w[2];
#pragma unroll
            for (int bj = 0; bj < 2; ++bj) {
                float v[8];
#pragma unroll
                for (int j = 0; j < 4; ++j) { v[j] = acc[ai][bj][m][0][j]; v[4 + j] = acc[ai][bj][m][1][j]; }
#pragma unroll
                for (int j = 0; j < 8; ++j) {
                    const float b_ = (j < 4) ? bb[bj][0][j & 3] : bb[bj][1][j & 3];
                    if (ACT == 1) { const float x = v[j]; v[j] = (cls[bj] == 0) ? tanhf_(x) : (cls[bj] == 1 ? x : (cls[bj] == 2 ? sigmoidf_(x) : 0.f)); }
                    else if (ACT == 2) v[j] = -0.60653066f * sigmoidf_(b_ + v[j]);
                    else if (ACT == 3) v[j] = sigmoidf_(b_ + v[j]);
                }
                w[bj].x = cvt_pk_bf16(v[0], v[1]); w[bj].y = cvt_pk_bf16(v[2], v[3]); w[bj].z = cvt_pk_bf16(v[4], v[5]); w[bj].w = cvt_pk_bf16(v[6], v[7]);
            }
            u32x4 p1; p1.x = dpp_x8(w[1].x); p1.y = dpp_x8(w[1].y); p1.z = dpp_x8(w[1].z); p1.w = dpp_x8(w[1].w);
            u32x4 dA, dB;
            dA.x = lo ? w[0].x : p1.x; dA.y = lo ? w[0].y : p1.y; dA.z = lo ? w[0].z : p1.z; dA.w = lo ? w[0].w : p1.w;
            dB.x = lo ? p1.x : w[0].x; dB.y = lo ? p1.y : w[0].y; dB.z = lo ? p1.z : w[0].z; dB.w = lo ? p1.w : w[0].w;
            const size_t ro = (size_t)(ai * HALF + m * 16) * ldc;
            if (okA) *(u32x4*)(pA + ro) = dA;
            if (okB) *(u32x4*)(pB + ro) = dB;
        }
}
template <int AI_LO = 0, int AI_HI = 2>
__device__ __forceinline__ void epilogue(const GemmDesc& g, const f32x4 (&acc)[2][2][4][2], const Unit& u, int wr, int wc, int fr, int fq) {
    const int row0 = u.pm * BM + wr * 64 + fr;
    const int cin = wc * 32 + 8 * fq;
    if (g.mode == EM_MIXIN && u.pn >= 2 && u.pn < 6) {
#pragma unroll
        for (int ai = AI_LO; ai < AI_HI; ++ai)
#pragma unroll
            for (int m = 0; m < 4; ++m) {
                bf16_t* rowp = g.o0 + (size_t)(row0 + ai * HALF + m * 16) * g.ldc + 512 + (u.pn - 2) * HALF + cin;
                const f32x4 g0 = acc[ai][0][m][0], g1 = acc[ai][0][m][1], u0 = acc[ai][1][m][0], u1 = acc[ai][1][m][1];
                u32x4 w;
                w.x = cvt_pk_bf16(g0[0] * u0[0], g0[1] * u0[1]); w.y = cvt_pk_bf16(g0[2] * u0[2], g0[3] * u0[3]);
                w.z = cvt_pk_bf16(g1[0] * u1[0], g1[1] * u1[1]); w.w = cvt_pk_bf16(g1[2] * u1[2], g1[3] * u1[3]);
                *(u32x4*)rowp = w;
            }
        return;
    }
    if (g.mode == EM_SWIGLU) {
#pragma unroll
        for (int ai = AI_LO; ai < AI_HI; ++ai)
#pragma unroll
            for (int m = 0; m < 4; ++m) {
                bf16_t* rowp = g.o0 + (size_t)(row0 + ai * HALF + m * 16) * g.ldc + u.pn * HALF + cin;
                const f32x4 g0 = acc[ai][0][m][0], g1 = acc[ai][0][m][1], u0 = acc[ai][1][m][0], u1 = acc[ai][1][m][1];
                u32x4 w;
                w.x = cvt_pk_bf16(siluf_(g0[0]) * u0[0], siluf_(g0[1]) * u0[1]); w.y = cvt_pk_bf16(siluf_(g0[2]) * u0[2], siluf_(g0[3]) * u0[3]);
                w.z = cvt_pk_bf16(siluf_(g1[0]) * u1[0], siluf_(g1[1]) * u1[1]); w.w = cvt_pk_bf16(siluf_(g1[2]) * u1[2], siluf_(g1[3]) * u1[3]);
                *(u32x4*)rowp = w;
            }
        return;
    }
    if (g.mode == EM_MOE2) {
        const bool lo = fr < 8;
        const int chA = lo ? fq : 4 + fq, chB = lo ? 4 + fq : fq;
        bf16_t* q = g.o0 + (size_t)(u.pm * BM + wr * 64) * g.ldc + u.pn * BM + wc * 64;
        bf16_t* pA = q + (size_t)(fr & 7) * g.ldc + chA * 8;
        bf16_t* pB = q + (size_t)(8 + (fr & 7)) * g.ldc + chB * 8;
        u32x4 oa_[2][4], ob_[2][4];
#pragma unroll
        for (int ai = AI_LO; ai < AI_HI; ++ai) {
        if (g.flag) {
#pragma unroll
            for (int m = 0; m < 4; ++m) { const size_t ro = (size_t)(ai * HALF + m * 16) * g.ldc; oa_[ai][m] = *(const u32x4*)(pA + ro); ob_[ai][m] = *(const u32x4*)(pB + ro); }
        }
        __builtin_amdgcn_sched_barrier(0);
#pragma unroll
            for (int m = 0; m < 4; ++m) {
                const size_t ro = (size_t)(ai * HALF + m * 16) * g.ldc;
                float dA[8], dB[8];
#pragma unroll
                for (int j = 0; j < 8; ++j) {
                    const float a0 = acc[ai][0][m][j >> 2][j & 3], a1 = acc[ai][1][m][j >> 2][j & 3];
                    const float p1 = dpp_x8f(a1);
                    dA[j] = lo ? a0 : p1; dB[j] = lo ? p1 : a0;
                }
                if (g.flag) { const u32x4 oa = oa_[ai][m], ob = ob_[ai][m];
                    dA[0] += bflo(oa.x); dA[1] += bfhi(oa.x); dA[2] += bflo(oa.y); dA[3] += bfhi(oa.y); dA[4] += bflo(oa.z); dA[5] += bfhi(oa.z); dA[6] += bflo(oa.w); dA[7] += bfhi(oa.w);
                    dB[0] += bflo(ob.x); dB[1] += bfhi(ob.x); dB[2] += bflo(ob.y); dB[3] += bfhi(ob.y); dB[4] += bflo(ob.z); dB[5] += bfhi(ob.z); dB[6] += bflo(ob.w); dB[7] += bfhi(ob.w); }
                u32x4 wa, wb;
                wa.x = cvt_pk_bf16(dA[0], dA[1]); wa.y = cvt_pk_bf16(dA[2], dA[3]); wa.z = cvt_pk_bf16(dA[4], dA[5]); wa.w = cvt_pk_bf16(dA[6], dA[7]);
                wb.x = cvt_pk_bf16(dB[0], dB[1]); wb.y = cvt_pk_bf16(dB[2], dB[3]); wb.z = cvt_pk_bf16(dB[4], dB[5]); wb.w = cvt_pk_bf16(dB[6], dB[7]);
                *(u32x4*)(pA + ro) = wa; *(u32x4*)(pB + ro) = wb;
            }
        __builtin_amdgcn_sched_barrier(0);
        }
        return;
    }
    int act = 0; bf16_t* base = g.o0; int colt = u.pn * BM; int ldc = g.ldc;
    if (g.mode == EM_MIXIN) colt = (u.pn < 2) ? u.pn * BM : 1024 + (u.pn - 6) * BM;
    else if (g.mode == EM_RKVL) {
        const int pnb = u.pn + g.pn_bias;
        if (pnb < 12) { const int t = pnb >> 2; base = g.o0 + (size_t)t * T * D; colt = (pnb & 3) * BM; }
        else { base = g.o1; colt = (pnb - 12) * BM; ldc = LACT_LD; act = 1; }
    } else if (g.mode == EM_LORA2) {
        const int t = (u.pn + g.pn_bias) >> 2; base = (t == 0) ? g.o0 : (t == 1 ? g.o1 : g.o2); colt = (u.pn & 3) * BM; act = (t == 2) ? 0 : 2 + t;
    }
    const int colw = colt + wc * 64;
    bf16_t* bq = base + (size_t)(u.pm * BM + wr * 64) * ldc + colw;
    if (act == 0) store_tiles<0, AI_LO, AI_HI>(acc, bq, ldc, colw, fr, fq, nullptr);
    else if (act == 1) store_tiles<1, AI_LO, AI_HI>(acc, bq, ldc, colw, fr, fq, nullptr, LACT_W);
    else if (act == 2) store_tiles<2, AI_LO, AI_HI>(acc, bq, ldc, colw, fr, fq, g.p0);
    else store_tiles<3, AI_LO, AI_HI>(acc, bq, ldc, colw, fr, fq, g.p1);
}

template <bool GATHER>
__device__ __forceinline__ void unit_offs_f(const GemmDesc& g, const Unit& u, const int (&Rl)[2], const int (&Cl)[2], unsigned (&o)[2][2]) {
#pragma unroll
    for (int h = 0; h < 2; ++h)
#pragma unroll
        for (int i = 0; i < 2; ++i) {
            if constexpr (GATHER) o[h][i] = (unsigned)g.rowidx[u.pm * BM + h * HALF + Rl[i]] * (unsigned)(g.lda * 2) + (unsigned)(Cl[i] * 2);
            else o[h][i] = (unsigned)(Rl[i] * g.lda + Cl[i]) * 2u;
        }
}
template <bool GATHER>
__device__ __forceinline__ void gemm_phase(LAS unsigned char* lds, const GemmDesc& g, int G, int c, int tid) {
    const int wid = __builtin_amdgcn_readfirstlane(tid >> 6), lane = tid & 63, wr = wid >> 2, wc = wid & 3, fr = lane & 15, fq = lane >> 4;
    const int K = g.K, nt = K / BK, lda = g.lda;
    StaticOrder S; S.init(g.nM, g.nN, G, c);
    int Rl[2], Cl[2]; unsigned voffB[2];
    unsigned offc[2][2], offn[2][2];
#pragma unroll
    for (int i = 0; i < 2; ++i) { int R, C; stage_rc(tid * 16 + i * 8192, R, C); const int Rb = (R & ~31) + perm32(R & 31);
        Rl[i] = R; Cl[i] = C; voffB[i] = (unsigned)(Rb * K + C) * 2u; }
    const size_t kstep = (size_t)(BK * 2);
    const size_t hstepB = (size_t)HALF * K * 2;
    const size_t hstepA = GATHER ? (size_t)0 : (size_t)HALF * lda * 2;
    const unsigned ldsw = (unsigned)wid * 1024u;
    const int aoff = lds_byte(wr * 64 + fr, fq * 8), boff = lds_byte((wc & 1) * 64 + fr, fq * 8); const int bh = wc >> 1;
#define PG8_SA(b, h) (((b) * 2 + (h)) * HTB)
#define PG8_SB(b, h) ((4 + (b) * 2 + (h)) * HTB)
#define PG8_STAGE(bufoff, gbase, voff) do { _Pragma("unroll") for (int _i = 0; _i < 2; ++_i) \
        __builtin_amdgcn_global_load_lds((const unsigned*)((const char*)(gbase) + (voff)[_i]), (LAS unsigned*)(lds + (bufoff) + ldsw + _i * 8192), 16, 0, 0); } while (0)
#define PG8_LDA(dst, b, h) do { _Pragma("unroll") for (int m = 0; m < 4; ++m) _Pragma("unroll") for (int k = 0; k < 2; ++k) dst[m][k] = *(const LAS bf16x8*)(lds + PG8_SA(b, h) + aoff + m * 2048 + k * 1024); } while (0)
#define PG8_LDB(dst, b, h) do { _Pragma("unroll") for (int n = 0; n < 2; ++n) _Pragma("unroll") for (int k = 0; k < 2; ++k) dst[n][k] = *(const LAS bf16x8*)(lds + PG8_SB(b, bh) + boff + (h) * 4096 + n * 2048 + k * 1024); } while (0)
#define PG8_MMA(ai, bj, At, Bt) do { __builtin_amdgcn_s_setprio(1); _Pragma("unroll") for (int m = 0; m < 4; ++m) _Pragma("unroll") for (int n = 0; n < 2; ++n) _Pragma("unroll") for (int k = 0; k < 2; ++k) \
        acc[ai][bj][m][n] = __builtin_amdgcn_mfma_f32_16x16x32_bf16(Bt[n][k], At[m][k], acc[ai][bj][m][n], 0, 0, 0); __builtin_amdgcn_s_setprio(0); } while (0)
#define PG8_WAIT_V(n) asm volatile("s_waitcnt vmcnt(" #n ")" ::: "memory")
#define PG8_WAIT_L(n) asm volatile("s_waitcnt lgkmcnt(" #n ")" ::: "memory")
#define PG8_BAR __builtin_amdgcn_s_barrier()
#define PG8_SCHED __builtin_amdgcn_sched_barrier(0)
    Unit cur, nxt; int ui = 0;
    if (!S.next(0, cur)) return;
    f32x4 acc[2][2][4][2];
#pragma unroll
    for (int a = 0; a < 2; ++a)
#pragma unroll
        for (int b = 0; b < 2; ++b)
#pragma unroll
            for (int m = 0; m < 4; ++m)
#pragma unroll
                for (int n = 0; n < 2; ++n) acc[a][b][m][n] = (f32x4){0.f, 0.f, 0.f, 0.f};
    bf16x8 At[4][2], B0[2][2], B1[2][2];
    unit_offs_f<GATHER>(g, cur, Rl, Cl, offc);
#pragma unroll
    for (int h = 0; h < 2; ++h) { offn[h][0] = offc[h][0]; offn[h][1] = offc[h][1]; }
    const char* cA = (const char*)g.A + (GATHER ? (size_t)0 : a_off_bytes(g, cur)); const char* cB = (const char*)g.Bt + b_off_bytes(g, cur);
    PG8_STAGE(PG8_SB(0, 0), cB, voffB); PG8_STAGE(PG8_SB(0, 1), cB + hstepB, voffB); PG8_STAGE(PG8_SA(0, 0), cA, offc[0]); PG8_STAGE(PG8_SA(0, 1), cA + hstepA, offc[1]);
    if (wr == 1) PG8_BAR;
    PG8_WAIT_V(2); PG8_BAR;
    PG8_STAGE(PG8_SB(1, 0), cB + kstep, voffB); PG8_STAGE(PG8_SA(1, 0), cA + kstep, offc[0]); PG8_STAGE(PG8_SB(1, 1), cB + hstepB + kstep, voffB);
    PG8_WAIT_V(6); PG8_BAR;
    for (;;) {
        const bool has_next = S.next(ui + 1, nxt);
        const char* nA = has_next ? (const char*)g.A + (GATHER ? (size_t)0 : a_off_bytes(g, nxt)) : cA; const char* nB = has_next ? (const char*)g.Bt + b_off_bytes(g, nxt) : cB;
        if constexpr (GATHER) {
            if (has_next && wid == 0) {
#pragma unroll
                for (int q = 0; q < 4; ++q) __builtin_amdgcn_global_load_lds((const unsigned*)(g.rowidx + nxt.pm * BM + q * 64 + lane), (LAS unsigned*)(lds + STAGE_BYTES + q * 256), 4, 0, 0);
            }
        }
        for (int t = 0; t < nt; t += 2) {
            const bool last = (t == nt - 2);
            const char* a1 = cA + (size_t)(t + 1) * kstep;
            const char* a2 = last ? nA : cA + (size_t)(t + 2) * kstep; const char* b2 = last ? nB : cB + (size_t)(t + 2) * kstep;
            const char* a3 = a2 + kstep; const char* b3 = b2 + kstep;
            unsigned o2[2][2];
            if constexpr (GATHER) {
                if (last && has_next) {
                    const LAS int* ridx = (const LAS int*)(lds + STAGE_BYTES);
#pragma unroll
                    for (int h = 0; h < 2; ++h)
#pragma unroll
                        for (int i = 0; i < 2; ++i) offn[h][i] = (unsigned)ridx[h * HALF + Rl[i]] * (unsigned)(g.lda * 2) + (unsigned)(Cl[i] * 2);
                }
#pragma unroll
                for (int h = 0; h < 2; ++h)
#pragma unroll
                    for (int i = 0; i < 2; ++i) o2[h][i] = last ? offn[h][i] : offc[h][i];
            } else {
#pragma unroll
                for (int h = 0; h < 2; ++h)
#pragma unroll
                    for (int i = 0; i < 2; ++i) o2[h][i] = offc[0][i];
            }
            PG8_LDB(B0, 0, 0); PG8_LDB(B1, 0, 1); PG8_SCHED; PG8_LDA(At, 0, 0); PG8_STAGE(PG8_SA(1, 1), a1 + hstepA, offc[1]);
            PG8_WAIT_V(8); PG8_WAIT_L(0); PG8_BAR; PG8_MMA(0, 0, At, B0); PG8_MMA(0, 1, At, B1); PG8_BAR; PG8_SCHED;
            PG8_LDA(At, 0, 1); PG8_STAGE(PG8_SB(0, 0), b2, voffB); PG8_STAGE(PG8_SB(0, 1), b2 + hstepB, voffB); PG8_STAGE(PG8_SA(0, 0), a2, o2[0]);
            PG8_WAIT_V(8); PG8_WAIT_L(0); PG8_BAR; PG8_MMA(1, 0, At, B0); PG8_MMA(1, 1, At, B1); PG8_BAR; PG8_SCHED;
            PG8_LDB(B0, 1, 0); PG8_LDB(B1, 1, 1); PG8_SCHED; PG8_LDA(At, 1, 0); PG8_STAGE(PG8_SA(0, 1), a2 + hstepA, o2[1]);
            PG8_WAIT_V(8); PG8_WAIT_L(0); PG8_BAR; PG8_MMA(0, 0, At, B0); PG8_MMA(0, 1, At, B1); PG8_BAR; PG8_SCHED;
            PG8_LDA(At, 1, 1); PG8_STAGE(PG8_SB(1, 0), b3, voffB); PG8_STAGE(PG8_SB(1, 1), b3 + hstepB, voffB); PG8_STAGE(PG8_SA(1, 0), a3, o2[0]);
            PG8_WAIT_V(8); PG8_WAIT_L(0); PG8_BAR; PG8_MMA(1, 0, At, B0); PG8_MMA(1, 1, At, B1); PG8_BAR; PG8_SCHED;
        }
        if (wr == 0) PG8_BAR;
        epilogue(g, acc, cur, wr, wc, fr, fq);
        if (!has_next) break;
#pragma unroll
        for (int a = 0; a < 2; ++a)
#pragma unroll
            for (int b = 0; b < 2; ++b)
#pragma unroll
                for (int m = 0; m < 4; ++m)
#pragma unroll
                    for (int n = 0; n < 2; ++n) acc[a][b][m][n] = (f32x4){0.f, 0.f, 0.f, 0.f};
        cur = nxt; cA = nA; cB = nB; ++ui;
        if constexpr (GATHER) {
#pragma unroll
            for (int h = 0; h < 2; ++h) { offc[h][0] = offn[h][0]; offc[h][1] = offn[h][1]; }
        }
        if (wr == 1) PG8_BAR;
    }
    PG8_WAIT_V(0);
    PG8_BAR;
#undef PG8_SA
#undef PG8_SB
#undef PG8_STAGE
#undef PG8_LDA
#undef PG8_LDB
#undef PG8_MMA
#undef PG8_WAIT_V
#undef PG8_WAIT_L
#undef PG8_BAR
#undef PG8_SCHED
}
}

#define XB_TMO      128
#define XB_XCNT(j)  (256  + 64 * (j))
#define XB_XSUB(j)  (1280 + 64 * (j))
#define XB_XGEN(j)  (2304 + 64 * (j))
#define XB_TOP      3328
#define XB_TOPGEN   3392
#define XCD_BAR_WORDS 3456
#define XB_SPIN_CAP (1u << 20)
__device__ __forceinline__ unsigned xb_ld(unsigned* p)              { return __hip_atomic_load(p, __ATOMIC_RELAXED, __HIP_MEMORY_SCOPE_AGENT); }
__device__ __forceinline__ unsigned xb_add(unsigned* p, unsigned v) { return __hip_atomic_fetch_add(p, v, __ATOMIC_RELAXED, __HIP_MEMORY_SCOPE_AGENT); }
__device__ __forceinline__ unsigned xb_xcc_id() { return (unsigned)__builtin_amdgcn_s_getreg((3 << 11) | 20) & 0xFu; }
#define XB_SPIN(cond, bar) do { unsigned _sp = 0; while (cond) { __builtin_amdgcn_s_sleep(1); \
    if ((++_sp & 255u) == 0u) { if (xb_ld(&(bar)[XB_TMO])) break; if (_sp > XB_SPIN_CAP) { atomicAdd(&(bar)[XB_TMO], 1u); break; } } } } while (0)
struct XcdBarrier { unsigned* bar; unsigned x; volatile LAS unsigned* st; };
__device__ __forceinline__ XcdBarrier xcd_barrier_post(unsigned* bar, volatile LAS unsigned* st) {
    XcdBarrier b; b.bar = bar; b.x = xb_xcc_id(); b.st = st;
    if (threadIdx.x == 0) (void)xb_add(&bar[XB_XCNT(b.x)], 1u);
    return b;
}
__device__ __forceinline__ void xcd_barrier_complete(unsigned* bar, unsigned x, unsigned& nloc, unsigned& nx) {
    const unsigned G = gridDim.x * gridDim.y * gridDim.z;
    unsigned sum, cnt, mine, sp = 0u;
    for (;;) {
        sum = 0u; cnt = 0u; mine = 0u;
#pragma unroll
        for (unsigned j = 0; j < 16; ++j) { const unsigned c = xb_ld(&bar[XB_XCNT(j)]); sum += c; cnt += (c > 0u) ? 1u : 0u; mine = (j == x) ? c : mine; }
        if (sum == G) break;
        __builtin_amdgcn_s_sleep(1);
        if ((++sp & 255u) == 0u) { if (xb_ld(&bar[XB_TMO])) break; if (sp > XB_SPIN_CAP) { atomicAdd(&bar[XB_TMO], 1u); break; } }
    }
    nloc = mine > 0u ? mine : 1u; nx = cnt > 0u ? cnt : 1u;
}
__device__ __forceinline__ void xcd_barrier(const XcdBarrier& b) {
    asm volatile("s_waitcnt vmcnt(0)" ::: "memory");
    __syncthreads();
    if (threadIdx.x == 0) {
        unsigned* bar = b.bar;
        __builtin_amdgcn_s_waitcnt(0);
        unsigned nloc = b.st[0], nx = b.st[1];
        if (nloc == 0u) { xcd_barrier_complete(bar, b.x, nloc, nx); b.st[0] = nloc; b.st[1] = nx; }
        const unsigned old = xb_add(&bar[XB_XSUB(b.x)], 1u);
        const unsigned gen = old / nloc;
        if (old + 1u == (gen + 1u) * nloc) {
            __builtin_amdgcn_fence(__ATOMIC_RELEASE, "agent");
            asm volatile("s_waitcnt vmcnt(0)" ::: "memory");
            const unsigned og = xb_add(&bar[XB_TOP], 1u);
            const unsigned tg = og / nx;
            if (og + 1u == (tg + 1u) * nx) xb_add(&bar[XB_TOPGEN], 1u);
            else XB_SPIN(xb_ld(&bar[XB_TOPGEN]) == tg, bar);
            __builtin_amdgcn_fence(__ATOMIC_ACQUIRE, "agent");
            asm volatile("s_waitcnt vmcnt(0)" ::: "memory");
        } else {
            XB_SPIN(xb_ld(&bar[XB_TOPGEN]) == gen, bar);
            __builtin_amdgcn_fence(__ATOMIC_ACQUIRE, "agent");
            asm volatile("s_waitcnt vmcnt(0)" ::: "memory");
        }
    }
    __syncthreads();
}

constexpr int RING_BYTES = 131072;
constexpr int LDS_BYTES = 163840;
constexpr int MISC_OFF = LDS_BYTES - 1024;

struct Args {
    const float* in[35]; float* out; unsigned char* ws; int ph_lo, ph_hi;
};
enum { I_X = 0, I_C, I_ADAW, I_ADAB, I_NORMG, I_MIXWIN, I_CONVW, I_POOLW, I_POOLS, I_MIXWOUT, I_FFG, I_FFU, I_FFD, I_MU, I_WR, I_WK, I_WV, I_WO, I_W0, I_W1, I_W2, I_A0, I_A1, I_A2, I_G1, I_G2,
       I_KK, I_KA, I_RK, I_LNG, I_LNB, I_ROUTER, I_MOEG, I_MOEU, I_MOED };

struct Frame {
    LAS unsigned char* lds;
    int tid, lane, wave, vcu, G;
    unsigned char* ws;
};

struct ConvJob {
    const float* src; int src_ld;
    int n0s;
    int nK, nN;
    int k_lo, k_hi;
    bf16_t* dst; int dst_ld; int dst_r0, dst_c0;
    const float* scale; int smode;
    int remap;
};
__device__ __forceinline__ int conv_items(const ConvJob& j) { return (j.nK / 64) * (j.nN / 32); }
__device__ __forceinline__ void conv_item(const ConvJob& j, LAS float* scr, int item, int lane) {
    const int nblk = j.nN / 32, kb = item / nblk, nb = item % nblk, k0 = 64 * kb, n0 = 32 * nb;
    f32x4 v[8];
#pragma unroll
    for (int i = 0; i < 8; ++i) { const int kk = 8 * i + (lane >> 3); const int k = k0 + kk; v[i] = (f32x4){0.f, 0.f, 0.f, 0.f};
        if (k >= j.k_lo && k < j.k_hi) { const int sr = k - j.k_lo; v[i] = *(const f32x4*)(j.src + (size_t)sr * j.src_ld + j.n0s + n0 + 4 * (lane & 7));
            if (j.smode == 1) v[i] = v[i] * j.scale[sr]; else if (j.smode == 2) v[i] = v[i] * (1.0f - j.scale[sr]); } }
#pragma unroll
    for (int i = 0; i < 8; ++i) { const int kk = 8 * i + (lane >> 3); LAS float* d = scr + kk * 33 + 4 * (lane & 7); d[0] = v[i][0]; d[1] = v[i][1]; d[2] = v[i][2]; d[3] = v[i][3]; }
    asm volatile("s_waitcnt lgkmcnt(0)" ::: "memory");
    const int c = lane & 7;
#pragma unroll
    for (int q = 0; q < 4; ++q) { const int n = (lane >> 3) + 8 * q; const LAS float* s = scr + (8 * c) * 33 + n;
        u32x4 o; o.x = pk2(s[0 * 33], s[1 * 33]); o.y = pk2(s[2 * 33], s[3 * 33]); o.z = pk2(s[4 * 33], s[5 * 33]); o.w = pk2(s[6 * 33], s[7 * 33]);
        const int nl = n0 + n; int drow = j.dst_r0 + nl; if (j.remap) drow = j.dst_r0 + 256 * (nl >> 7) + 64 * ((nl & 127) >> 5) + (j.remap == 2 ? 32 : 0) + (nl & 31);
        *(GAS u32x4*)(j.dst + (size_t)drow * j.dst_ld + j.dst_c0 + k0 + 8 * c) = o; }
    asm volatile("s_waitcnt lgkmcnt(0)" ::: "memory");
}
__device__ __forceinline__ ConvJob mkjob(const float* src, int src_ld, int n0s, int nK, int nN, int k_lo, int k_hi, bf16_t* dst, int dst_ld, int dst_r0, int dst_c0, const float* scale, int smode, int remap) {
    ConvJob j; j.src = src; j.src_ld = src_ld; j.n0s = n0s; j.nK = nK; j.nN = nN; j.k_lo = k_lo; j.k_hi = k_hi; j.dst = dst; j.dst_ld = dst_ld; j.dst_r0 = dst_r0; j.dst_c0 = dst_c0; j.scale = scale; j.smode = smode; j.remap = remap; return j;
}
#define RUN_JOB(J) do { const ConvJob _j = (J); const int _n = conv_items(_j); for (int _it = (gw + NGW - (itbase % NGW)) % NGW; _it < _n; _it += NGW) conv_item(_j, scr, _it, F.lane); itbase += _n; } while (0)

__device__ __forceinline__ void phase_prologue(Frame& F, const Args& A) {
    unsigned char* ws = F.ws;
    LAS float* scr = (LAS float*)(F.lds + F.wave * 16384);
    const int gw = F.vcu * NWAVES + F.wave, NGW = F.G * NWAVES;
    {
        float* mod = (float*)(ws + WS_MOD);
        LAS float* red = (LAS float*)(F.lds);
        LAS float* sc_ = (LAS float*)(F.lds + 8192);
        for (int i = F.tid; i < 4 * D; i += NTHREADS) sc_[i] = siluf_(A.in[I_C][i]);
        __syncthreads();
        for (int task = F.vcu; task < 2 * 96; task += F.G) {
            const int l = task / 96, nb = task % 96, n = nb * 64 + F.lane;
            const float* w = A.in[I_ADAW] + (size_t)l * D * 6144 + n;
            float acc0 = 0.f, acc1 = 0.f, acc2 = 0.f, acc3 = 0.f;
            const int kb = F.wave * 128;
#pragma unroll 32
            for (int k = kb; k < kb + 128; ++k) {
                const float wv = w[(size_t)k * 6144];
                acc0 += sc_[k] * wv; acc1 += sc_[D + k] * wv; acc2 += sc_[2 * D + k] * wv; acc3 += sc_[3 * D + k] * wv;
            }
            red[(F.wave * 4 + 0) * 64 + F.lane] = acc0; red[(F.wave * 4 + 1) * 64 + F.lane] = acc1; red[(F.wave * 4 + 2) * 64 + F.lane] = acc2; red[(F.wave * 4 + 3) * 64 + F.lane] = acc3;
            __syncthreads();
            if (F.wave < 4) { float s = 0.f; for (int w8 = 0; w8 < 8; ++w8) s += red[(w8 * 4 + F.wave) * 64 + F.lane];
                mod[((size_t)l * 4 + F.wave) * 6144 + n] = s + A.in[I_ADAB][l * 6144 + n]; }
            __syncthreads();
        }
    }
    int itbase = 0;
    bf16_t* Win = (bf16_t*)(ws + WS_WIN); bf16_t* Woute = (bf16_t*)(ws + WS_WOUTE); bf16_t* Wfgu = (bf16_t*)(ws + WS_WFGU); bf16_t* Wfd = (bf16_t*)(ws + WS_WFD);
    bf16_t* Wrkv = (bf16_t*)(ws + WS_WRKV); bf16_t* Wlor = (bf16_t*)(ws + WS_WLOR); bf16_t* Wl2 = (bf16_t*)(ws + WS_WL2); bf16_t* Wo = (bf16_t*)(ws + WS_WO);
    RUN_JOB(mkjob(A.in[I_MIXWIN], MIXIN, 0, D, 512, 0, D, Win, D, 0, 0, nullptr, 0, 0));
    RUN_JOB(mkjob(A.in[I_MIXWIN], MIXIN, 512, D, 512, 0, D, Win, D, 512, 0, nullptr, 0, 1));
    RUN_JOB(mkjob(A.in[I_MIXWIN], MIXIN, 1024, D, 512, 0, D, Win, D, 512, 0, nullptr, 0, 2));
    RUN_JOB(mkjob(A.in[I_MIXWIN], MIXIN, 1536, D, 512, 0, D, Win, D, 1536, 0, nullptr, 0, 0));
    RUN_JOB(mkjob(A.in[I_MIXWOUT], D, 0, 512, D, 0, 512, Woute, D, 0, 0, nullptr, 0, 0));
    RUN_JOB(mkjob(A.in[I_FFG], FF, 0, D, FF, 0, D, Wfgu, D, 0, 0, nullptr, 0, 1));
    RUN_JOB(mkjob(A.in[I_FFU], FF, 0, D, FF, 0, D, Wfgu, D, 0, 0, nullptr, 0, 2));
    RUN_JOB(mkjob(A.in[I_FFD], D, 0, FF, D, 0, FF, Wfd, FF, 0, 0, nullptr, 0, 0));
    const float* mu = A.in[I_MU];
    RUN_JOB(mkjob(A.in[I_WR], D, 0, D, D, 0, D, Wrkv, D, 0, 0, nullptr, 0, 0));
    RUN_JOB(mkjob(A.in[I_WK], D, 0, D, D, 0, D, Wrkv, D, D, 0, nullptr, 0, 0));
    RUN_JOB(mkjob(A.in[I_WV], D, 0, D, D, 0, D, Wrkv, D, 2 * D, 0, nullptr, 0, 0));
    RUN_JOB(mkjob(A.in[I_W1], 64, 0, D, 64, 0, D, Wlor, 2 * D, 0, 0, mu + 1 * D, 1, 0));
    RUN_JOB(mkjob(A.in[I_W1], 64, 0, D, 64, 0, D, Wlor, 2 * D, 0, D, mu + 1 * D, 2, 0));
    RUN_JOB(mkjob(A.in[I_A1], 64, 0, D, 64, 0, D, Wlor, 2 * D, 64, 0, mu + 4 * D, 1, 0));
    RUN_JOB(mkjob(A.in[I_A1], 64, 0, D, 64, 0, D, Wlor, 2 * D, 64, D, mu + 4 * D, 2, 0));
    RUN_JOB(mkjob(A.in[I_G1], 160, 0, D, 160, 0, D, Wlor, 2 * D, 128, 0, mu + 5 * D, 1, 0));
    RUN_JOB(mkjob(A.in[I_G1], 160, 0, D, 160, 0, D, Wlor, 2 * D, 128, D, mu + 5 * D, 2, 0));
    RUN_JOB(mkjob(A.in[I_W2], D, 0, 256, D, 0, 64, Wl2, 256, 0, 0, nullptr, 0, 0));
    RUN_JOB(mkjob(A.in[I_A2], D, 0, 256, D, 64, 128, Wl2, 256, D, 0, nullptr, 0, 0));
    RUN_JOB(mkjob(A.in[I_G2], D, 0, 256, D, 0, 160, Wl2, 256, 2 * D, 0, nullptr, 0, 0));
    RUN_JOB(mkjob(A.in[I_WO], D, 0, D, D, 0, D, Wo, D, 0, 0, nullptr, 0, 0));
    { u32x4* z = (u32x4*)(Wlor + (size_t)288 * 2 * D); const int n16 = 224 * 2 * D * 2 / 16;
      for (int i = gw * 64 + F.lane; i < n16; i += NGW * 64) z[i] = (u32x4){0u, 0u, 0u, 0u}; }
    {
        const float* pw = A.in[I_POOLW]; const float* ps = A.in[I_POOLS]; const float* wo = A.in[I_MIXWOUT];
        for (int item = gw; item < 512 * 4; item += NGW) {
            const int kk = item >> 2, db = item & 3, g = kk >> 7, c = kk & 127, d = db * 256 + 4 * F.lane;
            f32x4 s = (f32x4){0.f, 0.f, 0.f, 0.f};
#pragma unroll 32
            for (int c2 = 0; c2 < 128; ++c2) s = s + (pw[((size_t)g * 128 + c) * 128 + c2] * ps[g * 128 + c2]) * *(const f32x4*)(wo + (size_t)(512 + g * 128 + c2) * D + d);
#pragma unroll
            for (int q = 0; q < 4; ++q) Woute[(size_t)(d + q) * D + 512 + kk] = (bf16_t)f2bf(s[q]);
        }
    }
}

__device__ __forceinline__ void moe_convert(Frame& F, const Args& A, int part, int half, bf16_t* dst, int pidx, int np) {
    LAS float* scr = (LAS float*)(F.lds + F.wave * 16384);
    const int gw = pidx * NWAVES + F.wave, NGW = np * NWAVES;
    int itbase = 0;
    for (int e = 0; e < NE; ++e) {
        if (part == 0) {
            RUN_JOB(mkjob(A.in[I_MOEG] + (size_t)e * D * FF, FF, half * FH, D, FH, 0, D, dst, D, e * FF, 0, nullptr, 0, 1));
            RUN_JOB(mkjob(A.in[I_MOEU] + (size_t)e * D * FF, FF, half * FH, D, FH, 0, D, dst, D, e * FF, 0, nullptr, 0, 2));
        } else {
            RUN_JOB(mkjob(A.in[I_MOED] + (size_t)e * FF * D + (size_t)half * FH * D, D, 0, FH, D, 0, FH, dst, FH, e * D, 0, nullptr, 0, 0));
        }
    }
}

constexpr int MCV_ITEMS = 32 * 2816;
struct McvDst { bf16_t* p; };
__device__ __forceinline__ McvDst mcv_load(const Args& A, unsigned char* ws, int id, int lane, float (&v)[8]) {
    const int t = id / 2816, r = id % 2816;
    const float* src; int ld; bf16_t* dst;
    if (t < 16) { const int e = t >> 1, up = t & 1, kb = r / 22, nb = r % 22, nl = nb * 64 + lane;
        src = A.in[up ? I_MOEU : I_MOEG] + (size_t)e * D * FF + (size_t)(kb * 8) * FF + nl; ld = FF;
        dst = (bf16_t*)(ws + WS_WMGU) + (size_t)(e * FF + 256 * (nl >> 7) + 64 * ((nl & 127) >> 5) + (up ? 32 : 0) + (nl & 31)) * D + kb * 8;
    } else { const int half = (t - 16) >> 3, e = (t - 16) & 7, kb = r / 16, nb = r % 16, n = nb * 64 + lane;
        src = A.in[I_MOED] + (size_t)e * FF * D + (size_t)(half * FH + kb * 8) * D + n; ld = D;
        dst = (bf16_t*)(ws + (half ? WS_WMD1 : WS_WMD0)) + (size_t)(e * D + n) * FH + kb * 8; }
#pragma unroll
    for (int i = 0; i < 8; ++i) v[i] = __builtin_nontemporal_load(src + (size_t)i * ld);
    McvDst d; d.p = dst; return d;
}
__device__ __forceinline__ void mcv_store(const McvDst& d, const float (&v)[8]) {
    *(u32x4*)(d.p) = (u32x4){pk2(v[0], v[1]), pk2(v[2], v[3]), pk2(v[4], v[5]), pk2(v[6], v[7])};
}

struct RowP {
    const float* xin; float* xout;
    const bf16_t* y;
    const float* gate; const float* gpost;
    const float* gpre; const float* sc; const float* sh;
    bf16_t* hout; int hpad;
    float* xh;
    int xin_b, xout_b;
};
struct RowIn { f32x4 xf[4]; u32x2 xb[4]; u32x2 yw[4]; };
__device__ __forceinline__ void row_load(const RowP& P, int t, int lane, RowIn& in, const float* xrow = nullptr) {
    if (P.xin_b && !xrow) {
        const GAS u32x2* xr = (const GAS u32x2*)((const bf16_t*)P.xin + (size_t)t * 2048 + 1024) + lane;
#pragma unroll
        for (int j = 0; j < 4; ++j) in.xb[j] = xr[64 * j];
    } else {
        const GAS f32x4* xr = (const GAS f32x4*)(xrow ? xrow : P.xin + (size_t)t * D) + lane;
#pragma unroll
        for (int j = 0; j < 4; ++j) in.xf[j] = xr[64 * j];
    }
    if (P.y) {
        const GAS u32x2* yr = (const GAS u32x2*)(P.y + (size_t)t * D) + lane;
#pragma unroll
        for (int j = 0; j < 4; ++j) in.yw[j] = yr[64 * j];
    }
}
__device__ __forceinline__ void row_compute(const RowP& P, int t, int lane, const RowIn& in, f32x4 (&hv)[4], bool want_h, bool halo = false) {
    const int b = t / SEQ;
    f32x4 x[4];
    if (P.xin_b && !halo) {
#pragma unroll
        for (int j = 0; j < 4; ++j) { const u32x2 w = in.xb[j]; x[j] = (f32x4){bflo(w.x), bfhi(w.x), bflo(w.y), bfhi(w.y)}; }
    } else {
#pragma unroll
        for (int j = 0; j < 4; ++j) x[j] = in.xf[j];
    }
    if (P.y) {
        f32x4 yv[4]; float ss = 0.f;
#pragma unroll
        for (int j = 0; j < 4; ++j) { const u32x2 w = in.yw[j]; yv[j] = (f32x4){bflo(w.x), bfhi(w.x), bflo(w.y), bfhi(w.y)}; ss += (yv[j].x * yv[j].x + yv[j].y * yv[j].y) + (yv[j].z * yv[j].z + yv[j].w * yv[j].w); }
        const float rs = rsqrtf(wave_sum(ss) * (1.0f / D) + RMS_EPS);
#pragma unroll
        for (int j = 0; j < 4; ++j) { const f32x4 gt = *((const f32x4*)(P.gate + (size_t)b * 6144) + lane + 64 * j); const f32x4 gp = *((const f32x4*)P.gpost + lane + 64 * j);
            x[j] = x[j] + gt * gp * yv[j] * rs; }
    }
    if (P.xout_b) {
        u32x2 w[4];
#pragma unroll
        for (int j = 0; j < 4; ++j) { w[j] = (u32x2){pk2(x[j].x, x[j].y), pk2(x[j].z, x[j].w)}; x[j] = (f32x4){bflo(w[j].x), bfhi(w[j].x), bflo(w[j].y), bfhi(w[j].y)}; }
        if (!halo) { GAS u32x2* xo = (GAS u32x2*)((bf16_t*)P.xout + (size_t)t * 2048 + 1024) + lane;
#pragma unroll
            for (int j = 0; j < 4; ++j) xo[64 * j] = w[j]; }
    } else if (P.xout && !halo) { GAS f32x4* xo = (GAS f32x4*)(P.xout + (size_t)t * D) + lane;
#pragma unroll
        for (int j = 0; j < 4; ++j) xo[64 * j] = x[j]; }
    if (P.xh && (t & 15) == 15) { GAS f32x4* xo = (GAS f32x4*)(P.xh + (size_t)(t >> 4) * D) + lane;
#pragma unroll
        for (int j = 0; j < 4; ++j) xo[64 * j] = x[j]; }
    if (want_h) {
        float ss = 0.f;
#pragma unroll
        for (int j = 0; j < 4; ++j) ss += (x[j].x * x[j].x + x[j].y * x[j].y) + (x[j].z * x[j].z + x[j].w * x[j].w);
        const float rs = rsqrtf(wave_sum(ss) * (1.0f / D) + RMS_EPS);
#pragma unroll
        for (int j = 0; j < 4; ++j) { const f32x4 gp = *((const f32x4*)P.gpre + lane + 64 * j); const f32x4 sc = *((const f32x4*)(P.sc + (size_t)b * 6144) + lane + 64 * j); const f32x4 sh = *((const f32x4*)(P.sh + (size_t)b * 6144) + lane + 64 * j);
            hv[j] = x[j] * rs * gp * (1.0f + sc) + sh; }
        if (P.hout && !halo) { const size_t hr = P.hpad ? (size_t)b * (SEQ + 1) + (size_t)(t - b * SEQ) + 1 : (size_t)t;
            GAS u32x2* ho = (GAS u32x2*)(P.hout + hr * D) + lane;
#pragma unroll
            for (int j = 0; j < 4; ++j) ho[64 * j] = (u32x2){pk2(hv[j].x, hv[j].y), pk2(hv[j].z, hv[j].w)}; }
    }
}
__device__ __forceinline__ void phase_rows(Frame& F, const RowP& P) {
    const int gw = F.vcu * NWAVES + F.wave, NGW = F.G * NWAVES;
    f32x4 hv[4];
    RowIn cur, nxt;
    int t = gw; if (t < T) row_load(P, t, F.lane, cur);
    for (; t < T; t += NGW) { if (t + NGW < T) row_load(P, t + NGW, F.lane, nxt); row_compute(P, t, F.lane, cur, hv, P.gpre != nullptr); cur = nxt; }
}

__device__ __forceinline__ void phase_post2(Frame& F, const Args& A, const RowP& P) {
    const int g = F.vcu * NWAVES + F.wave, lane = F.lane;
    const float* mu = A.in[I_MU];
    f32x4 mur[4], muk[4], muv[4];
#pragma unroll
    for (int j = 0; j < 4; ++j) { mur[j] = *((const f32x4*)(mu + 0 * D) + lane + 64 * j); muk[j] = *((const f32x4*)(mu + 2 * D) + lane + 64 * j); muv[j] = *((const f32x4*)(mu + 3 * D) + lane + 64 * j); }
    bf16_t* XR = (bf16_t*)(F.ws + WS_XR); bf16_t* XK = (bf16_t*)(F.ws + WS_XK); bf16_t* XV = (bf16_t*)(F.ws + WS_XV);
    const int t0 = 16 * g;
    f32x4 hp[4];
    if (t0 % SEQ == 0) {
#pragma unroll
        for (int j = 0; j < 4; ++j) hp[j] = (f32x4){0.f, 0.f, 0.f, 0.f};
    } else { RowIn hin; row_load(P, t0 - 1, lane, hin, (const float*)(F.ws + WS_XH) + (size_t)(g - 1) * D); row_compute(P, t0 - 1, lane, hin, hp, true, true); }
    RowIn cur, nxt; row_load(P, t0, lane, cur);
#pragma unroll 1
    for (int t = t0; t < t0 + 16; ++t) {
        if (t + 1 < t0 + 16) row_load(P, t + 1, lane, nxt);
        f32x4 hv[4]; row_compute(P, t, lane, cur, hv, true); cur = nxt;
        GAS u32x2* pr = (GAS u32x2*)(XR + (size_t)t * D) + lane; GAS u32x2* pk = (GAS u32x2*)(XK + (size_t)t * D) + lane; GAS u32x2* pv = (GAS u32x2*)(XV + (size_t)t * D) + lane;
#pragma unroll
        for (int j = 0; j < 4; ++j) { const f32x4 d = hp[j] - hv[j];
            const f32x4 a = hv[j] + d * mur[j], b = hv[j] + d * muk[j], c = hv[j] + d * muv[j];
            pr[64 * j] = (u32x2){pk2(a.x, a.y), pk2(a.z, a.w)}; pk[64 * j] = (u32x2){pk2(b.x, b.y), pk2(b.z, b.w)}; pv[64 * j] = (u32x2){pk2(c.x, c.y), pk2(c.z, c.w)};
            hp[j] = hv[j]; }
    }
}

__device__ __forceinline__ void phase_mix(Frame& F, const Args& A) {
    const bf16_t* __restrict__ Z = (const bf16_t*)(F.ws + WS_Z); bf16_t* __restrict__ A2 = (bf16_t*)(F.ws + WS_A2);
    constexpr int TB = 32;
    const int tid = F.tid;
    for (int blk = F.vcu; blk < T / TB; blk += F.G) {
        const int t0 = blk * TB, b = t0 / SEQ, tb0 = t0 - b * SEQ;
        if (tid < 256) {
            const int c = 2 * tid;
            const float w00 = A.in[I_CONVW][c], w01 = A.in[I_CONVW][c + 1], w10 = A.in[I_CONVW][512 + c], w11 = A.in[I_CONVW][512 + c + 1], w20 = A.in[I_CONVW][1024 + c], w21 = A.in[I_CONVW][1024 + c + 1];
            float um2_0 = 0.f, um2_1 = 0.f, um1_0 = 0.f, um1_1 = 0.f;
            for (int s = -2; s < 0; ++s) if (tb0 + s >= 0) { const bf16_t* zr = Z + (size_t)(t0 + s) * ZLD;
                const unsigned uw = *(const unsigned*)(zr + 512 + c);
                const float u0 = bflo(uw), u1 = bfhi(uw);
                if (s == -2) { um2_0 = u0; um2_1 = u1; } else { um1_0 = u0; um1_1 = u1; } }
            unsigned bgv[2][8], uvv[2][8];
#pragma unroll
            for (int q = 0; q < 8; ++q) { const bf16_t* zr = Z + (size_t)(t0 + q) * ZLD; bgv[0][q] = *(const unsigned*)(zr + c); uvv[0][q] = *(const unsigned*)(zr + 512 + c); }
#pragma unroll
            for (int grp = 0; grp < TB / 8; ++grp) {
                const int cu = grp & 1, nx = cu ^ 1;
                if (grp + 1 < TB / 8) {
#pragma unroll
                    for (int q = 0; q < 8; ++q) { const bf16_t* zr = Z + (size_t)(t0 + 8 * (grp + 1) + q) * ZLD; bgv[nx][q] = *(const unsigned*)(zr + c); uvv[nx][q] = *(const unsigned*)(zr + 512 + c); }
                }
                __builtin_amdgcn_sched_barrier(0);
#pragma unroll
                for (int q = 0; q < 8; ++q) { const int s = 8 * grp + q; const unsigned bg = bgv[cu][q], uw = uvv[cu][q];
                    const float u0 = bflo(uw), u1 = bfhi(uw);
                    const float y0 = bflo(bg) * (w00 * um2_0 + w10 * um1_0 + w20 * u0), y1 = bfhi(bg) * (w01 * um2_1 + w11 * um1_1 + w21 * u1);
                    *(unsigned*)(A2 + (size_t)(t0 + s) * D + c) = pk2(y0, y1);
                    um2_0 = um1_0; um2_1 = um1_1; um1_0 = u0; um1_1 = u1; }
                __builtin_amdgcn_sched_barrier(0);
            }
        } else {
            const int c = 2 * (tid - 256), win = 2 << (c >> 7);
            float s0 = 0.f, s1 = 0.f;
            for (int s = -win + 1; s < 0; ++s) if (tb0 + s >= 0) { const unsigned v = *(const unsigned*)(Z + (size_t)(t0 + s) * ZLD + 1024 + c); s0 += bflo(v); s1 += bfhi(v); }
            unsigned vv[2][8], ov[2][8];
#pragma unroll
            for (int q = 0; q < 8; ++q) { vv[0][q] = *(const unsigned*)(Z + (size_t)(t0 + q) * ZLD + 1024 + c);
                ov[0][q] = (tb0 + q - win + 1 >= 0) ? *(const unsigned*)(Z + (size_t)(t0 + q - win + 1) * ZLD + 1024 + c) : 0u; }
#pragma unroll
            for (int grp = 0; grp < TB / 8; ++grp) {
                const int cu = grp & 1, nx = cu ^ 1;
                if (grp + 1 < TB / 8) {
#pragma unroll
                    for (int q = 0; q < 8; ++q) { const int s = 8 * (grp + 1) + q; vv[nx][q] = *(const unsigned*)(Z + (size_t)(t0 + s) * ZLD + 1024 + c);
                        ov[nx][q] = (tb0 + s - win + 1 >= 0) ? *(const unsigned*)(Z + (size_t)(t0 + s - win + 1) * ZLD + 1024 + c) : 0u; }
                }
                __builtin_amdgcn_sched_barrier(0);
#pragma unroll
                for (int q = 0; q < 8; ++q) { const int s = 8 * grp + q;
                    const unsigned v = vv[cu][q]; const float v0 = bflo(v), v1 = bfhi(v);
                    s0 += v0; s1 += v1;
                    const int pos = tb0 + s; const float icnt = __builtin_amdgcn_rcpf((float)((pos + 1 < win) ? pos + 1 : win));
                    *(unsigned*)(A2 + (size_t)(t0 + s) * D + 512 + c) = pk2(s0 * icnt - v0, s1 * icnt - v1);
                    const unsigned o = ov[cu][q]; s0 -= bflo(o); s1 -= bfhi(o);
                }
                __builtin_amdgcn_sched_barrier(0);
            }
        }
    }
}

namespace sm {
typedef LAS unsigned char* lp;
constexpr int TL = 8192;
constexpr int O_RAW = 0;
constexpr int O_LC = 40960;
constexpr int LCS = 68;
constexpr int O_TM = O_LC + 64 * LCS * 4;
constexpr int O_CM = O_TM + 4 * TL;
constexpr int O_X = O_CM + 4 * TL;
constexpr int O_S = O_X + 2 * TL;
constexpr int O_TB = O_S + 2 * TL;
constexpr int O_F = O_TB + 2048;
constexpr int O_END = O_F + (3 * 64 + 8 * 64 + 5 * 64) * 4;
static_assert(O_END <= MISC_OFF, "scan LDS map");
__device__ __forceinline__ int toff(int r, int c16) { return r * 128 + ((c16 ^ (r & 7)) << 4); }
typedef __bf16 bf16x2_t __attribute__((ext_vector_type(2)));
__device__ __forceinline__ unsigned cvtpk_s(float lo, float hi) { f32x2 v = {lo, hi}; bf16x2_t b = __builtin_convertvector(v, bf16x2_t); return __builtin_bit_cast(unsigned, b); }
__device__ __forceinline__ bf16x8 ldfrag(lp tile, int row, int c16) { return *(const LAS bf16x8*)(tile + toff(row, c16)); }
__device__ __forceinline__ f32x4 mm64(f32x4 acc, lp At, int m0, lp Bt, int n0, int lane) {
    const int r = lane & 15, q = lane >> 4;
#pragma unroll
    for (int ks = 0; ks < 2; ++ks) { const bf16x8 a = ldfrag(At, m0 + r, 4 * ks + q), b = ldfrag(Bt, n0 + r, 4 * ks + q); acc = __builtin_amdgcn_mfma_f32_16x16x32_bf16(a, b, acc, 0, 0, 0); }
    return acc;
}
__device__ __forceinline__ void st_nat(lp tile, int m0, int n0, f32x4 v, int lane) {
    const int n = n0 + (lane & 15), m = m0 + 4 * (lane >> 4);
    u32x2 w; w.x = cvtpk_s(v[0], v[1]); w.y = cvtpk_s(v[2], v[3]);
    *(LAS u32x2*)(tile + toff(n, m >> 3) + (m & 7) * 2) = w;
}
__device__ __forceinline__ f32x4 ld_nat(lp tile, int m0, int n0, int lane) {
    const int n = n0 + (lane & 15), m = m0 + 4 * (lane >> 4);
    const u32x2 w = *(const LAS u32x2*)(tile + toff(n, m >> 3) + (m & 7) * 2);
    return (f32x4){bflo(w.x), bfhi(w.x), bflo(w.y), bfhi(w.y)};
}
__device__ __forceinline__ float red8(float v) { return sum8_dpp(v); }
}

#define LBAR() asm volatile("s_waitcnt lgkmcnt(0)\n\ts_barrier" ::: "memory")
namespace sm {
constexpr int A_RAW = 0;
constexpr int A_LC = 4 * TL;
constexpr int A_TM = A_LC + 64 * LCS * 4;
constexpr int A_CM = A_TM + 4 * TL;
constexpr int A_X = A_CM + 4 * TL;
constexpr int A_S = A_X + 2 * TL;
constexpr int A_TB = A_S + 2 * TL;
constexpr int A_F = A_TB + 2048;
static_assert(A_F + 4096 <= MISC_OFF, "scan pass A LDS map");
constexpr int SEQQ = SEQ / 4, NCHQ = SEQQ / 64;
}
__device__ __forceinline__ void phase_scanA(Frame& F, const Args& A) {
    using namespace sm;
    const int unit = F.vcu, bh = unit >> 2, qq = unit & 3, b = bh / NH, h = bh % NH;
    const int tid = F.tid, lane = F.lane, w = F.wave;
    const int tA = tid >> 3, jsA = tid & 7;
    const int jB = tid & 63, qB = tid >> 6;
    lp L = F.lds;
    lp RAWk = L + A_RAW, RAWv = RAWk + TL, RAWw = RAWv + TL, RAWa = RAWw + TL;
    lp MabT = L + A_RAW, MkaT = MabT + TL, NbrT = MkaT + TL, NkrT = NbrT + TL; lp TG = MabT, TS = MkaT;
    LAS float* LC = (LAS float*)(L + A_LC); lp YT = L + A_LC, ZC = YT + TL;
    lp AtM = L + A_TM, RtM = AtM + TL, BtM = RtM + TL, KtM = BtM + TL; lp ZT = AtM, GcT = BtM;
    lp AtT = L + A_CM, BtT = AtT + TL, KtT = BtT + TL, VT = KtT + TL;
    lp XP = L + A_X, XQ = XP + TL;
    lp SG = L + A_S, SL = SG + TL;
    lp TB = L + A_TB;
    LAS float* FS = (LAS float*)(L + A_F); LAS float* DCv = FS; LAS float* INV = FS + 64; LAS float* BSC = FS + 128; LAS float* TOT = FS + 192; LAS float* PRM = FS + 192 + 512;
    if (tid < 64) { const int ch = h * HS + tid; PRM[tid] = A.in[I_KK][ch]; PRM[64 + tid] = A.in[I_KA][ch]; PRM[128 + tid] = A.in[I_RK][ch]; PRM[192 + tid] = A.in[I_W0][ch]; PRM[256 + tid] = A.in[I_A0][ch]; }
    { *(LAS u32x4*)(SG + tid * 16) = (u32x4){0u, 0u, 0u, 0u}; *(LAS u32x4*)(SL + tid * 16) = (u32x4){0u, 0u, 0u, 0u}; }
    LBAR();
    if (tid < 64) *(LAS bf16_t*)(SG + toff(tid, tid >> 3) + (tid & 7) * 2) = (bf16_t)0x3F80;
    const bf16_t* gR = (const bf16_t*)(F.ws + WS_R); const bf16_t* gK = (const bf16_t*)(F.ws + WS_K); const bf16_t* gV = (const bf16_t*)(F.ws + WS_V);
    const bf16_t* gL = (const bf16_t*)A.out;
    bf16_t* gYL = (bf16_t*)(F.ws + WS_R); bf16_t* gZC = (bf16_t*)(F.ws + WS_K); float* gBS = (float*)(F.ws + WS_BSC);
    const size_t trow0 = (size_t)b * SEQ + (size_t)qq * SEQQ;
    const size_t rowbase = (trow0 + tA) * D + h * HS + jsA * 8;
    const size_t lbase = (trow0 + tA) * LACT_LD + jsA * 8;
    u32x4 nr = *(const u32x4*)(gR + rowbase), nk = *(const u32x4*)(gK + rowbase), nv = *(const u32x4*)(gV + rowbase), nw = *(const u32x4*)(gL + lbase), na = *(const u32x4*)(gL + lbase + 64);
    const float kkwB = A.in[I_KK][h * HS + jB], kawB = A.in[I_KA][h * HS + jB];
    { const int o = toff(tA, jsA); *(LAS u32x4*)(AtM + o) = nw; *(LAS u32x4*)(RtM + o) = na; }
    const int l2kind = w >> 2, l2jb = w & 3;
    bf16x8 l2frag[2];
    { const bf16_t* l2W = (const bf16_t*)(F.ws + WS_WL2) + (size_t)((l2kind ? D : 0) + h * HS + 16 * l2jb + (lane & 15)) * 256 + (l2kind ? 64 : 0) + 8 * (lane >> 4);
      l2frag[0] = *(const bf16x8*)(l2W); l2frag[1] = *(const bf16x8*)(l2W + 32); }
    LBAR();
#pragma unroll 1
    for (int c = 0; c < NCHQ; ++c) {
        int tl_ = tid; asm volatile("" : "+v"(tl_));
        const int tid = tl_, lane = tl_ & 63, tA = tl_ >> 3, jsA = tl_ & 7, jB = tl_ & 63, qB = tl_ >> 6;
        const u32x4 cr = nr, ck = nk, cv = nv;
        { const int o = toff(tA, jsA); *(LAS u32x4*)(RAWk + o) = ck; *(LAS u32x4*)(RAWv + o) = cv; }
        if (c + 1 < NCHQ) { const size_t o = rowbase + (size_t)(c + 1) * 64 * D; nr = *(const u32x4*)(gR + o); nk = *(const u32x4*)(gK + o); nv = *(const u32x4*)(gV + o); nw = *(const u32x4*)(gL + lbase + (size_t)(c + 1) * 64 * LACT_LD); na = *(const u32x4*)(gL + lbase + (size_t)(c + 1) * 64 * LACT_LD + 64); }
        {
            lp Ht = l2kind ? RtM : AtM; lp Ot = l2kind ? RAWa : RAWw;
#pragma unroll
            for (int tb = 0; tb < 4; ++tb) {
                f32x4 acc = *(const LAS f32x4*)(PRM + (3 + l2kind) * 64 + 16 * l2jb + 4 * (lane >> 4));
#pragma unroll
                for (int ks = 0; ks < 2; ++ks) acc = __builtin_amdgcn_mfma_f32_16x16x32_bf16(l2frag[ks], ldfrag(Ht, 16 * tb + (lane & 15), 4 * ks + (lane >> 4)), acc, 0, 0, 0);
#pragma unroll
                for (int e = 0; e < 4; ++e) { const float sg = sigmoidf_(acc[e]); acc[e] = l2kind ? sg : -0.60653066f * sg; }
                st_nat(Ot, 16 * l2jb, 16 * tb, acc, lane);
            }
        }
        LBAR();
        const u32x4 cw = *(const LAS u32x4*)(RAWw + toff(tA, jsA)), ca = *(const LAS u32x4*)(RAWa + toff(tA, jsA));
        float kf[8], af[8], rf[8], wf[8];
        { const unsigned kw[4] = {ck.x, ck.y, ck.z, ck.w}, aw[4] = {ca.x, ca.y, ca.z, ca.w}, rw[4] = {cr.x, cr.y, cr.z, cr.w}, ww[4] = {cw.x, cw.y, cw.z, cw.w};
#pragma unroll
          for (int p = 0; p < 4; ++p) { kf[2 * p] = bflo(kw[p]); kf[2 * p + 1] = bfhi(kw[p]); af[2 * p] = bflo(aw[p]); af[2 * p + 1] = bfhi(aw[p]); rf[2 * p] = bflo(rw[p]); rf[2 * p + 1] = bfhi(rw[p]); wf[2 * p] = bflo(ww[p]); wf[2 * p + 1] = bfhi(ww[p]); } }
        float kkA[8], kpA[8];
        { const f32x4 k0 = *(const LAS f32x4*)(PRM + 8 * jsA), k1 = *(const LAS f32x4*)(PRM + 8 * jsA + 4), a0 = *(const LAS f32x4*)(PRM + 64 + 8 * jsA), a1 = *(const LAS f32x4*)(PRM + 64 + 8 * jsA + 4), r0 = *(const LAS f32x4*)(PRM + 128 + 8 * jsA), r1 = *(const LAS f32x4*)(PRM + 128 + 8 * jsA + 4);
          float ss = 0.f, bs = 0.f;
#pragma unroll
          for (int p = 0; p < 8; ++p) { const float kkw = p < 4 ? k0[p & 3] : k1[p & 3], kaw = p < 4 ? a0[p & 3] : a1[p & 3], rkw = p < 4 ? r0[p & 3] : r1[p & 3];
              kkA[p] = kf[p] * kkw; ss += kkA[p] * kkA[p]; kpA[p] = kf[p] * (1.0f + (af[p] - 1.0f) * kaw); bs += rf[p] * kpA[p] * rkw; }
          ss = red8(ss); bs = red8(bs);
          if (jsA == 0) { INV[tA] = 1.0f / fmaxf(sqrtf(ss), 1e-12f); BSC[tA] = bs; } }
        LBAR();
        {
            float pw[8], wlv[8];
            float run = 0.f;
#pragma unroll
            for (int p = 0; p < 8; ++p) { const int t = 8 * qB + p; wlv[p] = bf1(*(const LAS bf16_t*)(RAWw + toff(t, jB >> 3) + (jB & 7) * 2)); run += wlv[p]; pw[p] = run; }
            TOT[qB * 64 + jB] = run;
            LBAR();
            float off = 0.f;
#pragma unroll
            for (int q2 = 0; q2 < 7; ++q2) off += (q2 < qB) ? TOT[q2 * 64 + jB] : 0.f;
            unsigned oa[4], ob[4], ok[4], ov[4];
            float pa = 0.f, pb = 0.f, pk = 0.f, pv = 0.f;
#pragma unroll
            for (int p = 0; p < 8; ++p) { const int t = 8 * qB + p; const int eo = toff(t, jB >> 3) + (jB & 7) * 2;
                const float kv = bf1(*(const LAS bf16_t*)(RAWk + eo)), av = bf1(*(const LAS bf16_t*)(RAWa + eo)), vv = bf1(*(const LAS bf16_t*)(RAWv + eo));
                const float lc = off + pw[p], lx = lc - wlv[p]; LC[t * LCS + jB] = lc;
                const float kkn = kv * kkwB * INV[t], kp = kv * (1.0f + (av - 1.0f) * kawB), em = __expf(-lc);
                const float xa = -kkn * __expf(lx), xb = kkn * av * em, xk = kp * em;
                if (p & 1) { oa[p >> 1] = pk2(pa, xa); ob[p >> 1] = pk2(pb, xb); ok[p >> 1] = pk2(pk, xk); ov[p >> 1] = pk2(pv, vv); } else { pa = xa; pb = xb; pk = xk; pv = vv; }
                if (t == 63) DCv[jB] = __expf(lc); }
            const int o = toff(jB, qB);
            *(LAS u32x4*)(AtT + o) = (u32x4){oa[0], oa[1], oa[2], oa[3]}; *(LAS u32x4*)(BtT + o) = (u32x4){ob[0], ob[1], ob[2], ob[3]}; *(LAS u32x4*)(KtT + o) = (u32x4){ok[0], ok[1], ok[2], ok[3]}; *(LAS u32x4*)(VT + o) = (u32x4){ov[0], ov[1], ov[2], ov[3]};
        }
        LBAR();
        {
            const f32x4 l0 = *(const LAS f32x4*)(LC + tA * LCS + 8 * jsA), l1 = *(const LAS f32x4*)(LC + tA * LCS + 8 * jsA + 4);
            const float inv = INV[tA];
            float xa[8], xr[8], xb[8], xk[8];
#pragma unroll
            for (int p = 0; p < 8; ++p) { const float lc = p < 4 ? l0[p & 3] : l1[p & 3]; const float em = __expf(-lc), ep = __expf(lc), kkn = kkA[p] * inv;
                xa[p] = -kkn * __expf(lc - wf[p]); xr[p] = rf[p] * ep; xb[p] = kkn * af[p] * em; xk[p] = kpA[p] * em; }
            const int o = toff(tA, jsA);
            *(LAS u32x4*)(AtM + o) = (u32x4){pk2(xa[0], xa[1]), pk2(xa[2], xa[3]), pk2(xa[4], xa[5]), pk2(xa[6], xa[7])};
            *(LAS u32x4*)(RtM + o) = (u32x4){pk2(xr[0], xr[1]), pk2(xr[2], xr[3]), pk2(xr[4], xr[5]), pk2(xr[6], xr[7])};
            *(LAS u32x4*)(BtM + o) = (u32x4){pk2(xb[0], xb[1]), pk2(xb[2], xb[3]), pk2(xb[4], xb[5]), pk2(xb[6], xb[7])};
            *(LAS u32x4*)(KtM + o) = (u32x4){pk2(xk[0], xk[1]), pk2(xk[2], xk[3]), pk2(xk[4], xk[5]), pk2(xk[6], xk[7])};
        }
        LBAR();
        float mcv[8]; McvDst mcd; const int mcid = (2 * c) * (256 * NWAVES) + unit * NWAVES + w; const bool mcon = mcid + 256 * NWAVES < MCV_ITEMS + 256 * NWAVES && mcid < MCV_ITEMS;
        if (mcon) mcd = mcv_load(A, F.ws, mcid, lane, mcv);
#pragma unroll 1
        for (int it = 0; it < 5; ++it) {
            const int n = w + 8 * it, X = n / 10, p = n % 10;
            const int tb = (p >= 6) ? 3 : (p >= 3) ? 2 : (p >= 1) ? 1 : 0, sb = p - (tb * (tb + 1)) / 2;
            lp Am = (X & 1) ? KtM : BtM; lp Bm = (X & 2) ? RtM : AtM; lp Om = L + A_RAW + X * TL;
            f32x4 acc = (f32x4){0.f, 0.f, 0.f, 0.f};
            acc = mm64(acc, Am, 16 * sb, Bm, 16 * tb, lane);
            if (sb == tb) { const int tin = lane & 15, s0 = 4 * (lane >> 4);
#pragma unroll
                for (int e = 0; e < 4; ++e) { const bool keep = (X & 2) ? (s0 + e <= tin) : (s0 + e < tin); if (!keep) acc[e] = 0.f; } }
            st_nat(Om, 16 * sb, 16 * tb, acc, lane);
        }
#pragma unroll 1
        for (int it = 0; it < 3; ++it) {
            const int n = w + 8 * it, X = n / 6, p = n % 6;
            const int tb = (p >= 5) ? 2 : (p >= 3) ? 1 : 0, sb = (tb == 0) ? p + 1 : (tb == 1) ? p - 1 : 3;
            st_nat(L + A_RAW + X * TL, 16 * sb, 16 * tb, (f32x4){0.f, 0.f, 0.f, 0.f}, lane);
        }
        LBAR();
        f32x4 rhs[4];
        if (w < 4) {
            if (lane < 16) {
                const int bb = w, r = lane; float Tr[16];
#pragma unroll
                for (int t = 0; t < 16; ++t) {
                    const u32x4 m0 = *(const LAS u32x4*)(MabT + toff(16 * bb + t, 2 * bb)), m1 = *(const LAS u32x4*)(MabT + toff(16 * bb + t, 2 * bb + 1));
                    const unsigned mw[8] = {m0.x, m0.y, m0.z, m0.w, m1.x, m1.y, m1.z, m1.w};
                    float acc = (r == t) ? 1.f : 0.f;
#pragma unroll
                    for (int s2 = 0; s2 < 16; ++s2) if (s2 < t) acc += Tr[s2] * ((s2 & 1) ? bfhi(mw[s2 >> 1]) : bflo(mw[s2 >> 1]));
                    Tr[t] = acc;
                }
#pragma unroll
                for (int t2 = 0; t2 < 16; ++t2) *(LAS bf16_t*)(TB + bb * 512 + t2 * 32 + r * 2) = (bf16_t)f2bf(Tr[t2]);
            }
#pragma unroll
            for (int bb = 0; bb < 4; ++bb) rhs[bb] = ld_nat(AtT, 16 * bb, 16 * w, lane);
        } else {
#pragma unroll
            for (int bb = 0; bb < 4; ++bb) rhs[bb] = mm64((f32x4){0.f, 0.f, 0.f, 0.f}, MkaT, 16 * bb, VT, 16 * (w - 4), lane);
        }
        { lp Xw = (w < 4 ? XP : XQ) + (16 * (w & 3)) * 128; *(LAS u32x4*)(Xw + lane * 32) = (u32x4){0u, 0u, 0u, 0u}; *(LAS u32x4*)(Xw + lane * 32 + 16) = (u32x4){0u, 0u, 0u, 0u}; }
        LBAR();
        {
            lp Xt = (w < 4) ? XP : XQ; const int r0 = 16 * (w & 3); const int q = lane >> 4, rr = lane & 15;
#pragma unroll
            for (int bb = 0; bb < 4; ++bb) {
                f32x4 acc = rhs[bb];
                if (bb > 0) acc = mm64(acc, MabT, 16 * bb, Xt, r0, lane);
                st_nat(Xt, 16 * bb, r0, acc, lane);
                asm volatile("s_waitcnt lgkmcnt(0)" ::: "memory");
                bf16x8 ta = (bf16x8){0, 0, 0, 0, 0, 0, 0, 0}, xb = ta;
                if (q < 2) { ta = *(const LAS bf16x8*)(TB + bb * 512 + rr * 32 + q * 16); xb = ldfrag(Xt, r0 + rr, 2 * bb + q); }
                const f32x4 d2 = __builtin_amdgcn_mfma_f32_16x16x32_bf16(ta, xb, (f32x4){0.f, 0.f, 0.f, 0.f}, 0, 0, 0);
                st_nat(Xt, 16 * bb, r0, d2, lane);
                asm volatile("s_waitcnt lgkmcnt(0)" ::: "memory");
            }
        }
        LBAR();
        if (mcon) mcv_store(mcd, mcv);
        const bool mcon2 = mcid + 256 * NWAVES < MCV_ITEMS;
        if (mcon2) mcd = mcv_load(A, F.ws, mcid + 256 * NWAVES, lane, mcv);
#pragma unroll 2
        for (int it = 0; it < 4; ++it) {
            const int id = 4 * w + it, nb = (id >> 2) & 3, mb = id & 3;
            if (id < 16) { f32x4 acc = ld_nat(RtM, 16 * mb, 16 * nb, lane);
                acc = mm64(acc, XP, 16 * mb, NbrT, 16 * nb, lane); st_nat(ZT, 16 * mb, 16 * nb, acc, lane); }
            else { f32x4 acc = mm64((f32x4){0.f, 0.f, 0.f, 0.f}, XP, 16 * mb, BtT, 16 * nb, lane);
                const int jn = 16 * nb + (lane & 15), jm = 16 * mb + 4 * (lane >> 4); const float dc = DCv[jn];
#pragma unroll
                for (int e = 0; e < 4; ++e) acc[e] = (acc[e] + ((jm + e == jn) ? 1.f : 0.f)) * dc;
                st_nat(GcT, 16 * mb, 16 * nb, acc, lane); }
        }
        LBAR();
#pragma unroll 2
        for (int it = 0; it < 8; ++it) {
            const int kind = it & 3, ti = (it >> 2) * 8 + w, nb = ti >> 2, mb = ti & 3;
            if (kind == 0) { f32x4 acc = mm64((f32x4){0.f, 0.f, 0.f, 0.f}, XQ, 16 * mb, NbrT, 16 * nb, lane); acc = mm64(acc, VT, 16 * mb, NkrT, 16 * nb, lane); acc = mm64(acc, SL, 16 * mb, ZT, 16 * nb, lane);
                st_nat(YT, 16 * mb, 16 * nb, acc, lane); }
            else if (kind == 1) { f32x4 acc = mm64((f32x4){0.f, 0.f, 0.f, 0.f}, BtT, 16 * mb, XQ, 16 * nb, lane); acc = mm64(acc, KtT, 16 * mb, VT, 16 * nb, lane);
                const f32x4 dc = *(const LAS f32x4*)(DCv + 16 * mb + 4 * (lane >> 4)); acc = acc * dc;
                acc = mm64(acc, GcT, 16 * mb, SL, 16 * nb, lane); st_nat(TS, 16 * mb, 16 * nb, acc, lane); }
            else if (kind == 2) { const f32x4 acc = mm64((f32x4){0.f, 0.f, 0.f, 0.f}, SG, 16 * mb, ZT, 16 * nb, lane); st_nat(ZC, 16 * mb, 16 * nb, acc, lane); }
            else { const f32x4 acc = mm64((f32x4){0.f, 0.f, 0.f, 0.f}, GcT, 16 * mb, SG, 16 * nb, lane); st_nat(TG, 16 * mb, 16 * nb, acc, lane); }
        }
        LBAR();
        {
            const int o = toff(tA, jsA);
            const u32x4 y16 = *(const LAS u32x4*)(YT + o), z16 = *(const LAS u32x4*)(ZC + o);
            const u32x4 g16 = *(const LAS u32x4*)(TG + tid * 16), s16 = *(const LAS u32x4*)(TS + tid * 16);
            const size_t go = rowbase + (size_t)c * 64 * D;
            *(u32x4*)(gYL + go) = y16; *(u32x4*)(gZC + go) = z16;
            if (jsA == 0) gBS[(trow0 + (size_t)c * 64 + tA) * NH + h] = BSC[tA];
            *(LAS u32x4*)(SG + tid * 16) = g16; *(LAS u32x4*)(SL + tid * 16) = s16;
            if (c + 1 < NCHQ) { *(LAS u32x4*)(AtM + o) = nw; *(LAS u32x4*)(RtM + o) = na; }
        }
        if (mcon2) mcv_store(mcd, mcv);
        LBAR();
    }
    { u32x4* seg = (u32x4*)(F.ws + WS_SEG) + (size_t)unit * 1024; seg[tid] = *(const LAS u32x4*)(SG + tid * 16); seg[512 + tid] = *(const LAS u32x4*)(SL + tid * 16); }
}
__device__ __forceinline__ void phase_scanB(Frame& F, const Args& A) {
    using namespace sm;
    const int unit = F.vcu, bh = unit >> 2, qq = unit & 3, b = bh / NH, h = bh % NH;
    const int tid = F.tid, lane = F.lane, w = F.wave;
    const int tA = tid >> 3, jsA = tid & 7;
    lp L = F.lds;
    LAS float* Sf = (LAS float*)L;
    LAS float* Gf = Sf + 64 * 65;
    lp SS = L + 40960, YLt = SS + TL, ZCt = YLt + TL; LAS float* LCy = (LAS float*)(ZCt + TL);
    LAS float* PRM = LCy + 64 * LCS;
    if (tid < 64) { const int ch = h * HS + tid; PRM[tid] = A.in[I_LNG][ch]; PRM[64 + tid] = A.in[I_LNB][ch]; }
    lp LgT = L + 90112, W2T = LgT + 3 * TL; LAS float* Gy = (LAS float*)(W2T + 3 * TL);
    { const bf16_t* W2 = (const bf16_t*)(F.ws + WS_WL2) + (size_t)(2 * D + h * HS + tA) * 256 + 8 * jsA;
#pragma unroll
      for (int i = 0; i < 3; ++i) *(LAS u32x4*)(W2T + i * TL + toff(tA, jsA)) = *(const u32x4*)(W2 + 64 * i); }
    const bf16_t* gL = (const bf16_t*)A.out;
    const int ci = tid >> 3, cj0 = (tid & 7) * 8;
    float sv[8];
#pragma unroll
    for (int p = 0; p < 8; ++p) sv[p] = 0.f;
    for (int q2 = 0; q2 < qq; ++q2) {
        const unsigned char* seg = (const unsigned char*)(F.ws + WS_SEG) + (size_t)(bh * 4 + q2) * 16384;
        const u32x4 g16 = *(const u32x4*)(seg + toff(ci, cj0 >> 3)), h16 = *(const u32x4*)(seg + 8192 + toff(ci, cj0 >> 3));
#pragma unroll
        for (int p = 0; p < 8; ++p) Sf[ci * 65 + cj0 + p] = sv[p];
        { const unsigned gw[4] = {g16.x, g16.y, g16.z, g16.w};
#pragma unroll
          for (int p = 0; p < 4; ++p) { Gf[ci * 64 + cj0 + 2 * p] = bflo(gw[p]); Gf[ci * 64 + cj0 + 2 * p + 1] = bfhi(gw[p]); } }
        LBAR();
        const unsigned hw[4] = {h16.x, h16.y, h16.z, h16.w};
        float o[8] = {bflo(hw[0]), bfhi(hw[0]), bflo(hw[1]), bfhi(hw[1]), bflo(hw[2]), bfhi(hw[2]), bflo(hw[3]), bfhi(hw[3])};
#pragma unroll 8
        for (int k = 0; k < 64; ++k) { const float sk = Sf[ci * 65 + k]; const f32x4 g0 = *(const LAS f32x4*)(Gf + k * 64 + cj0), g1 = *(const LAS f32x4*)(Gf + k * 64 + cj0 + 4);
            o[0] += sk * g0[0]; o[1] += sk * g0[1]; o[2] += sk * g0[2]; o[3] += sk * g0[3]; o[4] += sk * g1[0]; o[5] += sk * g1[1]; o[6] += sk * g1[2]; o[7] += sk * g1[3]; }
#pragma unroll
        for (int p = 0; p < 8; ++p) sv[p] = o[p];
        LBAR();
    }
    *(LAS u32x4*)(SS + toff(ci, cj0 >> 3)) = (u32x4){pk2(sv[0], sv[1]), pk2(sv[2], sv[3]), pk2(sv[4], sv[5]), pk2(sv[6], sv[7])};
    const bf16_t* gYL = (const bf16_t*)(F.ws + WS_R); const bf16_t* gZC = (const bf16_t*)(F.ws + WS_K); const bf16_t* gV = (const bf16_t*)(F.ws + WS_V); const bf16_t* gG = (const bf16_t*)(F.ws + WS_GG);
    const float* gBS = (const float*)(F.ws + WS_BSC); bf16_t* gO = (bf16_t*)(F.ws + WS_R);
    const size_t trow0 = (size_t)b * SEQ + (size_t)qq * SEQQ;
    const size_t rowbase = (trow0 + tA) * D + h * HS + jsA * 8;
    u32x4 ny = *(const u32x4*)(gYL + rowbase), nz = *(const u32x4*)(gZC + rowbase), nv = *(const u32x4*)(gV + rowbase), ng0, ng1, ng2; float nbs = gBS[(trow0 + tA) * NH + h];
    const size_t lbase = (trow0 + tA) * LACT_LD + 128 + jsA * 8;
    ng0 = *(const u32x4*)(gL + lbase); ng1 = *(const u32x4*)(gL + lbase + 64); ng2 = *(const u32x4*)(gL + lbase + 128);
    LBAR();
#pragma unroll 1
    for (int c = 0; c < NCHQ; ++c) {
        const u32x4 cy = ny, cz = nz, cv = nv; const float bs = nbs;
        { const int o = toff(tA, jsA); *(LAS u32x4*)(YLt + o) = cy; *(LAS u32x4*)(ZCt + o) = cz; *(LAS u32x4*)(LgT + o) = ng0; *(LAS u32x4*)(LgT + TL + o) = ng1; *(LAS u32x4*)(LgT + 2 * TL + o) = ng2; }
        if (c + 1 < NCHQ) { const size_t o = rowbase + (size_t)(c + 1) * 64 * D; ny = *(const u32x4*)(gYL + o); nz = *(const u32x4*)(gZC + o); nv = *(const u32x4*)(gV + o); nbs = gBS[(trow0 + (size_t)(c + 1) * 64 + tA) * NH + h];
            const size_t lo = lbase + (size_t)(c + 1) * 64 * LACT_LD; ng0 = *(const u32x4*)(gL + lo); ng1 = *(const u32x4*)(gL + lo + 64); ng2 = *(const u32x4*)(gL + lo + 128); }
        LBAR();
#pragma unroll
        for (int it = 0; it < 2; ++it) { const int mb = w & 3, nb = 2 * (w >> 2) + it;
            f32x4 acc = ld_nat(YLt, 16 * mb, 16 * nb, lane); acc = mm64(acc, SS, 16 * mb, ZCt, 16 * nb, lane);
            *(LAS f32x4*)(LCy + (16 * nb + (lane & 15)) * LCS + 16 * mb + 4 * (lane >> 4)) = acc;
            f32x4 ga = (f32x4){0.f, 0.f, 0.f, 0.f};
#pragma unroll
            for (int i = 0; i < 3; ++i) ga = mm64(ga, W2T + i * TL, 16 * mb, LgT + i * TL, 16 * nb, lane);
            *(LAS f32x4*)(Gy + (16 * nb + (lane & 15)) * LCS + 16 * mb + 4 * (lane >> 4)) = ga; }
        LBAR();
        {
            const f32x4 y0 = *(const LAS f32x4*)(LCy + tA * LCS + 8 * jsA), y1 = *(const LAS f32x4*)(LCy + tA * LCS + 8 * jsA + 4);
            float yv[8] = {y0[0], y0[1], y0[2], y0[3], y1[0], y1[1], y1[2], y1[3]};
            float s1 = 0.f;
#pragma unroll
            for (int p = 0; p < 8; ++p) s1 += yv[p];
            const float mean = red8(s1) * (1.0f / 64.0f); float s2 = 0.f;
#pragma unroll
            for (int p = 0; p < 8; ++p) { yv[p] -= mean; s2 += yv[p] * yv[p]; }
            const float rstd = rsqrtf(red8(s2) * (1.0f / 64.0f) + LNX_EPS);
            const f32x4 g0 = *(const LAS f32x4*)(PRM + 8 * jsA), g1 = *(const LAS f32x4*)(PRM + 8 * jsA + 4), b0 = *(const LAS f32x4*)(PRM + 64 + 8 * jsA), b1 = *(const LAS f32x4*)(PRM + 64 + 8 * jsA + 4);
            const unsigned vw[4] = {cv.x, cv.y, cv.z, cv.w};
            const f32x4 gq0 = *(const LAS f32x4*)(Gy + tA * LCS + 8 * jsA), gq1 = *(const LAS f32x4*)(Gy + tA * LCS + 8 * jsA + 4);
            float ov[8];
#pragma unroll
            for (int p = 0; p < 8; ++p) { const float lg = p < 4 ? g0[p & 3] : g1[p & 3], lb = p < 4 ? b0[p & 3] : b1[p & 3];
                const float vv = (p & 1) ? bfhi(vw[p >> 1]) : bflo(vw[p >> 1]), gg = p < 4 ? gq0[p & 3] : gq1[p & 3];
                ov[p] = (yv[p] * rstd * lg + lb + bs * vv) * gg; }
            *(u32x4*)(gO + rowbase + (size_t)c * 64 * D) = (u32x4){pk2(ov[0], ov[1]), pk2(ov[2], ov[3]), pk2(ov[4], ov[5]), pk2(ov[6], ov[7])};
        }
    }
}

__device__ __forceinline__ void phase_post3(Frame& F, const Args& A, const RowP& P) {
    LAS float* rt = (LAS float*)F.lds;
    LAS int* sel = (LAS int*)(F.lds + 32768);
    LAS int* cnts = (LAS int*)(F.lds + 32768 + 1024);
    LAS int* bef = (LAS int*)(F.lds + 32768 + 2048);
    for (int i = F.tid; i < D * NE / 4; i += NTHREADS) ((LAS f32x4*)rt)[i] = ((const f32x4*)A.in[I_ROUTER])[i];
    __syncthreads();
    int* toke = (int*)(F.ws + WS_TOKE); float* tokw = (float*)(F.ws + WS_TOKW); int* tokli = (int*)(F.ws + WS_TOKLI); int* cnt = (int*)(F.ws + WS_CNT);
    const int wgi = blockIdx.x;
    RowIn cur, nxt; row_load(P, wgi * 128 + F.wave * 16, F.lane, cur);
    for (int s = 0; s < 16; ++s) {
        const int tl = F.wave * 16 + s, t = wgi * 128 + tl;
        if (s + 1 < 16) row_load(P, t + 1, F.lane, nxt);
        f32x4 hv[4]; row_compute(P, t, F.lane, cur, hv, true); cur = nxt;
        float lg[8];
#pragma unroll
        for (int e = 0; e < 8; ++e) lg[e] = 0.f;
#pragma unroll
        for (int j = 0; j < 4; ++j)
#pragma unroll
            for (int q = 0; q < 4; ++q) { const int c = 4 * F.lane + 256 * j + q; const f32x4 r0 = *(const LAS f32x4*)(rt + c * 8), r1 = *(const LAS f32x4*)(rt + c * 8 + 4); const float hvv = hv[j][q];
                lg[0] += hvv * r0[0]; lg[1] += hvv * r0[1]; lg[2] += hvv * r0[2]; lg[3] += hvv * r0[3]; lg[4] += hvv * r1[0]; lg[5] += hvv * r1[1]; lg[6] += hvv * r1[2]; lg[7] += hvv * r1[3]; }
        {
            const bool h5 = F.lane & 32, h4 = F.lane & 16, h3 = F.lane & 8;
            float a4[4];
#pragma unroll
            for (int i = 0; i < 4; ++i) { const float mine = h5 ? lg[i + 4] : lg[i], send = h5 ? lg[i] : lg[i + 4]; a4[i] = mine + __shfl_xor(send, 32); }
            float a2[2];
#pragma unroll
            for (int i = 0; i < 2; ++i) { const float mine = h4 ? a4[i + 2] : a4[i], send = h4 ? a4[i] : a4[i + 2]; a2[i] = mine + __shfl_xor(send, 16); }
            float a1 = (h3 ? a2[1] : a2[0]) + __shfl_xor(h3 ? a2[0] : a2[1], 8);
            a1 += __shfl_xor(a1, 1); a1 += __shfl_xor(a1, 2); a1 += __shfl_xor(a1, 4);
#pragma unroll
            for (int e = 0; e < 8; ++e) lg[e] = __builtin_bit_cast(float, __builtin_amdgcn_readlane(__builtin_bit_cast(int, a1), e * 8));
        }
        int e0 = 0; float m0 = lg[0];
#pragma unroll
        for (int e = 1; e < 8; ++e) if (lg[e] > m0) { m0 = lg[e]; e0 = e; }
        int e1 = -1; float m1 = -3.0e38f;
#pragma unroll
        for (int e = 0; e < 8; ++e) if (e != e0 && lg[e] > m1) { m1 = lg[e]; e1 = e; }
        const float w1 = 1.0f / (1.0f + __expf(m0 - m1)), w0 = 1.0f - w1;
        if (F.lane == 0) { toke[2 * t] = e0; toke[2 * t + 1] = e1; tokw[2 * t] = w0; tokw[2 * t + 1] = w1; sel[2 * tl] = e0; sel[2 * tl + 1] = e1; }
    }
    __syncthreads();
    if (F.tid < 256) {
        const int e = sel[F.tid];
        int before = 0;
#pragma unroll
        for (int q = 0; q < 8; ++q) { const unsigned long long mk = __ballot(e == q); if (e == q) before = __popcll(mk & ((1ull << F.lane) - 1ull)); if (F.lane == 0) cnts[F.wave * 8 + q] = __popcll(mk); }
        bef[F.tid] = before;
    }
    __syncthreads();
    if (F.tid < 256) {
        const int p = F.tid, tl = p >> 1, t = wgi * 128 + tl; const int e = sel[p];
        int base = 0; for (int w = 0; w < F.wave; ++w) base += cnts[w * 8 + e];
        tokli[2 * t + (p & 1)] = base + bef[p];
    }
    if (F.tid < 8) cnt[wgi * 8 + F.tid] = cnts[F.tid] + cnts[8 + F.tid] + cnts[16 + F.tid] + cnts[24 + F.tid];
}
__device__ __forceinline__ void phase_route(Frame& F) {
    LAS int* tot = (LAS int*)F.lds;
    const int* cnt = (const int*)(F.ws + WS_CNT); const int wgi = blockIdx.x;
    { const int e = F.wave; int s = 0, pre = 0;
      for (int v = F.lane; v < 256; v += 64) { const int c = cnt[v * 8 + e]; s += c; if (v < wgi) pre += c; }
      s = (int)wave_sum((float)s); pre = (int)wave_sum((float)pre);
      if (F.lane == 0) { tot[e] = s; tot[8 + e] = pre; } }
    __syncthreads();
    if (F.tid == 0) { int st = 0; for (int e = 0; e < 8; ++e) { tot[16 + e] = st; st += ((tot[e] + 255) >> 8) << 8; } tot[24] = st; }
    __syncthreads();
    const int* toke = (const int*)(F.ws + WS_TOKE); const int* tokli = (const int*)(F.ws + WS_TOKLI); int* tokslot = (int*)(F.ws + WS_TOKSLOT); int* rowidx = (int*)(F.ws + WS_ROWIDX); int* tilee = (int*)(F.ws + WS_TILEE);
    if (F.tid < 256) { const int p = F.tid, t = wgi * 128 + (p >> 1), e = toke[2 * t + (p & 1)]; const int slot = tot[16 + e] + tot[8 + e] + tokli[2 * t + (p & 1)];
        tokslot[2 * t + (p & 1)] = slot; rowidx[slot] = t; }
    if (wgi < 8) { const int e = wgi; const int s0 = tot[16 + e] + tot[e], s1 = tot[16 + e] + (((tot[e] + 255) >> 8) << 8); for (int s = s0 + F.tid; s < s1; s += NTHREADS) rowidx[s] = 0; }
    if (wgi == 8) { const int nt = tot[24] >> 8; for (int i = F.tid; i < nt; i += NTHREADS) { int e = 0; for (int q = 1; q < 8; ++q) if (i * 256 >= tot[16 + q]) e = q; tilee[i] = e; }
        if (F.tid == 0) ((unsigned*)(F.ws + WS_CTL))[CW_MOE_NM] = (unsigned)nt; }
}
struct FinIn { u32x2 xw[4]; u32x2 a[4]; u32x2 c[4]; };
__device__ __forceinline__ void fin_load(FinIn& in, const float* out, const bf16_t* Y2, int t, int s0, int s1, int lane) {
    const GAS u32x2* xb = (const GAS u32x2*)((const bf16_t*)out + (size_t)t * 2048 + 1024) + lane;
    const GAS u32x2* y0 = (const GAS u32x2*)(Y2 + (size_t)s0 * D) + lane; const GAS u32x2* y1 = (const GAS u32x2*)(Y2 + (size_t)s1 * D) + lane;
#pragma unroll
    for (int j = 0; j < 4; ++j) in.xw[j] = xb[64 * j];
#pragma unroll
    for (int j = 0; j < 4; ++j) { in.a[j] = y0[64 * j]; in.c[j] = y1[64 * j]; }
}
__device__ __forceinline__ void phase_final(Frame& F, float* out, const float* gate, const float* gpost) {
    const int gw = F.vcu * NWAVES + F.wave, NGW = F.G * NWAVES; const int lane = F.lane;
    const int* tokslot = (const int*)(F.ws + WS_TOKSLOT); const float* tokw = (const float*)(F.ws + WS_TOKW); const bf16_t* Y2 = (const bf16_t*)(F.ws + WS_Y2);
    int t = gw; if (t >= T) return;
    FinIn cur, nxt;
    float w0 = tokw[2 * t], w1 = tokw[2 * t + 1];
    fin_load(cur, out, Y2, t, tokslot[2 * t], tokslot[2 * t + 1], lane);
    int tn = t + NGW;
    int s0n = 0, s1n = 0; float w0n = 0.f, w1n = 0.f;
    if (tn < T) { s0n = tokslot[2 * tn]; s1n = tokslot[2 * tn + 1]; w0n = tokw[2 * tn]; w1n = tokw[2 * tn + 1]; }
#pragma unroll 1
    for (; t < T; t = tn, tn += NGW) {
        int s0f = 0, s1f = 0; float w0f = 0.f, w1f = 0.f;
        if (tn < T) fin_load(nxt, out, Y2, tn, s0n, s1n, lane);
        { const int tf = tn + NGW; if (tf < T) { s0f = tokslot[2 * tf]; s1f = tokslot[2 * tf + 1]; w0f = tokw[2 * tf]; w1f = tokw[2 * tf + 1]; } }
        const int b = t / SEQ;
        f32x4 yv[4]; float ss = 0.f;
#pragma unroll
        for (int j = 0; j < 4; ++j) { const u32x2 a = cur.a[j], c = cur.c[j];
            yv[j] = (f32x4){w0 * bflo(a.x) + w1 * bflo(c.x), w0 * bfhi(a.x) + w1 * bfhi(c.x), w0 * bflo(a.y) + w1 * bflo(c.y), w0 * bfhi(a.y) + w1 * bfhi(c.y)};
            ss += (yv[j].x * yv[j].x + yv[j].y * yv[j].y) + (yv[j].z * yv[j].z + yv[j].w * yv[j].w); }
        const float rs = rsqrtf(wave_sum(ss) * (1.0f / D) + RMS_EPS);
        GAS f32x4* xo = (GAS f32x4*)(out + (size_t)t * D) + lane;
        asm volatile("" :: "v"(cur.xw[0].x), "v"(cur.xw[0].y), "v"(cur.xw[1].x), "v"(cur.xw[1].y), "v"(cur.xw[2].x), "v"(cur.xw[2].y), "v"(cur.xw[3].x), "v"(cur.xw[3].y) : "memory");
#pragma unroll
        for (int j = 0; j < 4; ++j) { const f32x4 gt = *((const f32x4*)(gate + (size_t)b * 6144) + lane + 64 * j); const f32x4 gp = *((const f32x4*)gpost + lane + 64 * j);
            const f32x4 xv = (f32x4){bflo(cur.xw[j].x), bfhi(cur.xw[j].x), bflo(cur.xw[j].y), bfhi(cur.xw[j].y)};
            xo[64 * j] = xv + gt * gp * yv[j] * rs; }
        cur = nxt; w0 = w0n; w1 = w1n; s0n = s0f; s1n = s1f; w0n = w0f; w1n = w1f;
    }
}
__device__ __forceinline__ void zero_h2_rows(Frame& F) {
    bf16_t* H2 = (bf16_t*)(F.ws + WS_H2);
    if (F.vcu < BATCH && F.tid < 128) ((u32x4*)(H2 + (size_t)F.vcu * (SEQ + 1) * D))[F.tid] = (u32x4){0u, 0u, 0u, 0u};
}

__device__ __forceinline__ bool launder(Frame& F) { int t = F.tid; asm volatile("" : "+v"(t)); F.tid = t; F.lane = t & 63; return true; }
constexpr int NPHASE = 22;
__device__ __forceinline__ pg8::GemmDesc mkdesc(const bf16_t* A, int lda, const bf16_t* Bt, int K, int nM, int nN, int mode, bf16_t* o0, int ldc) {
    pg8::GemmDesc g; g.A = A; g.Bt = Bt; g.lda = lda; g.K = K; g.nM = nM; g.nN = nN; g.a_bt = 0; g.a_bx = 0; g.a_pn_split = 1 << 30; g.a_pn_coloff = 0; g.a_pn_div = 1 << 30; g.a_pn_stride = 0; g.pn_bias = 0; g.rowidx = nullptr; g.tile_e = nullptr; g.b_estride = 0;
    g.mode = mode; g.o0 = o0; g.o1 = nullptr; g.o2 = nullptr; g.ldc = ldc; g.p0 = nullptr; g.p1 = nullptr; g.flag = 0; return g;
}

__global__ void __launch_bounds__(NTHREADS, 2) fwd_kernel(Args args) {
    extern __shared__ __attribute__((aligned(16))) unsigned char lds_raw[];
    Frame F;
    F.lds = (LAS unsigned char*)lds_raw;
    F.tid = threadIdx.x; F.lane = F.tid & 63; F.wave = __builtin_amdgcn_readfirstlane(F.tid >> 6);
    F.G = gridDim.x; { const int bx = blockIdx.x; F.vcu = (F.G % 8 == 0) ? (bx % 8) * (F.G / 8) + bx / 8 : bx; }
    F.ws = args.ws;
    volatile LAS unsigned* MISC = (volatile LAS unsigned*)(F.lds + MISC_OFF);
    if (F.tid < 16) MISC[F.tid] = 0u;
    __syncthreads();
    unsigned* ctl = (unsigned*)(F.ws + WS_CTL);
    XcdBarrier bar; bar.bar = ctl + CW_BAR; bar.x = 0; bar.st = nullptr;
#if N_LAUNCH_MODE == 0
    bar = xcd_barrier_post(ctl + CW_BAR, MISC + 8);
#endif
    unsigned char* ws = F.ws;
    const float* mod = (const float*)(ws + WS_MOD);
    const float* ng = args.in[I_NORMG];
    const int lo = args.ph_lo, hi = args.ph_hi;
    const int cid = (int)blockIdx.x;
#define MODP(l, ch) (mod + (size_t)(l) * 4 * 6144 + (ch) * D)
    bf16_t* H = (bf16_t*)(ws + WS_H);

#define PHASE(k) if (lo <= (k) && (k) < hi && launder(F))
#define INP(k) (lo <= (k) && (k) < hi)
#define SEAM(k) do { if (INP(k) && INP((k) + 1)) xcd_barrier(bar); } while (0)
#define GEMM(GATH, g) pg8::gemm_phase<GATH>(F.lds, g, F.G, cid, F.tid)
    PHASE(0) { phase_prologue(F, args); } SEAM(0);
    PHASE(1) { RowP P{args.in[I_X], nullptr, nullptr, nullptr, nullptr, ng + 0 * D, MODP(0, 1), MODP(0, 0), H, 0, nullptr, 0, 0}; phase_rows(F, P); } SEAM(1);
    PHASE(2) { pg8::GemmDesc g = mkdesc(H, D, (const bf16_t*)(ws + WS_WIN), D, T / 256, MIXIN / 256, pg8::EM_MIXIN, (bf16_t*)(ws + WS_Z), ZLD); GEMM(false, g); } SEAM(2);
    PHASE(3) { phase_mix(F, args); } SEAM(3);
    PHASE(4) { pg8::GemmDesc g = mkdesc((const bf16_t*)(ws + WS_A2), D, (const bf16_t*)(ws + WS_WOUTE), D, T / 256, D / 256, pg8::EM_BF16, (bf16_t*)(ws + WS_Y0), D); GEMM(false, g); } SEAM(4);
    PHASE(5) { RowP P{args.in[I_X], args.out, (const bf16_t*)(ws + WS_Y0), MODP(0, 2), ng + 1 * D, ng + 2 * D, MODP(0, 4), MODP(0, 3), H, 0, (float*)(ws + WS_XH), 0, 1}; phase_rows(F, P); } SEAM(5);
    PHASE(6) { pg8::GemmDesc g = mkdesc(H, D, (const bf16_t*)(ws + WS_WFGU), D, T / 256, 2 * FF / 256, pg8::EM_SWIGLU, (bf16_t*)(ws + WS_HFF), FF); GEMM(false, g); } SEAM(6);
    PHASE(7) { pg8::GemmDesc g = mkdesc((const bf16_t*)(ws + WS_HFF), FF, (const bf16_t*)(ws + WS_WFD), FF, T / 256, D / 256, pg8::EM_BF16, (bf16_t*)(ws + WS_Y0), D); GEMM(false, g); } SEAM(7);
    PHASE(8) { RowP P{args.out, args.out, (const bf16_t*)(ws + WS_Y0), MODP(0, 5), ng + 3 * D, ng + 4 * D, MODP(1, 1), MODP(1, 0), (bf16_t*)(ws + WS_H2), 1, nullptr, 1, 1}; phase_post2(F, args, P); zero_h2_rows(F); } SEAM(8);
    PHASE(9) {
        { pg8::GemmDesc g = mkdesc((const bf16_t*)(ws + WS_XR), D, (const bf16_t*)(ws + WS_WRKV), D, T / 256, 12, pg8::EM_RKVL, (bf16_t*)(ws + WS_R), D);
          g.a_pn_div = 4; g.a_pn_stride = (long)T * D; GEMM(false, g); }
        { pg8::GemmDesc g = mkdesc((const bf16_t*)(ws + WS_H2), D, (const bf16_t*)(ws + WS_WLOR), 2 * D, T / 256, 2, pg8::EM_RKVL, (bf16_t*)(ws + WS_R), D);
          g.a_bt = SEQ / 256; g.a_bx = 1; g.o1 = (bf16_t*)args.out; g.pn_bias = 12; GEMM(false, g); } } SEAM(9);
    PHASE(11) { phase_scanA(F, args); } SEAM(11);
    PHASE(12) { phase_scanB(F, args); } SEAM(12);
    PHASE(14) { pg8::GemmDesc g = mkdesc((const bf16_t*)(ws + WS_R), D, (const bf16_t*)(ws + WS_WO), D, T / 256, D / 256, pg8::EM_BF16, (bf16_t*)(ws + WS_Y1), D); GEMM(false, g);
        } SEAM(14);
    PHASE(15) { RowP P{args.out, args.out, (const bf16_t*)(ws + WS_Y1), MODP(1, 2), ng + 5 * D, ng + 6 * D, MODP(1, 4), MODP(1, 3), (bf16_t*)(ws + WS_H3), 0, nullptr, 1, 1}; phase_post3(F, args, P); } SEAM(15);
    PHASE(16) { phase_route(F); } SEAM(16);
#define MOE1(p1) PHASE(p1) { const int moe_nm = (int)__hip_atomic_load(ctl + CW_MOE_NM, __ATOMIC_RELAXED, __HIP_MEMORY_SCOPE_AGENT); \
        pg8::GemmDesc g = mkdesc((const bf16_t*)(ws + WS_H3), D, (const bf16_t*)(ws + WS_WMGU), D, moe_nm, 2 * FH / 256, pg8::EM_SWIGLU, (bf16_t*)(ws + WS_HM), FH); \
        g.rowidx = (const int*)(ws + WS_ROWIDX); g.tile_e = (const int*)(ws + WS_TILEE); g.b_estride = (long)FF * D; GEMM(true, g); } SEAM(p1)
#define MOE2(p2, half) PHASE(p2) { const int moe_nm = (int)__hip_atomic_load(ctl + CW_MOE_NM, __ATOMIC_RELAXED, __HIP_MEMORY_SCOPE_AGENT); \
        pg8::GemmDesc g = mkdesc((const bf16_t*)(ws + WS_HM), FH, (const bf16_t*)(ws + (half ? WS_WMD1 : WS_WMD0)), FH, moe_nm, D / 256, pg8::EM_MOE2, (bf16_t*)(ws + WS_Y2), D); \
        g.tile_e = (const int*)(ws + WS_TILEE); g.b_estride = (long)D * FH; g.flag = half; GEMM(false, g); \
        if (half == 0) { __syncthreads();     \
            const int nbusy = (moe_nm * (D / 256)) % F.G; const bool excl = nbusy > 0 && nbusy <= 64; \
            if (!(excl && cid < nbusy)) moe_convert(F, args, 0, 1, (bf16_t*)(ws + WS_WMGU), excl ? cid - nbusy : F.vcu, excl ? F.G - nbusy : F.G); \
            __syncthreads(); } } SEAM(p2)
    MOE1(17); MOE2(18, 0); MOE1(19); MOE2(20, 1);
#undef MOE1
#undef MOE2
    PHASE(21) { phase_final(F, args.out, MODP(1, 5), ng + 7 * D); }
#undef PHASE
#undef INP
#undef SEAM
#undef GEMM
#undef MODP
}

extern "C" void kernel_launch(void* const* d_in, const int* in_sizes, int n_in, void* d_out, int out_size, void* d_ws, size_t ws_size, hipStream_t stream) {
    static int grid = 0;
    if (grid == 0) {
        if (n_in != 35 || in_sizes[0] != T * D || out_size != T * D || ws_size < WS_END) { fprintf(stderr, "kernel_launch: unexpected shapes: n_in %d in0 %d out %d ws %zu (need %zu)\n", n_in, n_in > 0 ? in_sizes[0] : -1, out_size, ws_size, (size_t)WS_END); grid = -1; return; }
        int dev = 0, cus = 0, per_cu = 0;
        if (hipGetDevice(&dev) != hipSuccess || hipDeviceGetAttribute(&cus, hipDeviceAttributeMultiprocessorCount, dev) != hipSuccess) { grid = -1; return; }
        if (hipFuncSetAttribute((const void*)fwd_kernel, hipFuncAttributeMaxDynamicSharedMemorySize, LDS_BYTES) != hipSuccess) { fprintf(stderr, "kernel_launch: hipFuncSetAttribute failed\n"); grid = -1; return; }
        if (hipOccupancyMaxActiveBlocksPerMultiprocessor(&per_cu, (const void*)fwd_kernel, NTHREADS, LDS_BYTES) != hipSuccess || per_cu < 1) fprintf(stderr, "kernel_launch: occupancy query reports %d\n", per_cu);
        (void)hipGetLastError();
        grid = cus;
        if (grid != 256) fprintf(stderr, "kernel_launch: %d CUs (built for 256)\n", grid);
    }
    if (grid < 0) return;
    (void)hipMemsetAsync((char*)d_ws + WS_CTL, 0, CTL_ZERO_BYTES, stream);
    Args a{};
    for (int i = 0; i < 35; ++i) a.in[i] = (const float*)d_in[i];
    a.out = (float*)d_out; a.ws = (unsigned char*)d_ws;
#if N_LAUNCH_MODE == 0
    a.ph_lo = 0; a.ph_hi = NPHASE;
    hipLaunchKernelGGL(fwd_kernel, dim3(grid), dim3(NTHREADS), LDS_BYTES, stream, a);
#else
    for (int p = 0; p < NPHASE; ++p) { a.ph_lo = p; a.ph_hi = p + 1; hipLaunchKernelGGL(fwd_kernel, dim3(grid), dim3(NTHREADS), LDS_BYTES, stream, a); }
#endif
}
```

```cpp
#include <hip/hip_runtime.h>
#include <cstdio>
#include <cstdint>

#ifndef N_LAUNCH_MODE
#define N_LAUNCH_MODE 0
#endif

#define LAS __attribute__((address_space(3)))
#define GAS __attribute__((address_space(1)))
typedef unsigned short bf16_t;
typedef short bf16x8 __attribute__((ext_vector_type(8)));
typedef float f32x4 __attribute__((ext_vector_type(4)));
typedef float f32x2 __attribute__((ext_vector_type(2)));
typedef unsigned u32x4 __attribute__((ext_vector_type(4)));
typedef unsigned u32x2 __attribute__((ext_vector_type(2)));

constexpr int D = 1024, BATCH = 4, SEQ = 8192, T = BATCH * SEQ, FF = 2816, FH = FF / 2, NE = 8, NH = 16, HS = 64;
constexpr int MIXIN = 2048, DCONV = 512, DPOOL = 512;
constexpr int ZLD = 1536;
constexpr float RMS_EPS = 1e-6f, LNX_EPS = 64e-5f;
constexpr int NWAVES = 8, NTHREADS = 512;
constexpr int MOE_MAXROWS = 2 * T + NE * 256;
constexpr int H2ROWS = BATCH * (SEQ + 1);

constexpr size_t MiB = 1u << 20;
constexpr size_t WS_CTL = 0, CTL_ZERO_BYTES = 256 * 1024;
constexpr size_t WS_MOD = 1 * MiB;
constexpr size_t WS_TOKE = 2 * MiB;
constexpr size_t WS_TOKW = WS_TOKE + (size_t)T * 8;
constexpr size_t WS_TOKLI = WS_TOKW + (size_t)T * 8;
constexpr size_t WS_TOKSLOT = WS_TOKLI + (size_t)T * 8;
constexpr size_t WS_CNT = WS_TOKSLOT + (size_t)T * 8;
constexpr size_t WS_ROWIDX = WS_CNT + 8192;
constexpr size_t WS_TILEE = WS_ROWIDX + (size_t)MOE_MAXROWS * 4;
static_assert(WS_TILEE + 4096 <= 4 * MiB, "route tables");
constexpr size_t WS_WIN = 4 * MiB, WS_WOUTE = 8 * MiB, WS_WFGU = 10 * MiB, WS_WFD = 21 * MiB, WS_WRKV = 26 * MiB + 512 * 1024, WS_WLOR = 32 * MiB + 512 * 1024, WS_WL2 = 504 * MiB, WS_WO = 493 * MiB;
constexpr size_t WS_WMGU = 4 * MiB, WS_WMD0 = 48 * MiB, WS_WMD1 = 70 * MiB;
constexpr size_t WS_H = 44 * MiB, WS_Z = 172 * MiB, WS_A2 = 300 * MiB, WS_HFF = 172 * MiB, WS_Y0 = 364 * MiB;
constexpr size_t WS_H2 = 44 * MiB, WS_XR = 109 * MiB, WS_XK = 173 * MiB, WS_XV = 237 * MiB, WS_R = 301 * MiB, WS_K = 365 * MiB, WS_V = 429 * MiB, WS_LACT = 4 * MiB, WS_WLOG = 109 * MiB, WS_AA = 173 * MiB, WS_GG = 237 * MiB, WS_Y1 = 173 * MiB;
constexpr size_t WS_XH = 495 * MiB;
constexpr int LACT_LD = 2048, LACT_W = 384;
constexpr size_t WS_BSC = 495 * MiB, WS_SEG = 497 * MiB;
constexpr size_t WS_H3 = 446 * MiB, WS_HM = 264 * MiB, WS_Y2 = 132 * MiB, WS_END = 510 * MiB;
static_assert(WS_H2 + (size_t)H2ROWS * D * 2 <= WS_XR, "h2");
static_assert(WS_HM + (size_t)MOE_MAXROWS * FH * 2 <= WS_H3, "hm");
static_assert(WS_Y2 + (size_t)MOE_MAXROWS * D * 2 <= WS_HM, "y2");
constexpr int CW_MOE_NM = 64;
constexpr int CW_BAR = 4096;

__device__ __forceinline__ unsigned f2bf(float f) { unsigned u = __builtin_bit_cast(unsigned, f); return (u + 0x7fffu + ((u >> 16) & 1u)) >> 16; }
typedef __bf16 bf16x2_hw __attribute__((ext_vector_type(2)));
typedef float f32x2_hw __attribute__((ext_vector_type(2)));
__device__ __forceinline__ unsigned pk2(float lo, float hi) { f32x2_hw v = {lo, hi}; return __builtin_bit_cast(unsigned, __builtin_convertvector(v, bf16x2_hw)); }
__device__ __forceinline__ float bflo(unsigned w) { return __builtin_bit_cast(float, w << 16); }
__device__ __forceinline__ float bfhi(unsigned w) { return __builtin_bit_cast(float, w & 0xffff0000u); }
__device__ __forceinline__ float bf1(bf16_t b) { return __builtin_bit_cast(float, (unsigned)b << 16); }
template <int CTRL> __device__ __forceinline__ float dppf(float v) { return __builtin_bit_cast(float, __builtin_amdgcn_update_dpp(0, __builtin_bit_cast(int, v), CTRL, 0xF, 0xF, true)); }
__device__ __forceinline__ float sum8_dpp(float v) { v += dppf<0xB1>(v); v += dppf<0x4E>(v); v += dppf<0x141>(v); return v; }
__device__ __forceinline__ float wave_sum(float v) { v = sum8_dpp(v); v += dppf<0x140>(v); v += __shfl_xor(v, 16); v += __shfl_xor(v, 32); return v; }
__device__ __forceinline__ float sigmoidf_(float x) { return __builtin_amdgcn_rcpf(1.0f + __expf(-x)); }
__device__ __forceinline__ float siluf_(float x) { return x * __builtin_amdgcn_rcpf(1.0f + __expf(-x)); }
__device__ __forceinline__ float tanhf_(float x) { const float e = __expf(-2.0f * fabsf(x)); const float t = (1.0f - e) * __builtin_amdgcn_rcpf(1.0f + e); return x < 0.f ? -t : t; }
__device__ __forceinline__ float softplusf_(float z) { return fmaxf(z, 0.f) + log1pf(__expf(-fabsf(z))); }

namespace pg8 {
constexpr int BM = 256, BK = 64, HALF = 128, HTB = HALF * BK * 2, STAGE_BYTES = 8 * HTB, NXCD = 8, WGM = 8;
__host__ __device__ __forceinline__ int lds_byte(int r, int c) { const int st = (r >> 4) * 2 + (c >> 5), rr = r & 15, cc = c & 31, ob = rr * 64 + cc * 2; return st * 1024 + (ob ^ (((ob >> 9) & 1) << 5)); }
__host__ __device__ __forceinline__ void stage_rc(int b, int& R, int& C) { const int st = b / 1024, sb = b % 1024, swz = sb ^ (((sb >> 9) & 1) << 5); R = (st >> 1) * 16 + swz / 64; C = (st & 1) * 32 + (swz % 64) / 2; }
__host__ __device__ __forceinline__ int perm32(int rho) { const int n = rho >> 4, i = rho & 15; return 8 * (i >> 2) + 4 * n + (i & 3); }

struct Unit { int pm, pn; };
enum { EM_BF16 = 0, EM_SWIGLU = 1, EM_RKVL = 2, EM_LORA2 = 3, EM_MOE2 = 4, EM_MIXIN = 5 };
struct GemmDesc {
    const bf16_t* A; const bf16_t* Bt;
    int lda, K, nM, nN;
    int a_bt, a_bx;
    int a_pn_split, a_pn_coloff;
    int a_pn_div; long a_pn_stride;
    int pn_bias;
    const int* rowidx;
    const int* tile_e; long b_estride;
    int mode;
    bf16_t* o0; bf16_t* o1; bf16_t* o2; int ldc;
    const float* p0;
    const float* p1;
    int flag;
};
__device__ __forceinline__ size_t a_off_bytes(const GemmDesc& g, const Unit& u) {
    size_t rows = (size_t)u.pm * BM; if (g.a_bt) rows += (size_t)(u.pm / g.a_bt) * g.a_bx;
    size_t o = rows * (size_t)g.lda; if (u.pn >= g.a_pn_split) o += g.a_pn_coloff; o += (size_t)(u.pn / g.a_pn_div) * (size_t)g.a_pn_stride; return o * 2;
}
__device__ __forceinline__ size_t b_off_bytes(const GemmDesc& g, const Unit& u) {
    size_t o = (size_t)u.pn * BM * (size_t)g.K; if (g.tile_e) o += (size_t)__builtin_amdgcn_readfirstlane(g.tile_e[u.pm]) * (size_t)g.b_estride; return o * 2;
}
struct StaticOrder {
    int nM, nN, nwg, G, c;
    __device__ void init(int nM_, int nN_, int G_, int c_) { nM = nM_; nN = nN_; nwg = nM * nN; G = G_; c = c_; }
    __device__ bool next(int i, Unit& u) const {
        const long L = (long)i * G + c; if (L >= nwg) return false;
        int wgid = (int)L; { const int q = nwg / NXCD, r = nwg % NXCD, xcd = wgid % NXCD, off = wgid / NXCD; wgid = (xcd < r ? xcd * (q + 1) : r * (q + 1) + (xcd - r) * q) + off; }
        const int nig = WGM * nN, gid = wgid / nig, fm = gid * WGM, gsz = (nM - fm) < WGM ? (nM - fm) : WGM;
        u.pm = fm + ((wgid % nig) % gsz); u.pn = (wgid % nig) / gsz; return true;
    }
};
typedef __bf16 bf16x2_t_ __attribute__((ext_vector_type(2)));
__device__ __forceinline__ unsigned cvt_pk_bf16(float lo, float hi) { f32x2 v = {lo, hi}; bf16x2_t_ b = __builtin_convertvector(v, bf16x2_t_); return __builtin_bit_cast(unsigned, b); }

__device__ __forceinline__ unsigned dpp_x8(unsigned x) { return (unsigned)__builtin_amdgcn_update_dpp(0, (int)x, 0x128, 0xF, 0xF, true); }
__device__ __forceinline__ float dpp_x8f(float x) { return __builtin_bit_cast(float, dpp_x8(__builtin_bit_cast(unsigned, x))); }
template <int ACT, int AI_LO, int AI_HI>
__device__ __forceinline__ void store_tiles(const f32x4 (&acc)[2][2][4][2], bf16_t* bq, int ldc, int colw, int fr, int fq, const float* bias, int climit = 1 << 30) {
    const bool lo = fr < 8;
    const int chA = lo ? fq : 4 + fq, chB = lo ? 4 + fq : fq;
    bf16_t* pA = bq + (size_t)(fr & 7) * ldc + chA * 8;
    bf16_t* pB = bq + (size_t)(8 + (fr & 7)) * ldc + chB * 8;
    const bool okA = (ACT != 1) || (colw + chA * 8 < climit), okB = (ACT != 1) || (colw + chB * 8 < climit);
    f32x4 bb[2][2];
    int cls[2];
#pragma unroll
    for (int bj = 0; bj < 2; ++bj) {
        const int col = colw + bj * 32 + 8 * fq;
        bb[bj][0] = (f32x4){0.f, 0.f, 0.f, 0.f}; bb[bj][1] = bb[bj][0];
        if (ACT >= 2) { bb[bj][0] = *(const f32x4*)(bias + col); bb[bj][1] = *(const f32x4*)(bias + col + 4); }
        cls[bj] = (ACT == 1) ? (col < 64 ? 0 : (col < 128 ? 1 : (col < 288 ? 2 : 3))) : 0;
    }
#pragma unroll
    for (int ai = AI_LO; ai < AI_HI; ++ai)
#pragma unroll
        for (int m = 0; m < 4; ++m) {
            u32x4 w[2];
#pragma unroll
            for (int bj = 0; bj < 2; ++bj) {
                float v[8];
#pragma unroll
                for (int j = 0; j < 4; ++j) { v[j] = acc[ai][bj][m][0][j]; v[4 + j] = acc[ai][bj][m][1][j]; }
#pragma unroll
                for (int j = 0; j < 8; ++j) {
                    const float b_ = (j < 4) ? bb[bj][0][j & 3] : bb[bj][1][j & 3];
                    if (ACT == 1) { const float x = v[j]; v[j] = (cls[bj] == 0) ? tanhf_(x) : (cls[bj] == 1 ? x : (cls[bj] == 2 ? sigmoidf_(x) : 0.f)); }
                    else if (ACT == 2) v[j] = -0.60653066f * sigmoidf_(b_ + v[j]);
                    else if (ACT == 3) v[j] = sigmoidf_(b_ + v[j]);
                }
                w[bj].x = cvt_pk_bf16(v[0], v[1]); w[bj].y = cvt_pk_bf16(v[2], v[3]); w[bj].z = cvt_pk_bf16(v[4], v[5]); w[bj].w = cvt_pk_bf16(v[6], v[7]);
            }
            u32x4 p1; p1.x = dpp_x8(w[1].x); p1.y = dpp_x8(w[1].y); p1.z = dpp_x8(w[1].z); p1.w = dpp_x8(w[1].w);
            u32x4 dA, dB;
            dA.x = lo ? w[0].x : p1.x; dA.y = lo ? w[0].y : p1.y; dA.z = lo ? w[0].z : p1.z; dA.w = lo ? w[0].w : p1.w;
            dB.x = lo ? p1.x : w[0].x; dB.y = lo ? p1.y : w[0].y; dB.z = lo ? p1.z : w[0].z; dB.w = lo ? p1.w : w[0].w;
            const size_t ro = (size_t)(ai * HALF + m * 16) * ldc;
            if (okA) *(u32x4*)(pA + ro) = dA;
            if (okB) *(u32x4*)(pB + ro) = dB;
        }
}
template <int AI_LO = 0, int AI_HI = 2>
__device__ __forceinline__ void epilogue(const GemmDesc& g, const f32x4 (&acc)[2][2][4][2], const Unit& u, int wr, int wc, int fr, int fq) {
    const int row0 = u.pm * BM + wr * 64 + fr;
    const int cin = wc * 32 + 8 * fq;
    if (g.mode == EM_MIXIN && u.pn >= 2 && u.pn < 6) {
#pragma unroll
        for (int ai = AI_LO; ai < AI_HI; ++ai)
#pragma unroll
            for (int m = 0; m < 4; ++m) {
                bf16_t* rowp = g.o0 + (size_t)(row0 + ai * HALF + m * 16) * g.ldc + 512 + (u.pn - 2) * HALF + cin;
                const f32x4 g0 = acc[ai][0][m][0], g1 = acc[ai][0][m][1], u0 = acc[ai][1][m][0], u1 = acc[ai][1][m][1];
                u32x4 w;
                w.x = cvt_pk_bf16(g0[0] * u0[0], g0[1] * u0[1]); w.y = cvt_pk_bf16(g0[2] * u0[2], g0[3] * u0[3]);
                w.z = cvt_pk_bf16(g1[0] * u1[0], g1[1] * u1[1]); w.w = cvt_pk_bf16(g1[2] * u1[2], g1[3] * u1[3]);
                *(u32x4*)rowp = w;
            }
        return;
    }
    if (g.mode == EM_SWIGLU) {
#pragma unroll
        for (int ai = AI_LO; ai < AI_HI; ++ai)
#pragma unroll
            for (int m = 0; m < 4; ++m) {
                bf16_t* rowp = g.o0 + (size_t)(row0 + ai * HALF + m * 16) * g.ldc + u.pn * HALF + cin;
                const f32x4 g0 = acc[ai][0][m][0], g1 = acc[ai][0][m][1], u0 = acc[ai][1][m][0], u1 = acc[ai][1][m][1];
                u32x4 w;
                w.x = cvt_pk_bf16(siluf_(g0[0]) * u0[0], siluf_(g0[1]) * u0[1]); w.y = cvt_pk_bf16(siluf_(g0[2]) * u0[2], siluf_(g0[3]) * u0[3]);
                w.z = cvt_pk_bf16(siluf_(g1[0]) * u1[0], siluf_(g1[1]) * u1[1]); w.w = cvt_pk_bf16(siluf_(g1[2]) * u1[2], siluf_(g1[3]) * u1[3]);
                *(u32x4*)rowp = w;
            }
        return;
    }
    if (g.mode == EM_MOE2) {
        const bool lo = fr < 8;
        const int chA = lo ? fq : 4 + fq, chB = lo ? 4 + fq : fq;
        bf16_t* q = g.o0 + (size_t)(u.pm * BM + wr * 64) * g.ldc + u.pn * BM + wc * 64;
        bf16_t* pA = q + (size_t)(fr & 7) * g.ldc + chA * 8;
        bf16_t* pB = q + (size_t)(8 + (fr & 7)) * g.ldc + chB * 8;
        u32x4 oa_[2][4], ob_[2][4];
#pragma unroll
        for (int ai = AI_LO; ai < AI_HI; ++ai) {
        if (g.flag) {
#pragma unroll
            for (int m = 0; m < 4; ++m) { const size_t ro = (size_t)(ai * HALF + m * 16) * g.ldc; oa_[ai][m] = *(const u32x4*)(pA + ro); ob_[ai][m] = *(const u32x4*)(pB + ro); }
        }
        __builtin_amdgcn_sched_barrier(0);
#pragma unroll
            for (int m = 0; m < 4; ++m) {
                const size_t ro = (size_t)(ai * HALF + m * 16) * g.ldc;
                float dA[8], dB[8];
#pragma unroll
                for (int j = 0; j < 8; ++j) {
                    const float a0 = acc[ai][0][m][j >> 2][j & 3], a1 = acc[ai][1][m][j >> 2][j & 3];
                    const float p1 = dpp_x8f(a1);
                    dA[j] = lo ? a0 : p1; dB[j] = lo ? p1 : a0;
                }
                if (g.flag) { const u32x4 oa = oa_[ai][m], ob = ob_[ai][m];
                    dA[0] += bflo(oa.x); dA[1] += bfhi(oa.x); dA[2] += bflo(oa.y); dA[3] += bfhi(oa.y); dA[4] += bflo(oa.z); dA[5] += bfhi(oa.z); dA[6] += bflo(oa.w); dA[7] += bfhi(oa.w);
                    dB[0] += bflo(ob.x); dB[1] += bfhi(ob.x); dB[2] += bflo(ob.y); dB[3] += bfhi(ob.y); dB[4] += bflo(ob.z); dB[5] += bfhi(ob.z); dB[6] += bflo(ob.w); dB[7] += bfhi(ob.w); }
                u32x4 wa, wb;
                wa.x = cvt_pk_bf16(dA[0], dA[1]); wa.y = cvt_pk_bf16(dA[2], dA[3]); wa.z = cvt_pk_bf16(dA[4], dA[5]); wa.w = cvt_pk_bf16(dA[6], dA[7]);
                wb.x = cvt_pk_bf16(dB[0], dB[1]); wb.y = cvt_pk_bf16(dB[2], dB[3]); wb.z = cvt_pk_bf16(dB[4], dB[5]); wb.w = cvt_pk_bf16(dB[6], dB[7]);
                *(u32x4*)(pA + ro) = wa; *(u32x4*)(pB + ro) = wb;
            }
        __builtin_amdgcn_sched_barrier(0);
        }
        return;
    }
    int act = 0; bf16_t* base = g.o0; int colt = u.pn * BM; int ldc = g.ldc;
    if (g.mode == EM_MIXIN) colt = (u.pn < 2) ? u.pn * BM : 1024 + (u.pn - 6) * BM;
    else if (g.mode == EM_RKVL) {
        const int pnb = u.pn + g.pn_bias;
        if (pnb < 12) { const int t = pnb >> 2; base = g.o0 + (size_t)t * T * D; colt = (pnb & 3) * BM; }
        else { base = g.o1; colt = (pnb - 12) * BM; ldc = LACT_LD; act = 1; }
    } else if (g.mode == EM_LORA2) {
        const int t = (u.pn + g.pn_bias) >> 2; base = (t == 0) ? g.o0 : (t == 1 ? g.o1 : g.o2); colt = (u.pn & 3) * BM; act = (t == 2) ? 0 : 2 + t;
    }
    const int colw = colt + wc * 64;
    bf16_t* bq = base + (size_t)(u.pm * BM + wr * 64) * ldc + colw;
    if (act == 0) store_tiles<0, AI_LO, AI_HI>(acc, bq, ldc, colw, fr, fq, nullptr);
    else if (act == 1) store_tiles<1, AI_LO, AI_HI>(acc, bq, ldc, colw, fr, fq, nullptr, LACT_W);
    else if (act == 2) store_tiles<2, AI_LO, AI_HI>(acc, bq, ldc, colw, fr, fq, g.p0);
    else store_tiles<3, AI_LO, AI_HI>(acc, bq, ldc, colw, fr, fq, g.p1);
}

template <bool GATHER>
__device__ __forceinline__ void unit_offs_f(const GemmDesc& g, const Unit& u, const int (&Rl)[2], const int (&Cl)[2], unsigned (&o)[2][2]) {
#pragma unroll
    for (int h = 0; h < 2; ++h)
#pragma unroll
        for (int i = 0; i < 2; ++i) {
            if constexpr (GATHER) o[h][i] = (unsigned)g.rowidx[u.pm * BM + h * HALF + Rl[i]] * (unsigned)(g.lda * 2) + (unsigned)(Cl[i] * 2);
            else o[h][i] = (unsigned)(Rl[i] * g.lda + Cl[i]) * 2u;
        }
}
template <bool GATHER>
__device__ __forceinline__ void gemm_phase(LAS unsigned char* lds, const GemmDesc& g, int G, int c, int tid) {
    const int wid = __builtin_amdgcn_readfirstlane(tid >> 6), lane = tid & 63, wr = wid >> 2, wc = wid & 3, fr = lane & 15, fq = lane >> 4;
    const int K = g.K, nt = K / BK, lda = g.lda;
    StaticOrder S; S.init(g.nM, g.nN, G, c);
    int Rl[2], Cl[2]; unsigned voffB[2];
    unsigned offc[2][2], offn[2][2];
#pragma unroll
    for (int i = 0; i < 2; ++i) { int R, C; stage_rc(tid * 16 + i * 8192, R, C); const int Rb = (R & ~31) + perm32(R & 31);
        Rl[i] = R; Cl[i] = C; voffB[i] = (unsigned)(Rb * K + C) * 2u; }
    const size_t kstep = (size_t)(BK * 2);
    const size_t hstepB = (size_t)HALF * K * 2;
    const size_t hstepA = GATHER ? (size_t)0 : (size_t)HALF * lda * 2;
    const unsigned ldsw = (unsigned)wid * 1024u;
    const int aoff = lds_byte(wr * 64 + fr, fq * 8), boff = lds_byte((wc & 1) * 64 + fr, fq * 8); const int bh = wc >> 1;
#define PG8_SA(b, h) (((b) * 2 + (h)) * HTB)
#define PG8_SB(b, h) ((4 + (b) * 2 + (h)) * HTB)
#define PG8_STAGE(bufoff, gbase, voff) do { _Pragma("unroll") for (int _i = 0; _i < 2; ++_i) \
        __builtin_amdgcn_global_load_lds((const unsigned*)((const char*)(gbase) + (voff)[_i]), (LAS unsigned*)(lds + (bufoff) + ldsw + _i * 8192), 16, 0, 0); } while (0)
#define PG8_LDA(dst, b, h) do { _Pragma("unroll") for (int m = 0; m < 4; ++m) _Pragma("unroll") for (int k = 0; k < 2; ++k) dst[m][k] = *(const LAS bf16x8*)(lds + PG8_SA(b, h) + aoff + m * 2048 + k * 1024); } while (0)
#define PG8_LDB(dst, b, h) do { _Pragma("unroll") for (int n = 0; n < 2; ++n) _Pragma("unroll") for (int k = 0; k < 2; ++k) dst[n][k] = *(const LAS bf16x8*)(lds + PG8_SB(b, bh) + boff + (h) * 4096 + n * 2048 + k * 1024); } while (0)
#define PG8_MMA(ai, bj, At, Bt) do { __builtin_amdgcn_s_setprio(1); _Pragma("unroll") for (int m = 0; m < 4; ++m) _Pragma("unroll") for (int n = 0; n < 2; ++n) _Pragma("unroll") for (int k = 0; k < 2; ++k) \
        acc[ai][bj][m][n] = __builtin_amdgcn_mfma_f32_16x16x32_bf16(Bt[n][k], At[m][k], acc[ai][bj][m][n], 0, 0, 0); __builtin_amdgcn_s_setprio(0); } while (0)
#define PG8_WAIT_V(n) asm volatile("s_waitcnt vmcnt(" #n ")" ::: "memory")
#define PG8_WAIT_L(n) asm volatile("s_waitcnt lgkmcnt(" #n ")" ::: "memory")
#define PG8_BAR __builtin_amdgcn_s_barrier()
#define PG8_SCHED __builtin_amdgcn_sched_barrier(0)
    Unit cur, nxt; int ui = 0;
    if (!S.next(0, cur)) return;
    f32x4 acc[2][2][4][2];
#pragma unroll
    for (int a = 0; a < 2; ++a)
#pragma unroll
        for (int b = 0; b < 2; ++b)
#pragma unroll
            for (int m = 0; m < 4; ++m)
#pragma unroll
                for (int n = 0; n < 2; ++n) acc[a][b][m][n] = (f32x4){0.f, 0.f, 0.f, 0.f};
    bf16x8 At[4][2], B0[2][2], B1[2][2];
    unit_offs_f<GATHER>(g, cur, Rl, Cl, offc);
#pragma unroll
    for (int h = 0; h < 2; ++h) { offn[h][0] = offc[h][0]; offn[h][1] = offc[h][1]; }
    const char* cA = (const char*)g.A + (GATHER ? (size_t)0 : a_off_bytes(g, cur)); const char* cB = (const char*)g.Bt + b_off_bytes(g, cur);
    PG8_STAGE(PG8_SB(0, 0), cB, voffB); PG8_STAGE(PG8_SB(0, 1), cB + hstepB, voffB); PG8_STAGE(PG8_SA(0, 0), cA, offc[0]); PG8_STAGE(PG8_SA(0, 1), cA + hstepA, offc[1]);
    if (wr == 1) PG8_BAR;
    PG8_WAIT_V(2); PG8_BAR;
    PG8_STAGE(PG8_SB(1, 0), cB + kstep, voffB); PG8_STAGE(PG8_SA(1, 0), cA + kstep, offc[0]); PG8_STAGE(PG8_SB(1, 1), cB + hstepB + kstep, voffB);
    PG8_WAIT_V(6); PG8_BAR;
    for (;;) {
        const bool has_next = S.next(ui + 1, nxt);
        const char* nA = has_next ? (const char*)g.A + (GATHER ? (size_t)0 : a_off_bytes(g, nxt)) : cA; const char* nB = has_next ? (const char*)g.Bt + b_off_bytes(g, nxt) : cB;
        if constexpr (GATHER) {
            if (has_next && wid == 0) {
#pragma unroll
                for (int q = 0; q < 4; ++q) __builtin_amdgcn_global_load_lds((const unsigned*)(g.rowidx + nxt.pm * BM + q * 64 + lane), (LAS unsigned*)(lds + STAGE_BYTES + q * 256), 4, 0, 0);
            }
        }
        for (int t = 0; t < nt; t += 2) {
            const bool last = (t == nt - 2);
            const char* a1 = cA + (size_t)(t + 1) * kstep;
            const char* a2 = last ? nA : cA + (size_t)(t + 2) * kstep; const char* b2 = last ? nB : cB + (size_t)(t + 2) * kstep;
            const char* a3 = a2 + kstep; const char* b3 = b2 + kstep;
            unsigned o2[2][2];
            if constexpr (GATHER) {
                if (last && has_next) {
                    const LAS int* ridx = (const LAS int*)(lds + STAGE_BYTES);
#pragma unroll
                    for (int h = 0; h < 2; ++h)
#pragma unroll
                        for (int i = 0; i < 2; ++i) offn[h][i] = (unsigned)ridx[h * HALF + Rl[i]] * (unsigned)(g.lda * 2) + (unsigned)(Cl[i] * 2);
                }
#pragma unroll
                for (int h = 0; h < 2; ++h)
#pragma unroll
                    for (int i = 0; i < 2; ++i) o2[h][i] = last ? offn[h][i] : offc[h][i];
            } else {
#pragma unroll
                for (int h = 0; h < 2; ++h)
#pragma unroll
                    for (int i = 0; i < 2; ++i) o2[h][i] = offc[0][i];
            }
            PG8_LDB(B0, 0, 0); PG8_LDB(B1, 0, 1); PG8_SCHED; PG8_LDA(At, 0, 0); PG8_STAGE(PG8_SA(1, 1), a1 + hstepA, offc[1]);
            PG8_WAIT_V(8); PG8_WAIT_L(0); PG8_BAR; PG8_MMA(0, 0, At, B0); PG8_MMA(0, 1, At, B1); PG8_BAR; PG8_SCHED;
            PG8_LDA(At, 0, 1); PG8_STAGE(PG8_SB(0, 0), b2, voffB); PG8_STAGE(PG8_SB(0, 1), b2 + hstepB, voffB); PG8_STAGE(PG8_SA(0, 0), a2, o2[0]);
            PG8_WAIT_V(8); PG8_WAIT_L(0); PG8_BAR; PG8_MMA(1, 0, At, B0); PG8_MMA(1, 1, At, B1); PG8_BAR; PG8_SCHED;
            PG8_LDB(B0, 1, 0); PG8_LDB(B1, 1, 1); PG8_SCHED; PG8_LDA(At, 1, 0); PG8_STAGE(PG8_SA(0, 1), a2 + hstepA, o2[1]);
            PG8_WAIT_V(8); PG8_WAIT_L(0); PG8_BAR; PG8_MMA(0, 0, At, B0); PG8_MMA(0, 1, At, B1); PG8_BAR; PG8_SCHED;
            PG8_LDA(At, 1, 1); PG8_STAGE(PG8_SB(1, 0), b3, voffB); PG8_STAGE(PG8_SB(1, 1), b3 + hstepB, voffB); PG8_STAGE(PG8_SA(1, 0), a3, o2[0]);
            PG8_WAIT_V(8); PG8_WAIT_L(0); PG8_BAR; PG8_MMA(1, 0, At, B0); PG8_MMA(1, 1, At, B1); PG8_BAR; PG8_SCHED;
        }
        if (wr == 0) PG8_BAR;
        epilogue(g, acc, cur, wr, wc, fr, fq);
        if (!has_next) break;
#pragma unroll
        for (int a = 0; a < 2; ++a)
#pragma unroll
            for (int b = 0; b < 2; ++b)
#pragma unroll
                for (int m = 0; m < 4; ++m)
#pragma unroll
                    for (int n = 0; n < 2; ++n) acc[a][b][m][n] = (f32x4){0.f, 0.f, 0.f, 0.f};
        cur = nxt; cA = nA; cB = nB; ++ui;
        if constexpr (GATHER) {
#pragma unroll
            for (int h = 0; h < 2; ++h) { offc[h][0] = offn[h][0]; offc[h][1] = offn[h][1]; }
        }
        if (wr == 1) PG8_BAR;
    }
    PG8_WAIT_V(0);
    PG8_BAR;
#undef PG8_SA
#undef PG8_SB
#undef PG8_STAGE
#undef PG8_LDA
#undef PG8_LDB
#undef PG8_MMA
#undef PG8_WAIT_V
#undef PG8_WAIT_L
#undef PG8_BAR
#undef PG8_SCHED
}
}

#define XB_TMO      128
#define XB_XCNT(j)  (256  + 64 * (j))
#define XB_XSUB(j)  (1280 + 64 * (j))
#define XB_XGEN(j)  (2304 + 64 * (j))
#define XB_TOP      3328
#define XB_TOPGEN   3392
#define XCD_BAR_WORDS 3456
#define XB_SPIN_CAP (1u << 20)
__device__ __forceinline__ unsigned xb_ld(unsigned* p)              { return __hip_atomic_load(p, __ATOMIC_RELAXED, __HIP_MEMORY_SCOPE_AGENT); }
__device__ __forceinline__ unsigned xb_add(unsigned* p, unsigned v) { return __hip_atomic_fetch_add(p, v, __ATOMIC_RELAXED, __HIP_MEMORY_SCOPE_AGENT); }
__device__ __forceinline__ unsigned xb_xcc_id() { return (unsigned)__builtin_amdgcn_s_getreg((3 << 11) | 20) & 0xFu; }
#define XB_SPIN(cond, bar) do { unsigned _sp = 0; while (cond) { __builtin_amdgcn_s_sleep(1); \
    if ((++_sp & 255u) == 0u) { if (xb_ld(&(bar)[XB_TMO])) break; if (_sp > XB_SPIN_CAP) { atomicAdd(&(bar)[XB_TMO], 1u); break; } } } } while (0)
struct XcdBarrier { unsigned* bar; unsigned x; volatile LAS unsigned* st; };
__device__ __forceinline__ XcdBarrier xcd_barrier_post(unsigned* bar, volatile LAS unsigned* st) {
    XcdBarrier b; b.bar = bar; b.x = xb_xcc_id(); b.st = st;
    if (threadIdx.x == 0) (void)xb_add(&bar[XB_XCNT(b.x)], 1u);
    return b;
}
__device__ __forceinline__ void xcd_barrier_complete(unsigned* bar, unsigned x, unsigned& nloc, unsigned& nx) {
    const unsigned G = gridDim.x * gridDim.y * gridDim.z;
    unsigned sum, cnt, mine, sp = 0u;
    for (;;) {
        sum = 0u; cnt = 0u; mine = 0u;
#pragma unroll
        for (unsigned j = 0; j < 16; ++j) { const unsigned c = xb_ld(&bar[XB_XCNT(j)]); sum += c; cnt += (c > 0u) ? 1u : 0u; mine = (j == x) ? c : mine; }
        if (sum == G) break;
        __builtin_amdgcn_s_sleep(1);
        if ((++sp & 255u) == 0u) { if (xb_ld(&bar[XB_TMO])) break; if (sp > XB_SPIN_CAP) { atomicAdd(&bar[XB_TMO], 1u); break; } }
    }
    nloc = mine > 0u ? mine : 1u; nx = cnt > 0u ? cnt : 1u;
}
__device__ __forceinline__ void xcd_barrier(const XcdBarrier& b) {
    asm volatile("s_waitcnt vmcnt(0)" ::: "memory");
    __syncthreads();
    if (threadIdx.x == 0) {
        unsigned* bar = b.bar;
        __builtin_amdgcn_s_waitcnt(0);
        unsigned nloc = b.st[0], nx = b.st[1];
        if (nloc == 0u) { xcd_barrier_complete(bar, b.x, nloc, nx); b.st[0] = nloc; b.st[1] = nx; }
        const unsigned old = xb_add(&bar[XB_XSUB(b.x)], 1u);
        const unsigned gen = old / nloc;
        if (old + 1u == (gen + 1u) * nloc) {
            __builtin_amdgcn_fence(__ATOMIC_RELEASE, "agent");
            asm volatile("s_waitcnt vmcnt(0)" ::: "memory");
            const unsigned og = xb_add(&bar[XB_TOP], 1u);
            const unsigned tg = og / nx;
            if (og + 1u == (tg + 1u) * nx) xb_add(&bar[XB_TOPGEN], 1u);
            else XB_SPIN(xb_ld(&bar[XB_TOPGEN]) == tg, bar);
            __builtin_amdgcn_fence(__ATOMIC_ACQUIRE, "agent");
            asm volatile("s_waitcnt vmcnt(0)" ::: "memory");
        } else {
            XB_SPIN(xb_ld(&bar[XB_TOPGEN]) == gen, bar);
            __builtin_amdgcn_fence(__ATOMIC_ACQUIRE, "agent");
            asm volatile("s_waitcnt vmcnt(0)" ::: "memory");
        }
    }
    __syncthreads();
}

constexpr int RING_BYTES = 131072;
constexpr int LDS_BYTES = 163840;
constexpr int MISC_OFF = LDS_BYTES - 1024;

struct Args {
    const float* in[35]; float* out; unsigned char* ws; int ph_lo, ph_hi;
};
enum { I_X = 0, I_C, I_ADAW, I_ADAB, I_NORMG, I_MIXWIN, I_CONVW, I_POOLW, I_POOLS, I_MIXWOUT, I_FFG, I_FFU, I_FFD, I_MU, I_WR, I_WK, I_WV, I_WO, I_W0, I_W1, I_W2, I_A0, I_A1, I_A2, I_G1, I_G2,
       I_KK, I_KA, I_RK, I_LNG, I_LNB, I_ROUTER, I_MOEG, I_MOEU, I_MOED };

struct Frame {
    LAS unsigned char* lds;
    int tid, lane, wave, vcu, G;
    unsigned char* ws;
};

struct ConvJob {
    const float* src; int src_ld;
    int n0s;
    int nK, nN;
    int k_lo, k_hi;
    bf16_t* dst; int dst_ld; int dst_r0, dst_c0;
    const float* scale; int smode;
    int remap;
};
__device__ __forceinline__ int conv_items(const ConvJob& j) { return (j.nK / 64) * (j.nN / 32); }
__device__ __forceinline__ void conv_item(const ConvJob& j, LAS float* scr, int item, int lane) {
    const int nblk = j.nN / 32, kb = item / nblk, nb = item % nblk, k0 = 64 * kb, n0 = 32 * nb;
    f32x4 v[8];
#pragma unroll
    for (int i = 0; i < 8; ++i) { const int kk = 8 * i + (lane >> 3); const int k = k0 + kk; v[i] = (f32x4){0.f, 0.f, 0.f, 0.f};
        if (k >= j.k_lo && k < j.k_hi) { const int sr = k - j.k_lo; v[i] = *(const f32x4*)(j.src + (size_t)sr * j.src_ld + j.n0s + n0 + 4 * (lane & 7));
            if (j.smode == 1) v[i] = v[i] * j.scale[sr]; else if (j.smode == 2) v[i] = v[i] * (1.0f - j.scale[sr]); } }
#pragma unroll
    for (int i = 0; i < 8; ++i) { const int kk = 8 * i + (lane >> 3); LAS float* d = scr + kk * 33 + 4 * (lane & 7); d[0] = v[i][0]; d[1] = v[i][1]; d[2] = v[i][2]; d[3] = v[i][3]; }
    asm volatile("s_waitcnt lgkmcnt(0)" ::: "memory");
    const int c = lane & 7;
#pragma unroll
    for (int q = 0; q < 4; ++q) { const int n = (lane >> 3) + 8 * q; const LAS float* s = scr + (8 * c) * 33 + n;
        u32x4 o; o.x = pk2(s[0 * 33], s[1 * 33]); o.y = pk2(s[2 * 33], s[3 * 33]); o.z = pk2(s[4 * 33], s[5 * 33]); o.w = pk2(s[6 * 33], s[7 * 33]);
        const int nl = n0 + n; int drow = j.dst_r0 + nl; if (j.remap) drow = j.dst_r0 + 256 * (nl >> 7) + 64 * ((nl & 127) >> 5) + (j.remap == 2 ? 32 : 0) + (nl & 31);
        *(GAS u32x4*)(j.dst + (size_t)drow * j.dst_ld + j.dst_c0 + k0 + 8 * c) = o; }
    asm volatile("s_waitcnt lgkmcnt(0)" ::: "memory");
}
__device__ __forceinline__ ConvJob mkjob(const float* src, int src_ld, int n0s, int nK, int nN, int k_lo, int k_hi, bf16_t* dst, int dst_ld, int dst_r0, int dst_c0, const float* scale, int smode, int remap) {
    ConvJob j; j.src = src; j.src_ld = src_ld; j.n0s = n0s; j.nK = nK; j.nN = nN; j.k_lo = k_lo; j.k_hi = k_hi; j.dst = dst; j.dst_ld = dst_ld; j.dst_r0 = dst_r0; j.dst_c0 = dst_c0; j.scale = scale; j.smode = smode; j.remap = remap; return j;
}
#define RUN_JOB(J) do { const ConvJob _j = (J); const int _n = conv_items(_j); for (int _it = (gw + NGW - (itbase % NGW)) % NGW; _it < _n; _it += NGW) conv_item(_j, scr, _it, F.lane); itbase += _n; } while (0)

__device__ __forceinline__ void phase_prologue(Frame& F, const Args& A) {
    unsigned char* ws = F.ws;
    LAS float* scr = (LAS float*)(F.lds + F.wave * 16384);
    const int gw = F.vcu * NWAVES + F.wave, NGW = F.G * NWAVES;
    {
        float* mod = (float*)(ws + WS_MOD);
        LAS float* red = (LAS float*)(F.lds);
        LAS float* sc_ = (LAS float*)(F.lds + 8192);
        for (int i = F.tid; i < 4 * D; i += NTHREADS) sc_[i] = siluf_(A.in[I_C][i]);
        __syncthreads();
        for (int task = F.vcu; task < 2 * 96; task += F.G) {
            const int l = task / 96, nb = task % 96, n = nb * 64 + F.lane;
            const float* w = A.in[I_ADAW] + (size_t)l * D * 6144 + n;
            float acc0 = 0.f, acc1 = 0.f, acc2 = 0.f, acc3 = 0.f;
            const int kb = F.wave * 128;
#pragma unroll 32
            for (int k = kb; k < kb + 128; ++k) {
                const float wv = w[(size_t)k * 6144];
                acc0 += sc_[k] * wv; acc1 += sc_[D + k] * wv; acc2 += sc_[2 * D + k] * wv; acc3 += sc_[3 * D + k] * wv;
            }
            red[(F.wave * 4 + 0) * 64 + F.lane] = acc0; red[(F.wave * 4 + 1) * 64 + F.lane] = acc1; red[(F.wave * 4 + 2) * 64 + F.lane] = acc2; red[(F.wave * 4 + 3) * 64 + F.lane] = acc3;
            __syncthreads();
            if (F.wave < 4) { float s = 0.f; for (int w8 = 0; w8 < 8; ++w8) s += red[(w8 * 4 + F.wave) * 64 + F.lane];
                mod[((size_t)l * 4 + F.wave) * 6144 + n] = s + A.in[I_ADAB][l * 6144 + n]; }
            __syncthreads();
        }
    }
    int itbase = 0;
    bf16_t* Win = (bf16_t*)(ws + WS_WIN); bf16_t* Woute = (bf16_t*)(ws + WS_WOUTE); bf16_t* Wfgu = (bf16_t*)(ws + WS_WFGU); bf16_t* Wfd = (bf16_t*)(ws + WS_WFD);
    bf16_t* Wrkv = (bf16_t*)(ws + WS_WRKV); bf16_t* Wlor = (bf16_t*)(ws + WS_WLOR); bf16_t* Wl2 = (bf16_t*)(ws + WS_WL2); bf16_t* Wo = (bf16_t*)(ws + WS_WO);
    RUN_JOB(mkjob(A.in[I_MIXWIN], MIXIN, 0, D, 512, 0, D, Win, D, 0, 0, nullptr, 0, 0));
    RUN_JOB(mkjob(A.in[I_MIXWIN], MIXIN, 512, D, 512, 0, D, Win, D, 512, 0, nullptr, 0, 1));
    RUN_JOB(mkjob(A.in[I_MIXWIN], MIXIN, 1024, D, 512, 0, D, Win, D, 512, 0, nullptr, 0, 2));
    RUN_JOB(mkjob(A.in[I_MIXWIN], MIXIN, 1536, D, 512, 0, D, Win, D, 1536, 0, nullptr, 0, 0));
    RUN_JOB(mkjob(A.in[I_MIXWOUT], D, 0, 512, D, 0, 512, Woute, D, 0, 0, nullptr, 0, 0));
    RUN_JOB(mkjob(A.in[I_FFG], FF, 0, D, FF, 0, D, Wfgu, D, 0, 0, nullptr, 0, 1));
    RUN_JOB(mkjob(A.in[I_FFU], FF, 0, D, FF, 0, D, Wfgu, D, 0, 0, nullptr, 0, 2));
    RUN_JOB(mkjob(A.in[I_FFD], D, 0, FF, D, 0, FF, Wfd, FF, 0, 0, nullptr, 0, 0));
    const float* mu = A.in[I_MU];
    RUN_JOB(mkjob(A.in[I_WR], D, 0, D, D, 0, D, Wrkv, D, 0, 0, nullptr, 0, 0));
    RUN_JOB(mkjob(A.in[I_WK], D, 0, D, D, 0, D, Wrkv, D, D, 0, nullptr, 0, 0));
    RUN_JOB(mkjob(A.in[I_WV], D, 0, D, D, 0, D, Wrkv, D, 2 * D, 0, nullptr, 0, 0));
    RUN_JOB(mkjob(A.in[I_W1], 64, 0, D, 64, 0, D, Wlor, 2 * D, 0, 0, mu + 1 * D, 1, 0));
    RUN_JOB(mkjob(A.in[I_W1], 64, 0, D, 64, 0, D, Wlor, 2 * D, 0, D, mu + 1 * D, 2, 0));
    RUN_JOB(mkjob(A.in[I_A1], 64, 0, D, 64, 0, D, Wlor, 2 * D, 64, 0, mu + 4 * D, 1, 0));
    RUN_JOB(mkjob(A.in[I_A1], 64, 0, D, 64, 0, D, Wlor, 2 * D, 64, D, mu + 4 * D, 2, 0));
    RUN_JOB(mkjob(A.in[I_G1], 160, 0, D, 160, 0, D, Wlor, 2 * D, 128, 0, mu + 5 * D, 1, 0));
    RUN_JOB(mkjob(A.in[I_G1], 160, 0, D, 160, 0, D, Wlor, 2 * D, 128, D, mu + 5 * D, 2, 0));
    RUN_JOB(mkjob(A.in[I_W2], D, 0, 256, D, 0, 64, Wl2, 256, 0, 0, nullptr, 0, 0));
    RUN_JOB(mkjob(A.in[I_A2], D, 0, 256, D, 64, 128, Wl2, 256, D, 0, nullptr, 0, 0));
    RUN_JOB(mkjob(A.in[I_G2], D, 0, 256, D, 0, 160, Wl2, 256, 2 * D, 0, nullptr, 0, 0));
    RUN_JOB(mkjob(A.in[I_WO], D, 0, D, D, 0, D, Wo, D, 0, 0, nullptr, 0, 0));
    { u32x4* z = (u32x4*)(Wlor + (size_t)288 * 2 * D); const int n16 = 224 * 2 * D * 2 / 16;
      for (int i = gw * 64 + F.lane; i < n16; i += NGW * 64) z[i] = (u32x4){0u, 0u, 0u, 0u}; }
    {
        const float* pw = A.in[I_POOLW]; const float* ps = A.in[I_POOLS]; const float* wo = A.in[I_MIXWOUT];
        for (int item = gw; item < 512 * 4; item += NGW) {
            const int kk = item >> 2, db = item & 3, g = kk >> 7, c = kk & 127, d = db * 256 + 4 * F.lane;
            f32x4 s = (f32x4){0.f, 0.f, 0.f, 0.f};
#pragma unroll 32
            for (int c2 = 0; c2 < 128; ++c2) s = s + (pw[((size_t)g * 128 + c) * 128 + c2] * ps[g * 128 + c2]) * *(const f32x4*)(wo + (size_t)(512 + g * 128 + c2) * D + d);
#pragma unroll
            for (int q = 0; q < 4; ++q) Woute[(size_t)(d + q) * D + 512 + kk] = (bf16_t)f2bf(s[q]);
        }
    }
}

__device__ __forceinline__ void moe_convert(Frame& F, const Args& A, int part, int half, bf16_t* dst, int pidx, int np) {
    LAS float* scr = (LAS float*)(F.lds + F.wave * 16384);
    const int gw = pidx * NWAVES + F.wave, NGW = np * NWAVES;
    int itbase = 0;
    for (int e = 0; e < NE; ++e) {
        if (part == 0) {
            RUN_JOB(mkjob(A.in[I_MOEG] + (size_t)e * D * FF, FF, half * FH, D, FH, 0, D, dst, D, e * FF, 0, nullptr, 0, 1));
            RUN_JOB(mkjob(A.in[I_MOEU] + (size_t)e * D * FF, FF, half * FH, D, FH, 0, D, dst, D, e * FF, 0, nullptr, 0, 2));
        } else {
            RUN_JOB(mkjob(A.in[I_MOED] + (size_t)e * FF * D + (size_t)half * FH * D, D, 0, FH, D, 0, FH, dst, FH, e * D, 0, nullptr, 0, 0));
        }
    }
}

constexpr int MCV_ITEMS = 32 * 2816;
struct McvDst { bf16_t* p; };
__device__ __forceinline__ McvDst mcv_load(const Args& A, unsigned char* ws, int id, int lane, float (&v)[8]) {
    const int t = id / 2816, r = id % 2816;
    const float* src; int ld; bf16_t* dst;
    if (t < 16) { const int e = t >> 1, up = t & 1, kb = r / 22, nb = r % 22, nl = nb * 64 + lane;
        src = A.in[up ? I_MOEU : I_MOEG] + (size_t)e * D * FF + (size_t)(kb * 8) * FF + nl; ld = FF;
        dst = (bf16_t*)(ws + WS_WMGU) + (size_t)(e * FF + 256 * (nl >> 7) + 64 * ((nl & 127) >> 5) + (up ? 32 : 0) + (nl & 31)) * D + kb * 8;
    } else { const int half = (t - 16) >> 3, e = (t - 16) & 7, kb = r / 16, nb = r % 16, n = nb * 64 + lane;
        src = A.in[I_MOED] + (size_t)e * FF * D + (size_t)(half * FH + kb * 8) * D + n; ld = D;
        dst = (bf16_t*)(ws + (half ? WS_WMD1 : WS_WMD0)) + (size_t)(e * D + n) * FH + kb * 8; }
#pragma unroll
    for (int i = 0; i < 8; ++i) v[i] = __builtin_nontemporal_load(src + (size_t)i * ld);
    McvDst d; d.p = dst; return d;
}
__device__ __forceinline__ void mcv_store(const McvDst& d, const float (&v)[8]) {
    *(u32x4*)(d.p) = (u32x4){pk2(v[0], v[1]), pk2(v[2], v[3]), pk2(v[4], v[5]), pk2(v[6], v[7])};
}

struct RowP {
    const float* xin; float* xout;
    const bf16_t* y;
    const float* gate; const float* gpost;
    const float* gpre; const float* sc; const float* sh;
    bf16_t* hout; int hpad;
    float* xh;
    int xin_b, xout_b;
};
struct RowIn { f32x4 xf[4]; u32x2 xb[4]; u32x2 yw[4]; };
__device__ __forceinline__ void row_load(const RowP& P, int t, int lane, RowIn& in, const float* xrow = nullptr) {
    if (P.xin_b && !xrow) {
        const GAS u32x2* xr = (const GAS u32x2*)((const bf16_t*)P.xin + (size_t)t * 2048 + 1024) + lane;
#pragma unroll
        for (int j = 0; j < 4; ++j) in.xb[j] = xr[64 * j];
    } else {
        const GAS f32x4* xr = (const GAS f32x4*)(xrow ? xrow : P.xin + (size_t)t * D) + lane;
#pragma unroll
        for (int j = 0; j < 4; ++j) in.xf[j] = xr[64 * j];
    }
    if (P.y) {
        const GAS u32x2* yr = (const GAS u32x2*)(P.y + (size_t)t * D) + lane;
#pragma unroll
        for (int j = 0; j < 4; ++j) in.yw[j] = yr[64 * j];
    }
}
__device__ __forceinline__ void row_compute(const RowP& P, int t, int lane, const RowIn& in, f32x4 (&hv)[4], bool want_h, bool halo = false) {
    const int b = t / SEQ;
    f32x4 x[4];
    if (P.xin_b && !halo) {
#pragma unroll
        for (int j = 0; j < 4; ++j) { const u32x2 w = in.xb[j]; x[j] = (f32x4){bflo(w.x), bfhi(w.x), bflo(w.y), bfhi(w.y)}; }
    } else {
#pragma unroll
        for (int j = 0; j < 4; ++j) x[j] = in.xf[j];
    }
    if (P.y) {
        f32x4 yv[4]; float ss = 0.f;
#pragma unroll
        for (int j = 0; j < 4; ++j) { const u32x2 w = in.yw[j]; yv[j] = (f32x4){bflo(w.x), bfhi(w.x), bflo(w.y), bfhi(w.y)}; ss += (yv[j].x * yv[j].x + yv[j].y * yv[j].y) + (yv[j].z * yv[j].z + yv[j].w * yv[j].w); }
        const float rs = rsqrtf(wave_sum(ss) * (1.0f / D) + RMS_EPS);
#pragma unroll
        for (int j = 0; j < 4; ++j) { const f32x4 gt = *((const f32x4*)(P.gate + (size_t)b * 6144) + lane + 64 * j); const f32x4 gp = *((const f32x4*)P.gpost + lane + 64 * j);
            x[j] = x[j] + gt * gp * yv[j] * rs; }
    }
    if (P.xout_b) {
        u32x2 w[4];
#pragma unroll
        for (int j = 0; j < 4; ++j) { w[j] = (u32x2){pk2(x[j].x, x[j].y), pk2(x[j].z, x[j].w)}; x[j] = (f32x4){bflo(w[j].x), bfhi(w[j].x), bflo(w[j].y), bfhi(w[j].y)}; }
        if (!halo) { GAS u32x2* xo = (GAS u32x2*)((bf16_t*)P.xout + (size_t)t * 2048 + 1024) + lane;
#pragma unroll
            for (int j = 0; j < 4; ++j) xo[64 * j] = w[j]; }
    } else if (P.xout && !halo) { GAS f32x4* xo = (GAS f32x4*)(P.xout + (size_t)t * D) + lane;
#pragma unroll
        for (int j = 0; j < 4; ++j) xo[64 * j] = x[j]; }
    if (P.xh && (t & 15) == 15) { GAS f32x4* xo = (GAS f32x4*)(P.xh + (size_t)(t >> 4) * D) + lane;
#pragma unroll
        for (int j = 0; j < 4; ++j) xo[64 * j] = x[j]; }
    if (want_h) {
        float ss = 0.f;
#pragma unroll
        for (int j = 0; j < 4; ++j) ss += (x[j].x * x[j].x + x[j].y * x[j].y) + (x[j].z * x[j].z + x[j].w * x[j].w);
        const float rs = rsqrtf(wave_sum(ss) * (1.0f / D) + RMS_EPS);
#pragma unroll
        for (int j = 0; j < 4; ++j) { const f32x4 gp = *((const f32x4*)P.gpre + lane + 64 * j); const f32x4 sc = *((const f32x4*)(P.sc + (size_t)b * 6144) + lane + 64 * j); const f32x4 sh = *((const f32x4*)(P.sh + (size_t)b * 6144) + lane + 64 * j);
            hv[j] = x[j] * rs * gp * (1.0f + sc) + sh; }
        if (P.hout && !halo) { const size_t hr = P.hpad ? (size_t)b * (SEQ + 1) + (size_t)(t - b * SEQ) + 1 : (size_t)t;
            GAS u32x2* ho = (GAS u32x2*)(P.hout + hr * D) + lane;
#pragma unroll
            for (int j = 0; j < 4; ++j) ho[64 * j] = (u32x2){pk2(hv[j].x, hv[j].y), pk2(hv[j].z, hv[j].w)}; }
    }
}
__device__ __forceinline__ void phase_rows(Frame& F, const RowP& P) {
    const int gw = F.vcu * NWAVES + F.wave, NGW = F.G * NWAVES;
    f32x4 hv[4];
    RowIn cur, nxt;
    int t = gw; if (t < T) row_load(P, t, F.lane, cur);
    for (; t < T; t += NGW) { if (t + NGW < T) row_load(P, t + NGW, F.lane, nxt); row_compute(P, t, F.lane, cur, hv, P.gpre != nullptr); cur = nxt; }
}

__device__ __forceinline__ void phase_post2(Frame& F, const Args& A, const RowP& P) {
    const int g = F.vcu * NWAVES + F.wave, lane = F.lane;
    const float* mu = A.in[I_MU];
    f32x4 mur[4], muk[4], muv[4];
#pragma unroll
    for (int j = 0; j < 4; ++j) { mur[j] = *((const f32x4*)(mu + 0 * D) + lane + 64 * j); muk[j] = *((const f32x4*)(mu + 2 * D) + lane + 64 * j); muv[j] = *((const f32x4*)(mu + 3 * D) + lane + 64 * j); }
    bf16_t* XR = (bf16_t*)(F.ws + WS_XR); bf16_t* XK = (bf16_t*)(F.ws + WS_XK); bf16_t* XV = (bf16_t*)(F.ws + WS_XV);
    const int t0 = 16 * g;
    f32x4 hp[4];
    if (t0 % SEQ == 0) {
#pragma unroll
        for (int j = 0; j < 4; ++j) hp[j] = (f32x4){0.f, 0.f, 0.f, 0.f};
    } else { RowIn hin; row_load(P, t0 - 1, lane, hin, (const float*)(F.ws + WS_XH) + (size_t)(g - 1) * D); row_compute(P, t0 - 1, lane, hin, hp, true, true); }
    RowIn cur, nxt; row_load(P, t0, lane, cur);
#pragma unroll 1
    for (int t = t0; t < t0 + 16; ++t) {
        if (t + 1 < t0 + 16) row_load(P, t + 1, lane, nxt);
        f32x4 hv[4]; row_compute(P, t, lane, cur, hv, true); cur = nxt;
        GAS u32x2* pr = (GAS u32x2*)(XR + (size_t)t * D) + lane; GAS u32x2* pk = (GAS u32x2*)(XK + (size_t)t * D) + lane; GAS u32x2* pv = (GAS u32x2*)(XV + (size_t)t * D) + lane;
#pragma unroll
        for (int j = 0; j < 4; ++j) { const f32x4 d = hp[j] - hv[j];
            const f32x4 a = hv[j] + d * mur[j], b = hv[j] + d * muk[j], c = hv[j] + d * muv[j];
            pr[64 * j] = (u32x2){pk2(a.x, a.y), pk2(a.z, a.w)}; pk[64 * j] = (u32x2){pk2(b.x, b.y), pk2(b.z, b.w)}; pv[64 * j] = (u32x2){pk2(c.x, c.y), pk2(c.z, c.w)};
            hp[j] = hv[j]; }
    }
}

__device__ __forceinline__ void phase_mix(Frame& F, const Args& A) {
    const bf16_t* __restrict__ Z = (const bf16_t*)(F.ws + WS_Z); bf16_t* __restrict__ A2 = (bf16_t*)(F.ws + WS_A2);
    constexpr int TB = 32;
    const int tid = F.tid;
    for (int blk = F.vcu; blk < T / TB; blk += F.G) {
        const int t0 = blk * TB, b = t0 / SEQ, tb0 = t0 - b * SEQ;
        if (tid < 256) {
            const int c = 2 * tid;
            const float w00 = A.in[I_CONVW][c], w01 = A.in[I_CONVW][c + 1], w10 = A.in[I_CONVW][512 + c], w11 = A.in[I_CONVW][512 + c + 1], w20 = A.in[I_CONVW][1024 + c], w21 = A.in[I_CONVW][1024 + c + 1];
            float um2_0 = 0.f, um2_1 = 0.f, um1_0 = 0.f, um1_1 = 0.f;
            for (int s = -2; s < 0; ++s) if (tb0 + s >= 0) { const bf16_t* zr = Z + (size_t)(t0 + s) * ZLD;
                const unsigned uw = *(const unsigned*)(zr + 512 + c);
                const float u0 = bflo(uw), u1 = bfhi(uw);
                if (s == -2) { um2_0 = u0; um2_1 = u1; } else { um1_0 = u0; um1_1 = u1; } }
            unsigned bgv[2][8], uvv[2][8];
#pragma unroll
            for (int q = 0; q < 8; ++q) { const bf16_t* zr = Z + (size_t)(t0 + q) * ZLD; bgv[0][q] = *(const unsigned*)(zr + c); uvv[0][q] = *(const unsigned*)(zr + 512 + c); }
#pragma unroll
            for (int grp = 0; grp < TB / 8; ++grp) {
                const int cu = grp & 1, nx = cu ^ 1;
                if (grp + 1 < TB / 8) {
#pragma unroll
                    for (int q = 0; q < 8; ++q) { const bf16_t* zr = Z + (size_t)(t0 + 8 * (grp + 1) + q) * ZLD; bgv[nx][q] = *(const unsigned*)(zr + c); uvv[nx][q] = *(const unsigned*)(zr + 512 + c); }
                }
                __builtin_amdgcn_sched_barrier(0);
#pragma unroll
                for (int q = 0; q < 8; ++q) { const int s = 8 * grp + q; const unsigned bg = bgv[cu][q], uw = uvv[cu][q];
                    const float u0 = bflo(uw), u1 = bfhi(uw);
                    const float y0 = bflo(bg) * (w00 * um2_0 + w10 * um1_0 + w20 * u0), y1 = bfhi(bg) * (w01 * um2_1 + w11 * um1_1 + w21 * u1);
                    *(unsigned*)(A2 + (size_t)(t0 + s) * D + c) = pk2(y0, y1);
                    um2_0 = um1_0; um2_1 = um1_1; um1_0 = u0; um1_1 = u1; }
                __builtin_amdgcn_sched_barrier(0);
            }
        } else {
            const int c = 2 * (tid - 256), win = 2 << (c >> 7);
            float s0 = 0.f, s1 = 0.f;
            for (int s = -win + 1; s < 0; ++s) if (tb0 + s >= 0) { const unsigned v = *(const unsigned*)(Z + (size_t)(t0 + s) * ZLD + 1024 + c); s0 += bflo(v); s1 += bfhi(v); }
            unsigned vv[2][8], ov[2][8];
#pragma unroll
            for (int q = 0; q < 8; ++q) { vv[0][q] = *(const unsigned*)(Z + (size_t)(t0 + q) * ZLD + 1024 + c);
                ov[0][q] = (tb0 + q - win + 1 >= 0) ? *(const unsigned*)(Z + (size_t)(t0 + q - win + 1) * ZLD + 1024 + c) : 0u; }
#pragma unroll
            for (int grp = 0; grp < TB / 8; ++grp) {
                const int cu = grp & 1, nx = cu ^ 1;
                if (grp + 1 < TB / 8) {
#pragma unroll
                    for (int q = 0; q < 8; ++q) { const int s = 8 * (grp + 1) + q; vv[nx][q] = *(const unsigned*)(Z + (size_t)(t0 + s) * ZLD + 1024 + c);
                        ov[nx][q] = (tb0 + s - win + 1 >= 0) ? *(const unsigned*)(Z + (size_t)(t0 + s - win + 1) * ZLD + 1024 + c) : 0u; }
                }
                __builtin_amdgcn_sched_barrier(0);
#pragma unroll
                for (int q = 0; q < 8; ++q) { const int s = 8 * grp + q;
                    const unsigned v = vv[cu][q]; const float v0 = bflo(v), v1 = bfhi(v);
                    s0 += v0; s1 += v1;
                    const int pos = tb0 + s; const float icnt = __builtin_amdgcn_rcpf((float)((pos + 1 < win) ? pos + 1 : win));
                    *(unsigned*)(A2 + (size_t)(t0 + s) * D + 512 + c) = pk2(s0 * icnt - v0, s1 * icnt - v1);
                    const unsigned o = ov[cu][q]; s0 -= bflo(o); s1 -= bfhi(o);
                }
                __builtin_amdgcn_sched_barrier(0);
            }
        }
    }
}

namespace sm {
typedef LAS unsigned char* lp;
constexpr int TL = 8192;
constexpr int O_RAW = 0;
constexpr int O_LC = 40960;
constexpr int LCS = 68;
constexpr int O_TM = O_LC + 64 * LCS * 4;
constexpr int O_CM = O_TM + 4 * TL;
constexpr int O_X = O_CM + 4 * TL;
constexpr int O_S = O_X + 2 * TL;
constexpr int O_TB = O_S + 2 * TL;
constexpr int O_F = O_TB + 2048;
constexpr int O_END = O_F + (3 * 64 + 8 * 64 + 5 * 64) * 4;
static_assert(O_END <= MISC_OFF, "scan LDS map");
__device__ __forceinline__ int toff(int r, int c16) { return r * 128 + ((c16 ^ (r & 7)) << 4); }
typedef __bf16 bf16x2_t __attribute__((ext_vector_type(2)));
__device__ __forceinline__ unsigned cvtpk_s(float lo, float hi) { f32x2 v = {lo, hi}; bf16x2_t b = __builtin_convertvector(v, bf16x2_t); return __builtin_bit_cast(unsigned, b); }
__device__ __forceinline__ bf16x8 ldfrag(lp tile, int row, int c16) { return *(const LAS bf16x8*)(tile + toff(row, c16)); }
__device__ __forceinline__ f32x4 mm64(f32x4 acc, lp At, int m0, lp Bt, int n0, int lane) {
    const int r = lane & 15, q = lane >> 4;
#pragma unroll
    for (int ks = 0; ks < 2; ++ks) { const bf16x8 a = ldfrag(At, m0 + r, 4 * ks + q), b = ldfrag(Bt, n0 + r, 4 * ks + q); acc = __builtin_amdgcn_mfma_f32_16x16x32_bf16(a, b, acc, 0, 0, 0); }
    return acc;
}
__device__ __forceinline__ void st_nat(lp tile, int m0, int n0, f32x4 v, int lane) {
    const int n = n0 + (lane & 15), m = m0 + 4 * (lane >> 4);
    u32x2 w; w.x = cvtpk_s(v[0], v[1]); w.y = cvtpk_s(v[2], v[3]);
    *(LAS u32x2*)(tile + toff(n, m >> 3) + (m & 7) * 2) = w;
}
__device__ __forceinline__ f32x4 ld_nat(lp tile, int m0, int n0, int lane) {
    const int n = n0 + (lane & 15), m = m0 + 4 * (lane >> 4);
    const u32x2 w = *(const LAS u32x2*)(tile + toff(n, m >> 3) + (m & 7) * 2);
    return (f32x4){bflo(w.x), bfhi(w.x), bflo(w.y), bfhi(w.y)};
}
__device__ __forceinline__ float red8(float v) { return sum8_dpp(v); }
}

#define LBAR() asm volatile("s_waitcnt lgkmcnt(0)\n\ts_barrier" ::: "memory")
namespace sm {
constexpr int A_RAW = 0;
constexpr int A_LC = 4 * TL;
constexpr int A_TM = A_LC + 64 * LCS * 4;
constexpr int A_CM = A_TM + 4 * TL;
constexpr int A_X = A_CM + 4 * TL;
constexpr int A_S = A_X + 2 * TL;
constexpr int A_TB = A_S + 2 * TL;
constexpr int A_F = A_TB + 2048;
static_assert(A_F + 4096 <= MISC_OFF, "scan pass A LDS map");
constexpr int SEQQ = SEQ / 4, NCHQ = SEQQ / 64;
}
__device__ __forceinline__ void phase_scanA(Frame& F, const Args& A) {
    using namespace sm;
    const int unit = F.vcu, bh = unit >> 2, qq = unit & 3, b = bh / NH, h = bh % NH;
    const int tid = F.tid, lane = F.lane, w = F.wave;
    const int tA = tid >> 3, jsA = tid & 7;
    const int jB = tid & 63, qB = tid >> 6;
    lp L = F.lds;
    lp RAWk = L + A_RAW, RAWv = RAWk + TL, RAWw = RAWv + TL, RAWa = RAWw + TL;
    lp MabT = L + A_RAW, MkaT = MabT + TL, NbrT = MkaT + TL, NkrT = NbrT + TL; lp TG = MabT, TS = MkaT;
    LAS float* LC = (LAS float*)(L + A_LC); lp YT = L + A_LC, ZC = YT + TL;
    lp AtM = L + A_TM, RtM = AtM + TL, BtM = RtM + TL, KtM = BtM + TL; lp ZT = AtM, GcT = BtM;
    lp AtT = L + A_CM, BtT = AtT + TL, KtT = BtT + TL, VT = KtT + TL;
    lp XP = L + A_X, XQ = XP + TL;
    lp SG = L + A_S, SL = SG + TL;
    lp TB = L + A_TB;
    LAS float* FS = (LAS float*)(L + A_F); LAS float* DCv = FS; LAS float* INV = FS + 64; LAS float* BSC = FS + 128; LAS float* TOT = FS + 192; LAS float* PRM = FS + 192 + 512;
    if (tid < 64) { const int ch = h * HS + tid; PRM[tid] = A.in[I_KK][ch]; PRM[64 + tid] = A.in[I_KA][ch]; PRM[128 + tid] = A.in[I_RK][ch]; PRM[192 + tid] = A.in[I_W0][ch]; PRM[256 + tid] = A.in[I_A0][ch]; }
    { *(LAS u32x4*)(SG + tid * 16) = (u32x4){0u, 0u, 0u, 0u}; *(LAS u32x4*)(SL + tid * 16) = (u32x4){0u, 0u, 0u, 0u}; }
    LBAR();
    if (tid < 64) *(LAS bf16_t*)(SG + toff(tid, tid >> 3) + (tid & 7) * 2) = (bf16_t)0x3F80;
    const bf16_t* gR = (const bf16_t*)(F.ws + WS_R); const bf16_t* gK = (const bf16_t*)(F.ws + WS_K); const bf16_t* gV = (const bf16_t*)(F.ws + WS_V);
    const bf16_t* gL = (const bf16_t*)A.out;
    bf16_t* gYL = (bf16_t*)(F.ws + WS_R); bf16_t* gZC = (bf16_t*)(F.ws + WS_K); float* gBS = (float*)(F.ws + WS_BSC);
    const size_t trow0 = (size_t)b * SEQ + (size_t)qq * SEQQ;
    const size_t rowbase = (trow0 + tA) * D + h * HS + jsA * 8;
    const size_t lbase = (trow0 + tA) * LACT_LD + jsA * 8;
    u32x4 nr = *(const u32x4*)(gR + rowbase), nk = *(const u32x4*)(gK + rowbase), nv = *(const u32x4*)(gV + rowbase), nw = *(const u32x4*)(gL + lbase), na = *(const u32x4*)(gL + lbase + 64);
    const float kkwB = A.in[I_KK][h * HS + jB], kawB = A.in[I_KA][h * HS + jB];
    { const int o = toff(tA, jsA); *(LAS u32x4*)(AtM + o) = nw; *(LAS u32x4*)(RtM + o) = na; }
    const int l2kind = w >> 2, l2jb = w & 3;
    bf16x8 l2frag[2];
    { const bf16_t* l2W = (const bf16_t*)(F.ws + WS_WL2) + (size_t)((l2kind ? D : 0) + h * HS + 16 * l2jb + (lane & 15)) * 256 + (l2kind ? 64 : 0) + 8 * (lane >> 4);
      l2frag[0] = *(const bf16x8*)(l2W); l2frag[1] = *(const bf16x8*)(l2W + 32); }
    LBAR();
#pragma unroll 1
    for (int c = 0; c < NCHQ; ++c) {
        int tl_ = tid; asm volatile("" : "+v"(tl_));
        const int tid = tl_, lane = tl_ & 63, tA = tl_ >> 3, jsA = tl_ & 7, jB = tl_ & 63, qB = tl_ >> 6;
        const u32x4 cr = nr, ck = nk, cv = nv;
        { const int o = toff(tA, jsA); *(LAS u32x4*)(RAWk + o) = ck; *(LAS u32x4*)(RAWv + o) = cv; }
        if (c + 1 < NCHQ) { const size_t o = rowbase + (size_t)(c + 1) * 64 * D; nr = *(const u32x4*)(gR + o); nk = *(const u32x4*)(gK + o); nv = *(const u32x4*)(gV + o); nw = *(const u32x4*)(gL + lbase + (size_t)(c + 1) * 64 * LACT_LD); na = *(const u32x4*)(gL + lbase + (size_t)(c + 1) * 64 * LACT_LD + 64); }
        {
            lp Ht = l2kind ? RtM : AtM; lp Ot = l2kind ? RAWa : RAWw;
#pragma unroll
            for (int tb = 0; tb < 4; ++tb) {
                f32x4 acc = *(const LAS f32x4*)(PRM + (3 + l2kind) * 64 + 16 * l2jb + 4 * (lane >> 4));
#pragma unroll
                for (int ks = 0; ks < 2; ++ks) acc = __builtin_amdgcn_mfma_f32_16x16x32_bf16(l2frag[ks], ldfrag(Ht, 16 * tb + (lane & 15), 4 * ks + (lane >> 4)), acc, 0, 0, 0);
#pragma unroll
                for (int e = 0; e < 4; ++e) { const float sg = sigmoidf_(acc[e]); acc[e] = l2kind ? sg : -0.60653066f * sg; }
                st_nat(Ot, 16 * l2jb, 16 * tb, acc, lane);
            }
        }
        LBAR();
        const u32x4 cw = *(const LAS u32x4*)(RAWw + toff(tA, jsA)), ca = *(const LAS u32x4*)(RAWa + toff(tA, jsA));
        float kf[8], af[8], rf[8], wf[8];
        { const unsigned kw[4] = {ck.x, ck.y, ck.z, ck.w}, aw[4] = {ca.x, ca.y, ca.z, ca.w}, rw[4] = {cr.x, cr.y, cr.z, cr.w}, ww[4] = {cw.x, cw.y, cw.z, cw.w};
#pragma unroll
          for (int p = 0; p < 4; ++p) { kf[2 * p] = bflo(kw[p]); kf[2 * p + 1] = bfhi(kw[p]); af[2 * p] = bflo(aw[p]); af[2 * p + 1] = bfhi(aw[p]); rf[2 * p] = bflo(rw[p]); rf[2 * p + 1] = bfhi(rw[p]); wf[2 * p] = bflo(ww[p]); wf[2 * p + 1] = bfhi(ww[p]); } }
        float kkA[8], kpA[8];
        { const f32x4 k0 = *(const LAS f32x4*)(PRM + 8 * jsA), k1 = *(const LAS f32x4*)(PRM + 8 * jsA + 4), a0 = *(const LAS f32x4*)(PRM + 64 + 8 * jsA), a1 = *(const LAS f32x4*)(PRM + 64 + 8 * jsA + 4), r0 = *(const LAS f32x4*)(PRM + 128 + 8 * jsA), r1 = *(const LAS f32x4*)(PRM + 128 + 8 * jsA + 4);
          float ss = 0.f, bs = 0.f;
#pragma unroll
          for (int p = 0; p < 8; ++p) { const float kkw = p < 4 ? k0[p & 3] : k1[p & 3], kaw = p < 4 ? a0[p & 3] : a1[p & 3], rkw = p < 4 ? r0[p & 3] : r1[p & 3];
              kkA[p] = kf[p] * kkw; ss += kkA[p] * kkA[p]; kpA[p] = kf[p] * (1.0f + (af[p] - 1.0f) * kaw); bs += rf[p] * kpA[p] * rkw; }
          ss = red8(ss); bs = red8(bs);
          if (jsA == 0) { INV[tA] = 1.0f / fmaxf(sqrtf(ss), 1e-12f); BSC[tA] = bs; } }
        {
            float pw[8], wlv[8];
            float run = 0.f;
#pragma unroll
            for (int p = 0; p < 8; ++p) { const int t = 8 * qB + p; wlv[p] = bf1(*(const LAS bf16_t*)(RAWw + toff(t, jB >> 3) + (jB & 7) * 2)); run += wlv[p]; pw[p] = run; }
            TOT[qB * 64 + jB] = run;
            LBAR();
            float off = 0.f;
#pragma unroll
            for (int q2 = 0; q2 < 7; ++q2) off += (q2 < qB) ? TOT[q2 * 64 + jB] : 0.f;
            unsigned oa[4], ob[4], ok[4], ov[4];
            float pa = 0.f, pb = 0.f, pk = 0.f, pv = 0.f;
#pragma unroll
            for (int p = 0; p < 8; ++p) { const int t = 8 * qB + p; const int eo = toff(t, jB >> 3) + (jB & 7) * 2;
                const float kv = bf1(*(const LAS bf16_t*)(RAWk + eo)), av = bf1(*(const LAS bf16_t*)(RAWa + eo)), vv = bf1(*(const LAS bf16_t*)(RAWv + eo));
                const float lc = off + pw[p], lx = lc - wlv[p]; LC[t * LCS + jB] = lc;
                const float kkn = kv * kkwB * INV[t], kp = kv * (1.0f + (av - 1.0f) * kawB), em = __expf(-lc);
                const float xa = -kkn * __expf(lx), xb = kkn * av * em, xk = kp * em;
                if (p & 1) { oa[p >> 1] = pk2(pa, xa); ob[p >> 1] = pk2(pb, xb); ok[p >> 1] = pk2(pk, xk); ov[p >> 1] = pk2(pv, vv); } else { pa = xa; pb = xb; pk = xk; pv = vv; }
                if (t == 63) DCv[jB] = __expf(lc); }
            const int o = toff(jB, qB);
            *(LAS u32x4*)(AtT + o) = (u32x4){oa[0], oa[1], oa[2], oa[3]}; *(LAS u32x4*)(BtT + o) = (u32x4){ob[0], ob[1], ob[2], ob[3]}; *(LAS u32x4*)(KtT + o) = (u32x4){ok[0], ok[1], ok[2], ok[3]}; *(LAS u32x4*)(VT + o) = (u32x4){ov[0], ov[1], ov[2], ov[3]};
        }
        LBAR();
        {
            const f32x4 l0 = *(const LAS f32x4*)(LC + tA * LCS + 8 * jsA), l1 = *(const LAS f32x4*)(LC + tA * LCS + 8 * jsA + 4);
            const float inv = INV[tA];
            float xa[8], xr[8], xb[8], xk[8];
#pragma unroll
            for (int p = 0; p < 8; ++p) { const float lc = p < 4 ? l0[p & 3] : l1[p & 3]; const float em = __expf(-lc), ep = __expf(lc), kkn = kkA[p] * inv;
                xa[p] = -kkn * __expf(lc - wf[p]); xr[p] = rf[p] * ep; xb[p] = kkn * af[p] * em; xk[p] = kpA[p] * em; }
            const int o = toff(tA, jsA);
            *(LAS u32x4*)(AtM + o) = (u32x4){pk2(xa[0], xa[1]), pk2(xa[2], xa[3]), pk2(xa[4], xa[5]), pk2(xa[6], xa[7])};
            *(LAS u32x4*)(RtM + o) = (u32x4){pk2(xr[0], xr[1]), pk2(xr[2], xr[3]), pk2(xr[4], xr[5]), pk2(xr[6], xr[7])};
            *(LAS u32x4*)(BtM + o) = (u32x4){pk2(xb[0], xb[1]), pk2(xb[2], xb[3]), pk2(xb[4], xb[5]), pk2(xb[6], xb[7])};
            *(LAS u32x4*)(KtM + o) = (u32x4){pk2(xk[0], xk[1]), pk2(xk[2], xk[3]), pk2(xk[4], xk[5]), pk2(xk[6], xk[7])};
        }
        LBAR();
        float mcv[8]; McvDst mcd; const int mcid = (2 * c) * (256 * NWAVES) + unit * NWAVES + w; const bool mcon = mcid + 256 * NWAVES < MCV_ITEMS + 256 * NWAVES && mcid < MCV_ITEMS;
        if (mcon) mcd = mcv_load(A, F.ws, mcid, lane, mcv);
#pragma unroll 1
        for (int it = 0; it < 5; ++it) {
            const int n = w + 8 * it, X = n / 10, p = n % 10;
            const int tb = (p >= 6) ? 3 : (p >= 3) ? 2 : (p >= 1) ? 1 : 0, sb = p - (tb * (tb + 1)) / 2;
            lp Am = (X & 1) ? KtM : BtM; lp Bm = (X & 2) ? RtM : AtM; lp Om = L + A_RAW + X * TL;
            f32x4 acc = (f32x4){0.f, 0.f, 0.f, 0.f};
            acc = mm64(acc, Am, 16 * sb, Bm, 16 * tb, lane);
            if (sb == tb) { const int tin = lane & 15, s0 = 4 * (lane >> 4);
#pragma unroll
                for (int e = 0; e < 4; ++e) { const bool keep = (X & 2) ? (s0 + e <= tin) : (s0 + e < tin); if (!keep) acc[e] = 0.f; } }
            st_nat(Om, 16 * sb, 16 * tb, acc, lane);
        }
#pragma unroll 1
        for (int it = 0; it < 3; ++it) {
            const int n = w + 8 * it, X = n / 6, p = n % 6;
            const int tb = (p >= 5) ? 2 : (p >= 3) ? 1 : 0, sb = (tb == 0) ? p + 1 : (tb == 1) ? p - 1 : 3;
            st_nat(L + A_RAW + X * TL, 16 * sb, 16 * tb, (f32x4){0.f, 0.f, 0.f, 0.f}, lane);
        }
        LBAR();
        f32x4 rhs[4];
        if (w < 4) {
            if (lane < 16) {
                const int bb = w, r = lane; float Tr[16];
#pragma unroll
                for (int t = 0; t < 16; ++t) {
                    const u32x4 m0 = *(const LAS u32x4*)(MabT + toff(16 * bb + t, 2 * bb)), m1 = *(const LAS u32x4*)(MabT + toff(16 * bb + t, 2 * bb + 1));
                    const unsigned mw[8] = {m0.x, m0.y, m0.z, m0.w, m1.x, m1.y, m1.z, m1.w};
                    float acc = (r == t) ? 1.f : 0.f;
#pragma unroll
                    for (int s2 = 0; s2 < 16; ++s2) if (s2 < t) acc += Tr[s2] * ((s2 & 1) ? bfhi(mw[s2 >> 1]) : bflo(mw[s2 >> 1]));
                    Tr[t] = acc;
                }
#pragma unroll
                for (int t2 = 0; t2 < 16; ++t2) *(LAS bf16_t*)(TB + bb * 512 + t2 * 32 + r * 2) = (bf16_t)f2bf(Tr[t2]);
            }
#pragma unroll
            for (int bb = 0; bb < 4; ++bb) rhs[bb] = ld_nat(AtT, 16 * bb, 16 * w, lane);
        } else {
#pragma unroll
            for (int bb = 0; bb < 4; ++bb) rhs[bb] = mm64((f32x4){0.f, 0.f, 0.f, 0.f}, MkaT, 16 * bb, VT, 16 * (w - 4), lane);
        }
        { lp Xw = (w < 4 ? XP : XQ) + (16 * (w & 3)) * 128; *(LAS u32x4*)(Xw + lane * 32) = (u32x4){0u, 0u, 0u, 0u}; *(LAS u32x4*)(Xw + lane * 32 + 16) = (u32x4){0u, 0u, 0u, 0u}; }
        LBAR();
        {
            lp Xt = (w < 4) ? XP : XQ; const int r0 = 16 * (w & 3); const int q = lane >> 4, rr = lane & 15;
#pragma unroll
            for (int bb = 0; bb < 4; ++bb) {
                f32x4 acc = rhs[bb];
                if (bb > 0) acc = mm64(acc, MabT, 16 * bb, Xt, r0, lane);
                st_nat(Xt, 16 * bb, r0, acc, lane);
                asm volatile("s_waitcnt lgkmcnt(0)" ::: "memory");
                bf16x8 ta = (bf16x8){0, 0, 0, 0, 0, 0, 0, 0}, xb = ta;
                if (q < 2) { ta = *(const LAS bf16x8*)(TB + bb * 512 + rr * 32 + q * 16); xb = ldfrag(Xt, r0 + rr, 2 * bb + q); }
                const f32x4 d2 = __builtin_amdgcn_mfma_f32_16x16x32_bf16(ta, xb, (f32x4){0.f, 0.f, 0.f, 0.f}, 0, 0, 0);
                st_nat(Xt, 16 * bb, r0, d2, lane);
                asm volatile("s_waitcnt lgkmcnt(0)" ::: "memory");
            }
        }
        LBAR();
        if (mcon) mcv_store(mcd, mcv);
        const bool mcon2 = mcid + 256 * NWAVES < MCV_ITEMS;
        if (mcon2) mcd = mcv_load(A, F.ws, mcid + 256 * NWAVES, lane, mcv);
#pragma unroll 2
        for (int it = 0; it < 4; ++it) {
            const int id = 4 * w + it, nb = (id >> 2) & 3, mb = id & 3;
            if (id < 16) { f32x4 acc = ld_nat(RtM, 16 * mb, 16 * nb, lane);
                acc = mm64(acc, XP, 16 * mb, NbrT, 16 * nb, lane); st_nat(ZT, 16 * mb, 16 * nb, acc, lane); }
            else { f32x4 acc = mm64((f32x4){0.f, 0.f, 0.f, 0.f}, XP, 16 * mb, BtT, 16 * nb, lane);
                const int jn = 16 * nb + (lane & 15), jm = 16 * mb + 4 * (lane >> 4); const float dc = DCv[jn];
#pragma unroll
                for (int e = 0; e < 4; ++e) acc[e] = (acc[e] + ((jm + e == jn) ? 1.f : 0.f)) * dc;
                st_nat(GcT, 16 * mb, 16 * nb, acc, lane); }
        }
        LBAR();
#pragma unroll 2
        for (int it = 0; it < 8; ++it) {
            const int kind = it & 3, ti = (it >> 2) * 8 + w, nb = ti >> 2, mb = ti & 3;
            if (kind == 0) { f32x4 acc = mm64((f32x4){0.f, 0.f, 0.f, 0.f}, XQ, 16 * mb, NbrT, 16 * nb, lane); acc = mm64(acc, VT, 16 * mb, NkrT, 16 * nb, lane); acc = mm64(acc, SL, 16 * mb, ZT, 16 * nb, lane);
                st_nat(YT, 16 * mb, 16 * nb, acc, lane); }
            else if (kind == 1) { f32x4 acc = mm64((f32x4){0.f, 0.f, 0.f, 0.f}, BtT, 16 * mb, XQ, 16 * nb, lane); acc = mm64(acc, KtT, 16 * mb, VT, 16 * nb, lane);
                const f32x4 dc = *(const LAS f32x4*)(DCv + 16 * mb + 4 * (lane >> 4)); acc = acc * dc;
                acc = mm64(acc, GcT, 16 * mb, SL, 16 * nb, lane); st_nat(TS, 16 * mb, 16 * nb, acc, lane); }
            else if (kind == 2) { const f32x4 acc = mm64((f32x4){0.f, 0.f, 0.f, 0.f}, SG, 16 * mb, ZT, 16 * nb, lane); st_nat(ZC, 16 * mb, 16 * nb, acc, lane); }
            else { const f32x4 acc = mm64((f32x4){0.f, 0.f, 0.f, 0.f}, GcT, 16 * mb, SG, 16 * nb, lane); st_nat(TG, 16 * mb, 16 * nb, acc, lane); }
        }
        LBAR();
        {
            const int o = toff(tA, jsA);
            const u32x4 y16 = *(const LAS u32x4*)(YT + o), z16 = *(const LAS u32x4*)(ZC + o);
            const u32x4 g16 = *(const LAS u32x4*)(TG + tid * 16), s16 = *(const LAS u32x4*)(TS + tid * 16);
            const size_t go = rowbase + (size_t)c * 64 * D;
            *(u32x4*)(gYL + go) = y16; *(u32x4*)(gZC + go) = z16;
            if (jsA == 0) gBS[(trow0 + (size_t)c * 64 + tA) * NH + h] = BSC[tA];
            *(LAS u32x4*)(SG + tid * 16) = g16; *(LAS u32x4*)(SL + tid * 16) = s16;
            if (c + 1 < NCHQ) { *(LAS u32x4*)(AtM + o) = nw; *(LAS u32x4*)(RtM + o) = na; }
        }
        if (mcon2) mcv_store(mcd, mcv);
        LBAR();
    }
    { u32x4* seg = (u32x4*)(F.ws + WS_SEG) + (size_t)unit * 1024; seg[tid] = *(const LAS u32x4*)(SG + tid * 16); seg[512 + tid] = *(const LAS u32x4*)(SL + tid * 16); }
}
__device__ __forceinline__ void phase_scanB(Frame& F, const Args& A) {
    using namespace sm;
    const int unit = F.vcu, bh = unit >> 2, qq = unit & 3, b = bh / NH, h = bh % NH;
    const int tid = F.tid, lane = F.lane, w = F.wave;
    const int tA = tid >> 3, jsA = tid & 7;
    lp L = F.lds;
    LAS float* Sf = (LAS float*)L;
    LAS float* Gf = Sf + 64 * 65;
    lp SS = L + 40960, YLt = SS + TL, ZCt = YLt + TL; LAS float* LCy = (LAS float*)(ZCt + TL);
    LAS float* PRM = LCy + 64 * LCS;
    if (tid < 64) { const int ch = h * HS + tid; PRM[tid] = A.in[I_LNG][ch]; PRM[64 + tid] = A.in[I_LNB][ch]; }
    lp LgT = L + 90112, W2T = LgT + 3 * TL; LAS float* Gy = (LAS float*)(W2T + 3 * TL);
    { const bf16_t* W2 = (const bf16_t*)(F.ws + WS_WL2) + (size_t)(2 * D + h * HS + tA) * 256 + 8 * jsA;
#pragma unroll
      for (int i = 0; i < 3; ++i) *(LAS u32x4*)(W2T + i * TL + toff(tA, jsA)) = *(const u32x4*)(W2 + 64 * i); }
    const bf16_t* gL = (const bf16_t*)A.out;
    const int ci = tid >> 3, cj0 = (tid & 7) * 8;
    float sv[8];
#pragma unroll
    for (int p = 0; p < 8; ++p) sv[p] = 0.f;
    for (int q2 = 0; q2 < qq; ++q2) {
        const unsigned char* seg = (const unsigned char*)(F.ws + WS_SEG) + (size_t)(bh * 4 + q2) * 16384;
        const u32x4 g16 = *(const u32x4*)(seg + toff(ci, cj0 >> 3)), h16 = *(const u32x4*)(seg + 8192 + toff(ci, cj0 >> 3));
#pragma unroll
        for (int p = 0; p < 8; ++p) Sf[ci * 65 + cj0 + p] = sv[p];
        { const unsigned gw[4] = {g16.x, g16.y, g16.z, g16.w};
#pragma unroll
          for (int p = 0; p < 4; ++p) { Gf[ci * 64 + cj0 + 2 * p] = bflo(gw[p]); Gf[ci * 64 + cj0 + 2 * p + 1] = bfhi(gw[p]); } }
        LBAR();
        const unsigned hw[4] = {h16.x, h16.y, h16.z, h16.w};
        float o[8] = {bflo(hw[0]), bfhi(hw[0]), bflo(hw[1]), bfhi(hw[1]), bflo(hw[2]), bfhi(hw[2]), bflo(hw[3]), bfhi(hw[3])};
#pragma unroll 8
        for (int k = 0; k < 64; ++k) { const float sk = Sf[ci * 65 + k]; const f32x4 g0 = *(const LAS f32x4*)(Gf + k * 64 + cj0), g1 = *(const LAS f32x4*)(Gf + k * 64 + cj0 + 4);
            o[0] += sk * g0[0]; o[1] += sk * g0[1]; o[2] += sk * g0[2]; o[3] += sk * g0[3]; o[4] += sk * g1[0]; o[5] += sk * g1[1]; o[6] += sk * g1[2]; o[7] += sk * g1[3]; }
#pragma unroll
        for (int p = 0; p < 8; ++p) sv[p] = o[p];
        LBAR();
    }
    *(LAS u32x4*)(SS + toff(ci, cj0 >> 3)) = (u32x4){pk2(sv[0], sv[1]), pk2(sv[2], sv[3]), pk2(sv[4], sv[5]), pk2(sv[6], sv[7])};
    const bf16_t* gYL = (const bf16_t*)(F.ws + WS_R); const bf16_t* gZC = (const bf16_t*)(F.ws + WS_K); const bf16_t* gV = (const bf16_t*)(F.ws + WS_V); const bf16_t* gG = (const bf16_t*)(F.ws + WS_GG);
    const float* gBS = (const float*)(F.ws + WS_BSC); bf16_t* gO = (bf16_t*)(F.ws + WS_R);
    const size_t trow0 = (size_t)b * SEQ + (size_t)qq * SEQQ;
    const size_t rowbase = (trow0 + tA) * D + h * HS + jsA * 8;
    u32x4 ny = *(const u32x4*)(gYL + rowbase), nz = *(const u32x4*)(gZC + rowbase), nv = *(const u32x4*)(gV + rowbase), ng0, ng1, ng2; float nbs = gBS[(trow0 + tA) * NH + h];
    const size_t lbase = (trow0 + tA) * LACT_LD + 128 + jsA * 8;
    ng0 = *(const u32x4*)(gL + lbase); ng1 = *(const u32x4*)(gL + lbase + 64); ng2 = *(const u32x4*)(gL + lbase + 128);
    LBAR();
#pragma unroll 1
    for (int c = 0; c < NCHQ; ++c) {
        const u32x4 cy = ny, cz = nz, cv = nv; const float bs = nbs;
        { const int o = toff(tA, jsA); *(LAS u32x4*)(YLt + o) = cy; *(LAS u32x4*)(ZCt + o) = cz; *(LAS u32x4*)(LgT + o) = ng0; *(LAS u32x4*)(LgT + TL + o) = ng1; *(LAS u32x4*)(LgT + 2 * TL + o) = ng2; }
        if (c + 1 < NCHQ) { const size_t o = rowbase + (size_t)(c + 1) * 64 * D; ny = *(const u32x4*)(gYL + o); nz = *(const u32x4*)(gZC + o); nv = *(const u32x4*)(gV + o); nbs = gBS[(trow0 + (size_t)(c + 1) * 64 + tA) * NH + h];
            const size_t lo = lbase + (size_t)(c + 1) * 64 * LACT_LD; ng0 = *(const u32x4*)(gL + lo); ng1 = *(const u32x4*)(gL + lo + 64); ng2 = *(const u32x4*)(gL + lo + 128); }
        LBAR();
#pragma unroll
        for (int it = 0; it < 2; ++it) { const int mb = w & 3, nb = 2 * (w >> 2) + it;
            f32x4 acc = ld_nat(YLt, 16 * mb, 16 * nb, lane); acc = mm64(acc, SS, 16 * mb, ZCt, 16 * nb, lane);
            *(LAS f32x4*)(LCy + (16 * nb + (lane & 15)) * LCS + 16 * mb + 4 * (lane >> 4)) = acc;
            f32x4 ga = (f32x4){0.f, 0.f, 0.f, 0.f};
#pragma unroll
            for (int i = 0; i < 3; ++i) ga = mm64(ga, W2T + i * TL, 16 * mb, LgT + i * TL, 16 * nb, lane);
            *(LAS f32x4*)(Gy + (16 * nb + (lane & 15)) * LCS + 16 * mb + 4 * (lane >> 4)) = ga; }
        LBAR();
        {
            const f32x4 y0 = *(const LAS f32x4*)(LCy + tA * LCS + 8 * jsA), y1 = *(const LAS f32x4*)(LCy + tA * LCS + 8 * jsA + 4);
            float yv[8] = {y0[0], y0[1], y0[2], y0[3], y1[0], y1[1], y1[2], y1[3]};
            float s1 = 0.f;
#pragma unroll
            for (int p = 0; p < 8; ++p) s1 += yv[p];
            const float mean = red8(s1) * (1.0f / 64.0f); float s2 = 0.f;
#pragma unroll
            for (int p = 0; p < 8; ++p) { yv[p] -= mean; s2 += yv[p] * yv[p]; }
            const float rstd = rsqrtf(red8(s2) * (1.0f / 64.0f) + LNX_EPS);
            const f32x4 g0 = *(const LAS f32x4*)(PRM + 8 * jsA), g1 = *(const LAS f32x4*)(PRM + 8 * jsA + 4), b0 = *(const LAS f32x4*)(PRM + 64 + 8 * jsA), b1 = *(const LAS f32x4*)(PRM + 64 + 8 * jsA + 4);
            const unsigned vw[4] = {cv.x, cv.y, cv.z, cv.w};
            const f32x4 gq0 = *(const LAS f32x4*)(Gy + tA * LCS + 8 * jsA), gq1 = *(const LAS f32x4*)(Gy + tA * LCS + 8 * jsA + 4);
            float ov[8];
#pragma unroll
            for (int p = 0; p < 8; ++p) { const float lg = p < 4 ? g0[p & 3] : g1[p & 3], lb = p < 4 ? b0[p & 3] : b1[p & 3];
                const float vv = (p & 1) ? bfhi(vw[p >> 1]) : bflo(vw[p >> 1]), gg = p < 4 ? gq0[p & 3] : gq1[p & 3];
                ov[p] = (yv[p] * rstd * lg + lb + bs * vv) * gg; }
            *(u32x4*)(gO + rowbase + (size_t)c * 64 * D) = (u32x4){pk2(ov[0], ov[1]), pk2(ov[2], ov[3]), pk2(ov[4], ov[5]), pk2(ov[6], ov[7])};
        }
    }
}

__device__ __forceinline__ void phase_post3(Frame& F, const Args& A, const RowP& P) {
    LAS float* rt = (LAS float*)F.lds;
    LAS int* sel = (LAS int*)(F.lds + 32768);
    LAS int* cnts = (LAS int*)(F.lds + 32768 + 1024);
    LAS int* bef = (LAS int*)(F.lds + 32768 + 2048);
    for (int i = F.tid; i < D * NE / 4; i += NTHREADS) ((LAS f32x4*)rt)[i] = ((const f32x4*)A.in[I_ROUTER])[i];
    __syncthreads();
    int* toke = (int*)(F.ws + WS_TOKE); float* tokw = (float*)(F.ws + WS_TOKW); int* tokli = (int*)(F.ws + WS_TOKLI); int* cnt = (int*)(F.ws + WS_CNT);
    const int wgi = blockIdx.x;
    RowIn cur, nxt; row_load(P, wgi * 128 + F.wave * 16, F.lane, cur);
    for (int s = 0; s < 16; ++s) {
        const int tl = F.wave * 16 + s, t = wgi * 128 + tl;
        if (s + 1 < 16) row_load(P, t + 1, F.lane, nxt);
        f32x4 hv[4]; row_compute(P, t, F.lane, cur, hv, true); cur = nxt;
        float lg[8];
#pragma unroll
        for (int e = 0; e < 8; ++e) lg[e] = 0.f;
#pragma unroll
        for (int j = 0; j < 4; ++j)
#pragma unroll
            for (int q = 0; q < 4; ++q) { const int c = 4 * F.lane + 256 * j + q; const f32x4 r0 = *(const LAS f32x4*)(rt + c * 8), r1 = *(const LAS f32x4*)(rt + c * 8 + 4); const float hvv = hv[j][q];
                lg[0] += hvv * r0[0]; lg[1] += hvv * r0[1]; lg[2] += hvv * r0[2]; lg[3] += hvv * r0[3]; lg[4] += hvv * r1[0]; lg[5] += hvv * r1[1]; lg[6] += hvv * r1[2]; lg[7] += hvv * r1[3]; }
        {
            const bool h5 = F.lane & 32, h4 = F.lane & 16, h3 = F.lane & 8;
            float a4[4];
#pragma unroll
            for (int i = 0; i < 4; ++i) { const float mine = h5 ? lg[i + 4] : lg[i], send = h5 ? lg[i] : lg[i + 4]; a4[i] = mine + __shfl_xor(send, 32); }
            float a2[2];
#pragma unroll
            for (int i = 0; i < 2; ++i) { const float mine = h4 ? a4[i + 2] : a4[i], send = h4 ? a4[i] : a4[i + 2]; a2[i] = mine + __shfl_xor(send, 16); }
            float a1 = (h3 ? a2[1] : a2[0]) + __shfl_xor(h3 ? a2[0] : a2[1], 8);
            a1 += __shfl_xor(a1, 1); a1 += __shfl_xor(a1, 2); a1 += __shfl_xor(a1, 4);
#pragma unroll
            for (int e = 0; e < 8; ++e) lg[e] = __builtin_bit_cast(float, __builtin_amdgcn_readlane(__builtin_bit_cast(int, a1), e * 8));
        }
        int e0 = 0; float m0 = lg[0];
#pragma unroll
        for (int e = 1; e < 8; ++e) if (lg[e] > m0) { m0 = lg[e]; e0 = e; }
        int e1 = -1; float m1 = -3.0e38f;
#pragma unroll
        for (int e = 0; e < 8; ++e) if (e != e0 && lg[e] > m1) { m1 = lg[e]; e1 = e; }
        const float w1 = 1.0f / (1.0f + __expf(m0 - m1)), w0 = 1.0f - w1;
        if (F.lane == 0) { toke[2 * t] = e0; toke[2 * t + 1] = e1; tokw[2 * t] = w0; tokw[2 * t + 1] = w1; sel[2 * tl] = e0; sel[2 * tl + 1] = e1; }
    }
    __syncthreads();
    if (F.tid < 256) {
        const int e = sel[F.tid];
        int before = 0;
#pragma unroll
        for (int q = 0; q < 8; ++q) { const unsigned long long mk = __ballot(e == q); if (e == q) before = __popcll(mk & ((1ull << F.lane) - 1ull)); if (F.lane == 0) cnts[F.wave * 8 + q] = __popcll(mk); }
        bef[F.tid] = before;
    }
    __syncthreads();
    if (F.tid < 256) {
        const int p = F.tid, tl = p >> 1, t = wgi * 128 + tl; const int e = sel[p];
        int base = 0; for (int w = 0; w < F.wave; ++w) base += cnts[w * 8 + e];
        tokli[2 * t + (p & 1)] = base + bef[p];
    }
    if (F.tid < 8) cnt[wgi * 8 + F.tid] = cnts[F.tid] + cnts[8 + F.tid] + cnts[16 + F.tid] + cnts[24 + F.tid];
}
__device__ __forceinline__ void phase_route(Frame& F) {
    LAS int* tot = (LAS int*)F.lds;
    const int* cnt = (const int*)(F.ws + WS_CNT); const int wgi = blockIdx.x;
    { const int e = F.wave; int s = 0, pre = 0;
      for (int v = F.lane; v < 256; v += 64) { const int c = cnt[v * 8 + e]; s += c; if (v < wgi) pre += c; }
      s = (int)wave_sum((float)s); pre = (int)wave_sum((float)pre);
      if (F.lane == 0) { tot[e] = s; tot[8 + e] = pre; } }
    __syncthreads();
    if (F.tid == 0) { int st = 0; for (int e = 0; e < 8; ++e) { tot[16 + e] = st; st += ((tot[e] + 255) >> 8) << 8; } tot[24] = st; }
    __syncthreads();
    const int* toke = (const int*)(F.ws + WS_TOKE); const int* tokli = (const int*)(F.ws + WS_TOKLI); int* tokslot = (int*)(F.ws + WS_TOKSLOT); int* rowidx = (int*)(F.ws + WS_ROWIDX); int* tilee = (int*)(F.ws + WS_TILEE);
    if (F.tid < 256) { const int p = F.tid, t = wgi * 128 + (p >> 1), e = toke[2 * t + (p & 1)]; const int slot = tot[16 + e] + tot[8 + e] + tokli[2 * t + (p & 1)];
        tokslot[2 * t + (p & 1)] = slot; rowidx[slot] = t; }
    if (wgi < 8) { const int e = wgi; const int s0 = tot[16 + e] + tot[e], s1 = tot[16 + e] + (((tot[e] + 255) >> 8) << 8); for (int s = s0 + F.tid; s < s1; s += NTHREADS) rowidx[s] = 0; }
    if (wgi == 8) { const int nt = tot[24] >> 8; for (int i = F.tid; i < nt; i += NTHREADS) { int e = 0; for (int q = 1; q < 8; ++q) if (i * 256 >= tot[16 + q]) e = q; tilee[i] = e; }
        if (F.tid == 0) ((unsigned*)(F.ws + WS_CTL))[CW_MOE_NM] = (unsigned)nt; }
}
struct FinIn { u32x2 xw[4]; u32x2 a[4]; u32x2 c[4]; };
__device__ __forceinline__ void fin_load(FinIn& in, const float* out, const bf16_t* Y2, int t, int s0, int s1, int lane) {
    const GAS u32x2* xb = (const GAS u32x2*)((const bf16_t*)out + (size_t)t * 2048 + 1024) + lane;
    const GAS u32x2* y0 = (const GAS u32x2*)(Y2 + (size_t)s0 * D) + lane; const GAS u32x2* y1 = (const GAS u32x2*)(Y2 + (size_t)s1 * D) + lane;
#pragma unroll
    for (int j = 0; j < 4; ++j) in.xw[j] = xb[64 * j];
#pragma unroll
    for (int j = 0; j < 4; ++j) { in.a[j] = y0[64 * j]; in.c[j] = y1[64 * j]; }
}
__device__ __forceinline__ void phase_final(Frame& F, float* out, const float* gate, const float* gpost) {
    const int gw = F.vcu * NWAVES + F.wave, NGW = F.G * NWAVES; const int lane = F.lane;
    const int* tokslot = (const int*)(F.ws + WS_TOKSLOT); const float* tokw = (const float*)(F.ws + WS_TOKW); const bf16_t* Y2 = (const bf16_t*)(F.ws + WS_Y2);
    int t = gw; if (t >= T) return;
    FinIn cur, nxt;
    float w0 = tokw[2 * t], w1 = tokw[2 * t + 1];
    fin_load(cur, out, Y2, t, tokslot[2 * t], tokslot[2 * t + 1], lane);
    int tn = t + NGW;
    int s0n = 0, s1n = 0; float w0n = 0.f, w1n = 0.f;
    if (tn < T) { s0n = tokslot[2 * tn]; s1n = tokslot[2 * tn + 1]; w0n = tokw[2 * tn]; w1n = tokw[2 * tn + 1]; }
#pragma unroll 1
    for (; t < T; t = tn, tn += NGW) {
        int s0f = 0, s1f = 0; float w0f = 0.f, w1f = 0.f;
        if (tn < T) fin_load(nxt, out, Y2, tn, s0n, s1n, lane);
        { const int tf = tn + NGW; if (tf < T) { s0f = tokslot[2 * tf]; s1f = tokslot[2 * tf + 1]; w0f = tokw[2 * tf]; w1f = tokw[2 * tf + 1]; } }
        const int b = t / SEQ;
        f32x4 yv[4]; float ss = 0.f;
#pragma unroll
        for (int j = 0; j < 4; ++j) { const u32x2 a = cur.a[j], c = cur.c[j];
            yv[j] = (f32x4){w0 * bflo(a.x) + w1 * bflo(c.x), w0 * bfhi(a.x) + w1 * bfhi(c.x), w0 * bflo(a.y) + w1 * bflo(c.y), w0 * bfhi(a.y) + w1 * bfhi(c.y)};
            ss += (yv[j].x * yv[j].x + yv[j].y * yv[j].y) + (yv[j].z * yv[j].z + yv[j].w * yv[j].w); }
        const float rs = rsqrtf(wave_sum(ss) * (1.0f / D) + RMS_EPS);
        GAS f32x4* xo = (GAS f32x4*)(out + (size_t)t * D) + lane;
        asm volatile("" :: "v"(cur.xw[0].x), "v"(cur.xw[0].y), "v"(cur.xw[1].x), "v"(cur.xw[1].y), "v"(cur.xw[2].x), "v"(cur.xw[2].y), "v"(cur.xw[3].x), "v"(cur.xw[3].y) : "memory");
#pragma unroll
        for (int j = 0; j < 4; ++j) { const f32x4 gt = *((const f32x4*)(gate + (size_t)b * 6144) + lane + 64 * j); const f32x4 gp = *((const f32x4*)gpost + lane + 64 * j);
            const f32x4 xv = (f32x4){bflo(cur.xw[j].x), bfhi(cur.xw[j].x), bflo(cur.xw[j].y), bfhi(cur.xw[j].y)};
            xo[64 * j] = xv + gt * gp * yv[j] * rs; }
        cur = nxt; w0 = w0n; w1 = w1n; s0n = s0f; s1n = s1f; w0n = w0f; w1n = w1f;
    }
}
__device__ __forceinline__ void zero_h2_rows(Frame& F) {
    bf16_t* H2 = (bf16_t*)(F.ws + WS_H2);
    if (F.vcu < BATCH && F.tid < 128) ((u32x4*)(H2 + (size_t)F.vcu * (SEQ + 1) * D))[F.tid] = (u32x4){0u, 0u, 0u, 0u};
}

__device__ __forceinline__ bool launder(Frame& F) { int t = F.tid; asm volatile("" : "+v"(t)); F.tid = t; F.lane = t & 63; return true; }
constexpr int NPHASE = 22;
__device__ __forceinline__ pg8::GemmDesc mkdesc(const bf16_t* A, int lda, const bf16_t* Bt, int K, int nM, int nN, int mode, bf16_t* o0, int ldc) {
    pg8::GemmDesc g; g.A = A; g.Bt = Bt; g.lda = lda; g.K = K; g.nM = nM; g.nN = nN; g.a_bt = 0; g.a_bx = 0; g.a_pn_split = 1 << 30; g.a_pn_coloff = 0; g.a_pn_div = 1 << 30; g.a_pn_stride = 0; g.pn_bias = 0; g.rowidx = nullptr; g.tile_e = nullptr; g.b_estride = 0;
    g.mode = mode; g.o0 = o0; g.o1 = nullptr; g.o2 = nullptr; g.ldc = ldc; g.p0 = nullptr; g.p1 = nullptr; g.flag = 0; return g;
}

__global__ void __launch_bounds__(NTHREADS, 2) fwd_kernel(Args args) {
    extern __shared__ __attribute__((aligned(16))) unsigned char lds_raw[];
    Frame F;
    F.lds = (LAS unsigned char*)lds_raw;
    F.tid = threadIdx.x; F.lane = F.tid & 63; F.wave = __builtin_amdgcn_readfirstlane(F.tid >> 6);
    F.G = gridDim.x; { const int bx = blockIdx.x; F.vcu = (F.G % 8 == 0) ? (bx % 8) * (F.G / 8) + bx / 8 : bx; }
    F.ws = args.ws;
    volatile LAS unsigned* MISC = (volatile LAS unsigned*)(F.lds + MISC_OFF);
    if (F.tid < 16) MISC[F.tid] = 0u;
    __syncthreads();
    unsigned* ctl = (unsigned*)(F.ws + WS_CTL);
    XcdBarrier bar; bar.bar = ctl + CW_BAR; bar.x = 0; bar.st = nullptr;
#if N_LAUNCH_MODE == 0
    bar = xcd_barrier_post(ctl + CW_BAR, MISC + 8);
#endif
    unsigned char* ws = F.ws;
    const float* mod = (const float*)(ws + WS_MOD);
    const float* ng = args.in[I_NORMG];
    const int lo = args.ph_lo, hi = args.ph_hi;
    const int cid = (int)blockIdx.x;
#define MODP(l, ch) (mod + (size_t)(l) * 4 * 6144 + (ch) * D)
    bf16_t* H = (bf16_t*)(ws + WS_H);

#define PHASE(k) if (lo <= (k) && (k) < hi && launder(F))
#define INP(k) (lo <= (k) && (k) < hi)
#define SEAM(k) do { if (INP(k) && INP((k) + 1)) xcd_barrier(bar); } while (0)
#define GEMM(GATH, g) pg8::gemm_phase<GATH>(F.lds, g, F.G, cid, F.tid)
    PHASE(0) { phase_prologue(F, args); } SEAM(0);
    PHASE(1) { RowP P{args.in[I_X], nullptr, nullptr, nullptr, nullptr, ng + 0 * D, MODP(0, 1), MODP(0, 0), H, 0, nullptr, 0, 0}; phase_rows(F, P); } SEAM(1);
    PHASE(2) { pg8::GemmDesc g = mkdesc(H, D, (const bf16_t*)(ws + WS_WIN), D, T / 256, MIXIN / 256, pg8::EM_MIXIN, (bf16_t*)(ws + WS_Z), ZLD); GEMM(false, g); } SEAM(2);
    PHASE(3) { phase_mix(F, args); } SEAM(3);
    PHASE(4) { pg8::GemmDesc g = mkdesc((const bf16_t*)(ws + WS_A2), D, (const bf16_t*)(ws + WS_WOUTE), D, T / 256, D / 256, pg8::EM_BF16, (bf16_t*)(ws + WS_Y0), D); GEMM(false, g); } SEAM(4);
    PHASE(5) { RowP P{args.in[I_X], args.out, (const bf16_t*)(ws + WS_Y0), MODP(0, 2), ng + 1 * D, ng + 2 * D, MODP(0, 4), MODP(0, 3), H, 0, (float*)(ws + WS_XH), 0, 1}; phase_rows(F, P); } SEAM(5);
    PHASE(6) { pg8::GemmDesc g = mkdesc(H, D, (const bf16_t*)(ws + WS_WFGU), D, T / 256, 2 * FF / 256, pg8::EM_SWIGLU, (bf16_t*)(ws + WS_HFF), FF); GEMM(false, g); } SEAM(6);
    PHASE(7) { pg8::GemmDesc g = mkdesc((const bf16_t*)(ws + WS_HFF), FF, (const bf16_t*)(ws + WS_WFD), FF, T / 256, D / 256, pg8::EM_BF16, (bf16_t*)(ws + WS_Y0), D); GEMM(false, g); } SEAM(7);
    PHASE(8) { RowP P{args.out, args.out, (const bf16_t*)(ws + WS_Y0), MODP(0, 5), ng + 3 * D, ng + 4 * D, MODP(1, 1), MODP(1, 0), (bf16_t*)(ws + WS_H2), 1, nullptr, 1, 1}; phase_post2(F, args, P); zero_h2_rows(F); } SEAM(8);
    PHASE(9) {
        { pg8::GemmDesc g = mkdesc((const bf16_t*)(ws + WS_XR), D, (const bf16_t*)(ws + WS_WRKV), D, T / 256, 12, pg8::EM_RKVL, (bf16_t*)(ws + WS_R), D);
          g.a_pn_div = 4; g.a_pn_stride = (long)T * D; GEMM(false, g); }
        { pg8::GemmDesc g = mkdesc((const bf16_t*)(ws + WS_H2), D, (const bf16_t*)(ws + WS_WLOR), 2 * D, T / 256, 2, pg8::EM_RKVL, (bf16_t*)(ws + WS_R), D);
          g.a_bt = SEQ / 256; g.a_bx = 1; g.o1 = (bf16_t*)args.out; g.pn_bias = 12; GEMM(false, g); } } SEAM(9);
    PHASE(11) { phase_scanA(F, args); } SEAM(11);
    PHASE(12) { phase_scanB(F, args); } SEAM(12);
    PHASE(14) { pg8::GemmDesc g = mkdesc((const bf16_t*)(ws + WS_R), D, (const bf16_t*)(ws + WS_WO), D, T / 256, D / 256, pg8::EM_BF16, (bf16_t*)(ws + WS_Y1), D); GEMM(false, g);
        } SEAM(14);
    PHASE(15) { RowP P{args.out, args.out, (const bf16_t*)(ws + WS_Y1), MODP(1, 2), ng + 5 * D, ng + 6 * D, MODP(1, 4), MODP(1, 3), (bf16_t*)(ws + WS_H3), 0, nullptr, 1, 1}; phase_post3(F, args, P); } SEAM(15);
    PHASE(16) { phase_route(F); } SEAM(16);
#define MOE1(p1) PHASE(p1) { const int moe_nm = (int)__hip_atomic_load(ctl + CW_MOE_NM, __ATOMIC_RELAXED, __HIP_MEMORY_SCOPE_AGENT); \
        pg8::GemmDesc g = mkdesc((const bf16_t*)(ws + WS_H3), D, (const bf16_t*)(ws + WS_WMGU), D, moe_nm, 2 * FH / 256, pg8::EM_SWIGLU, (bf16_t*)(ws + WS_HM), FH); \
        g.rowidx = (const int*)(ws + WS_ROWIDX); g.tile_e = (const int*)(ws + WS_TILEE); g.b_estride = (long)FF * D; GEMM(true, g); } SEAM(p1)
#define MOE2(p2, half) PHASE(p2) { const int moe_nm = (int)__hip_atomic_load(ctl + CW_MOE_NM, __ATOMIC_RELAXED, __HIP_MEMORY_SCOPE_AGENT); \
        pg8::GemmDesc g = mkdesc((const bf16_t*)(ws + WS_HM), FH, (const bf16_t*)(ws + (half ? WS_WMD1 : WS_WMD0)), FH, moe_nm, D / 256, pg8::EM_MOE2, (bf16_t*)(ws + WS_Y2), D); \
        g.tile_e = (const int*)(ws + WS_TILEE); g.b_estride = (long)D * FH; g.flag = half; GEMM(false, g); \
        if (half == 0) { __syncthreads();     \
            const int nbusy = (moe_nm * (D / 256)) % F.G; const bool excl = nbusy > 0 && nbusy <= 64; \
            if (!(excl && cid < nbusy)) moe_convert(F, args, 0, 1, (bf16_t*)(ws + WS_WMGU), excl ? cid - nbusy : F.vcu, excl ? F.G - nbusy : F.G); \
            __syncthreads(); } } SEAM(p2)
    MOE1(17); MOE2(18, 0); MOE1(19); MOE2(20, 1);
#undef MOE1
#undef MOE2
    PHASE(21) { phase_final(F, args.out, MODP(1, 5), ng + 7 * D); }
#undef PHASE
#undef INP
#undef SEAM
#undef GEMM
#undef MODP
}

extern "C" void kernel_launch(void* const* d_in, const int* in_sizes, int n_in, void* d_out, int out_size, void* d_ws, size_t ws_size, hipStream_t stream) {
    static int grid = 0;
    if (grid == 0) {
        if (n_in != 35 || in_sizes[0] != T * D || out_size != T * D || ws_size < WS_END) { fprintf(stderr, "kernel_launch: unexpected shapes: n_in %d in0 %d out %d ws %zu (need %zu)\n", n_in, n_in > 0 ? in_sizes[0] : -1, out_size, ws_size, (size_t)WS_END); grid = -1; return; }
        int dev = 0, cus = 0, per_cu = 0;
        if (hipGetDevice(&dev) != hipSuccess || hipDeviceGetAttribute(&cus, hipDeviceAttributeMultiprocessorCount, dev) != hipSuccess) { grid = -1; return; }
        if (hipFuncSetAttribute((const void*)fwd_kernel, hipFuncAttributeMaxDynamicSharedMemorySize, LDS_BYTES) != hipSuccess) { fprintf(stderr, "kernel_launch: hipFuncSetAttribute failed\n"); grid = -1; return; }
        if (hipOccupancyMaxActiveBlocksPerMultiprocessor(&per_cu, (const void*)fwd_kernel, NTHREADS, LDS_BYTES) != hipSuccess || per_cu < 1) fprintf(stderr, "kernel_launch: occupancy query reports %d\n", per_cu);
        (void)hipGetLastError();
        grid = cus;
        if (grid != 256) fprintf(stderr, "kernel_launch: %d CUs (built for 256)\n", grid);
    }
    if (grid < 0) return;
    (void)hipMemsetAsync((char*)d_ws + WS_CTL, 0, CTL_ZERO_BYTES, stream);
    Args a{};
    for (int i = 0; i < 35; ++i) a.in[i] = (const float*)d_in[i];
    a.out = (float*)d_out; a.ws = (unsigned char*)d_ws;
#if N_LAUNCH_MODE == 0
    a.ph_lo = 0; a.ph_hi = NPHASE;
    hipLaunchKernelGGL(fwd_kernel, dim3(grid), dim3(NTHREADS), LDS_BYTES, stream, a);
#else
    for (int p = 0; p < NPHASE; ++p) { a.ph_lo = p; a.ph_hi = p + 1; hipLaunchKernelGGL(fwd_kernel, dim3(grid), dim3(NTHREADS), LDS_BYTES, stream, a); }
#endif
}
```

```cpp
#include <hip/hip_runtime.h>
#include <cstdio>
#include <cstdint>

#ifndef N_LAUNCH_MODE
#define N_LAUNCH_MODE 0
#endif

#define LAS __attribute__((address_space(3)))
#define GAS __attribute__((address_space(1)))
typedef unsigned short bf16_t;
typedef short bf16x8 __attribute__((ext_vector_type(8)));
typedef float f32x4 __attribute__((ext_vector_type(4)));
typedef float f32x2 __attribute__((ext_vector_type(2)));
typedef unsigned u32x4 __attribute__((ext_vector_type(4)));
typedef unsigned u32x2 __attribute__((ext_vector_type(2)));

constexpr int D = 1024, BATCH = 4, SEQ = 8192, T = BATCH * SEQ, FF = 2816, FH = FF / 2, NE = 8, NH = 16, HS = 64;
constexpr int MIXIN = 2048, DCONV = 512, DPOOL = 512;
constexpr int ZLD = 1536;
constexpr float RMS_EPS = 1e-6f, LNX_EPS = 64e-5f;
constexpr int NWAVES = 8, NTHREADS = 512;
constexpr int MOE_MAXROWS = 2 * T + NE * 256;
constexpr int H2ROWS = BATCH * (SEQ + 1);

constexpr size_t MiB = 1u << 20;
constexpr size_t WS_CTL = 0, CTL_ZERO_BYTES = 256 * 1024;
constexpr size_t WS_MOD = 1 * MiB;
constexpr size_t WS_TOKE = 2 * MiB;
constexpr size_t WS_TOKW = WS_TOKE + (size_t)T * 8;
constexpr size_t WS_TOKLI = WS_TOKW + (size_t)T * 8;
constexpr size_t WS_TOKSLOT = WS_TOKLI + (size_t)T * 8;
constexpr size_t WS_CNT = WS_TOKSLOT + (size_t)T * 8;
constexpr size_t WS_ROWIDX = WS_CNT + 8192;
constexpr size_t WS_TILEE = WS_ROWIDX + (size_t)MOE_MAXROWS * 4;
static_assert(WS_TILEE + 4096 <= 4 * MiB, "route tables");
constexpr size_t WS_WIN = 4 * MiB, WS_WOUTE = 8 * MiB, WS_WFGU = 10 * MiB, WS_WFD = 21 * MiB, WS_WRKV = 26 * MiB + 512 * 1024, WS_WLOR = 32 * MiB + 512 * 1024, WS_WL2 = 504 * MiB, WS_WO = 493 * MiB;
constexpr size_t WS_WMGU = 4 * MiB, WS_WMD0 = 48 * MiB, WS_WMD1 = 70 * MiB;
constexpr size_t WS_H = 44 * MiB, WS_Z = 172 * MiB, WS_A2 = 300 * MiB, WS_HFF = 172 * MiB, WS_Y0 = 364 * MiB;
constexpr size_t WS_H2 = 44 * MiB, WS_XR = 109 * MiB, WS_XK = 173 * MiB, WS_XV = 237 * MiB, WS_R = 301 * MiB, WS_K = 365 * MiB, WS_V = 429 * MiB, WS_LACT = 4 * MiB, WS_WLOG = 109 * MiB, WS_AA = 173 * MiB, WS_GG = 237 * MiB, WS_Y1 = 173 * MiB;
constexpr size_t WS_XH = 495 * MiB;
constexpr int LACT_LD = 2048, LACT_W = 384;
constexpr size_t WS_BSC = 495 * MiB, WS_SEG = 497 * MiB;
constexpr size_t WS_H3 = 446 * MiB, WS_HM = 264 * MiB, WS_Y2 = 132 * MiB, WS_END = 510 * MiB;
static_assert(WS_H2 + (size_t)H2ROWS * D * 2 <= WS_XR, "h2");
static_assert(WS_HM + (size_t)MOE_MAXROWS * FH * 2 <= WS_H3, "hm");
static_assert(WS_Y2 + (size_t)MOE_MAXROWS * D * 2 <= WS_HM, "y2");
constexpr int CW_MOE_NM = 64;
constexpr int CW_BAR = 4096;

__device__ __forceinline__ unsigned f2bf(float f) { unsigned u = __builtin_bit_cast(unsigned, f); return (u + 0x7fffu + ((u >> 16) & 1u)) >> 16; }
typedef __bf16 bf16x2_hw __attribute__((ext_vector_type(2)));
typedef float f32x2_hw __attribute__((ext_vector_type(2)));
__device__ __forceinline__ unsigned pk2(float lo, float hi) { f32x2_hw v = {lo, hi}; return __builtin_bit_cast(unsigned, __builtin_convertvector(v, bf16x2_hw)); }
__device__ __forceinline__ float bflo(unsigned w) { return __builtin_bit_cast(float, w << 16); }
__device__ __forceinline__ float bfhi(unsigned w) { return __builtin_bit_cast(float, w & 0xffff0000u); }
__device__ __forceinline__ float bf1(bf16_t b) { return __builtin_bit_cast(float, (unsigned)b << 16); }
template <int CTRL> __device__ __forceinline__ float dppf(float v) { return __builtin_bit_cast(float, __builtin_amdgcn_update_dpp(0, __builtin_bit_cast(int, v), CTRL, 0xF, 0xF, true)); }
__device__ __forceinline__ float sum8_dpp(float v) { v += dppf<0xB1>(v); v += dppf<0x4E>(v); v += dppf<0x141>(v); return v; }
__device__ __forceinline__ float wave_sum(float v) { v = sum8_dpp(v); v += dppf<0x140>(v); v += __shfl_xor(v, 16); v += __shfl_xor(v, 32); return v; }
__device__ __forceinline__ float sigmoidf_(float x) { return __builtin_amdgcn_rcpf(1.0f + __expf(-x)); }
__device__ __forceinline__ float siluf_(float x) { return x * __builtin_amdgcn_rcpf(1.0f + __expf(-x)); }
__device__ __forceinline__ float tanhf_(float x) { const float e = __expf(-2.0f * fabsf(x)); const float t = (1.0f - e) * __builtin_amdgcn_rcpf(1.0f + e); return x < 0.f ? -t : t; }
__device__ __forceinline__ float softplusf_(float z) { return fmaxf(z, 0.f) + log1pf(__expf(-fabsf(z))); }

namespace pg8 {
constexpr int BM = 256, BK = 64, HALF = 128, HTB = HALF * BK * 2, STAGE_BYTES = 8 * HTB, NXCD = 8, WGM = 8;
__host__ __device__ __forceinline__ int lds_byte(int r, int c) { const int st = (r >> 4) * 2 + (c >> 5), rr = r & 15, cc = c & 31, ob = rr * 64 + cc * 2; return st * 1024 + (ob ^ (((ob >> 9) & 1) << 5)); }
__host__ __device__ __forceinline__ void stage_rc(int b, int& R, int& C) { const int st = b / 1024, sb = b % 1024, swz = sb ^ (((sb >> 9) & 1) << 5); R = (st >> 1) * 16 + swz / 64; C = (st & 1) * 32 + (swz % 64) / 2; }
__host__ __device__ __forceinline__ int perm32(int rho) { const int n = rho >> 4, i = rho & 15; return 8 * (i >> 2) + 4 * n + (i & 3); }

struct Unit { int pm, pn; };
enum { EM_BF16 = 0, EM_SWIGLU = 1, EM_RKVL = 2, EM_LORA2 = 3, EM_MOE2 = 4, EM_MIXIN = 5 };
struct GemmDesc {
    const bf16_t* A; const bf16_t* Bt;
    int lda, K, nM, nN;
    int a_bt, a_bx;
    int a_pn_split, a_pn_coloff;
    int a_pn_div; long a_pn_stride;
    int pn_bias;
    const int* rowidx;
    const int* tile_e; long b_estride;
    int mode;
    bf16_t* o0; bf16_t* o1; bf16_t* o2; int ldc;
    const float* p0;
    const float* p1;
    int flag;
};
__device__ __forceinline__ size_t a_off_bytes(const GemmDesc& g, const Unit& u) {
    size_t rows = (size_t)u.pm * BM; if (g.a_bt) rows += (size_t)(u.pm / g.a_bt) * g.a_bx;
    size_t o = rows * (size_t)g.lda; if (u.pn >= g.a_pn_split) o += g.a_pn_coloff; o += (size_t)(u.pn / g.a_pn_div) * (size_t)g.a_pn_stride; return o * 2;
}
__device__ __forceinline__ size_t b_off_bytes(const GemmDesc& g, const Unit& u) {
    size_t o = (size_t)u.pn * BM * (size_t)g.K; if (g.tile_e) o += (size_t)__builtin_amdgcn_readfirstlane(g.tile_e[u.pm]) * (size_t)g.b_estride; return o * 2;
}
struct StaticOrder {
    int nM, nN, nwg, G, c;
    __device__ void init(int nM_, int nN_, int G_, int c_) { nM = nM_; nN = nN_; nwg = nM * nN; G = G_; c = c_; }
    __device__ bool next(int i, Unit& u) const {
        const long L = (long)i * G + c; if (L >= nwg) return false;
        int wgid = (int)L; { const int q = nwg / NXCD, r = nwg % NXCD, xcd = wgid % NXCD, off = wgid / NXCD; wgid = (xcd < r ? xcd * (q + 1) : r * (q + 1) + (xcd - r) * q) + off; }
        const int nig = WGM * nN, gid = wgid / nig, fm = gid * WGM, gsz = (nM - fm) < WGM ? (nM - fm) : WGM;
        u.pm = fm + ((wgid % nig) % gsz); u.pn = (wgid % nig) / gsz; return true;
    }
};
typedef __bf16 bf16x2_t_ __attribute__((ext_vector_type(2)));
__device__ __forceinline__ unsigned cvt_pk_bf16(float lo, float hi) { f32x2 v = {lo, hi}; bf16x2_t_ b = __builtin_convertvector(v, bf16x2_t_); return __builtin_bit_cast(unsigned, b); }

__device__ __forceinline__ unsigned dpp_x8(unsigned x) { return (unsigned)__builtin_amdgcn_update_dpp(0, (int)x, 0x128, 0xF, 0xF, true); }
__device__ __forceinline__ float dpp_x8f(float x) { return __builtin_bit_cast(float, dpp_x8(__builtin_bit_cast(unsigned, x))); }
template <int ACT, int AI_LO, int AI_HI>
__device__ __forceinline__ void store_tiles(const f32x4 (&acc)[2][2][4][2], bf16_t* bq, int ldc, int colw, int fr, int fq, const float* bias, int climit = 1 << 30) {
    const bool lo = fr < 8;
    const int chA = lo ? fq : 4 + fq, chB = lo ? 4 + fq : fq;
    bf16_t* pA = bq + (size_t)(fr & 7) * ldc + chA * 8;
    bf16_t* pB = bq + (size_t)(8 + (fr & 7)) * ldc + chB * 8;
    const bool okA = (ACT != 1) || (colw + chA * 8 < climit), okB = (ACT != 1) || (colw + chB * 8 < climit);
    f32x4 bb[2][2];
    int cls[2];
#pragma unroll
    for (int bj = 0; bj < 2; ++bj) {
        const int col = colw + bj * 32 + 8 * fq;
        bb[bj][0] = (f32x4){0.f, 0.f, 0.f, 0.f}; bb[bj][1] = bb[bj][0];
        if (ACT >= 2) { bb[bj][0] = *(const f32x4*)(bias + col); bb[bj][1] = *(const f32x4*)(bias + col + 4); }
        cls[bj] = (ACT == 1) ? (col < 64 ? 0 : (col < 128 ? 1 : (col < 288 ? 2 : 3))) : 0;
    }
#pragma unroll
    for (int ai = AI_LO; ai < AI_HI; ++ai)
#pragma unroll
        for (int m = 0; m < 4; ++m) {
            u32x4 w[2];
#pragma unroll
            for (int bj = 0; bj < 2; ++bj) {
                float v[8];
#pragma unroll
                for (int j = 0; j < 4; ++j) { v[j] = acc[ai][bj][m][0][j]; v[4 + j] = acc[ai][bj][m][1][j]; }
#pragma unroll
                for (int j = 0; j < 8; ++j) {
                    const float b_ = (j < 4) ? bb[bj][0][j & 3] : bb[bj][1][j & 3];
                    if (ACT == 1) { const float x = v[j]; v[j] = (cls[bj] == 0) ? tanhf_(x) : (cls[bj] == 1 ? x : (cls[bj] == 2 ? sigmoidf_(x) : 0.f)); }
                    else if (ACT == 2) v[j] = -0.60653066f * sigmoidf_(b_ + v[j]);
                    else if (ACT == 3) v[j] = sigmoidf_(b_ + v[j]);
                }
                w[bj].x = cvt_pk_bf16(v[0], v[1]); w[bj].y = cvt_pk_bf16(v[2], v[3]); w[bj].z = cvt_pk_bf16(v[4], v[5]); w[bj].w = cvt_pk_bf16(v[6], v[7]);
            }
            u32x4 p1; p1.x = dpp_x8(w[1].x); p1.y = dpp_x8(w[1].y); p1.z = dpp_x8(w[1].z); p1.w = dpp_x8(w[1].w);
            u32x4 dA, dB;
            dA.x = lo ? w[0].x : p1.x; dA.y = lo ? w[0].y : p1.y; dA.z = lo ? w[0].z : p1.z; dA.w = lo ? w[0].w : p1.w;
            dB.x = lo ? p1.x : w[0].x; dB.y = lo ? p1.y : w[0].y; dB.z = lo ? p1.z : w[0].z; dB.w = lo ? p1.w : w[0].w;
            const size_t ro = (size_t)(ai * HALF + m * 16) * ldc;
            if (okA) *(u32x4*)(pA + ro) = dA;
            if (okB) *(u32x4*)(pB + ro) = dB;
        }
}
template <int AI_LO = 0, int AI_HI = 2>
__device__ __forceinline__ void epilogue(const GemmDesc& g, const f32x4 (&acc)[2][2][4][2], const Unit& u, int wr, int wc, int fr, int fq) {
    const int row0 = u.pm * BM + wr * 64 + fr;
    const int cin = wc * 32 + 8 * fq;
    if (g.mode == EM_MIXIN && u.pn >= 2 && u.pn < 6) {
#pragma unroll
        for (int ai = AI_LO; ai < AI_HI; ++ai)
#pragma unroll
            for (int m = 0; m < 4; ++m) {
                bf16_t* rowp = g.o0 + (size_t)(row0 + ai * HALF + m * 16) * g.ldc + 512 + (u.pn - 2) * HALF + cin;
                const f32x4 g0 = acc[ai][0][m][0], g1 = acc[ai][0][m][1], u0 = acc[ai][1][m][0], u1 = acc[ai][1][m][1];
                u32x4 w;
                w.x = cvt_pk_bf16(g0[0] * u0[0], g0[1] * u0[1]); w.y = cvt_pk_bf16(g0[2] * u0[2], g0[3] * u0[3]);
                w.z = cvt_pk_bf16(g1[0] * u1[0], g1[1] * u1[1]); w.w = cvt_pk_bf16(g1[2] * u1[2], g1[3] * u1[3]);
                *(u32x4*)rowp = w;
            }
        return;
    }
    if (g.mode == EM_SWIGLU) {
#pragma unroll
        for (int ai = AI_LO; ai < AI_HI; ++ai)
#pragma unroll
            for (int m = 0; m < 4; ++m) {
                bf16_t* rowp = g.o0 + (size_t)(row0 + ai * HALF + m * 16) * g.ldc + u.pn * HALF + cin;
                const f32x4 g0 = acc[ai][0][m][0], g1 = acc[ai][0][m][1], u0 = acc[ai][1][m][0], u1 = acc[ai][1][m][1];
                u32x4 w;
                w.x = cvt_pk_bf16(siluf_(g0[0]) * u0[0], siluf_(g0[1]) * u0[1]); w.y = cvt_pk_bf16(siluf_(g0[2]) * u0[2], siluf_(g0[3]) * u0[3]);
                w.z = cvt_pk_bf16(siluf_(g1[0]) * u1[0], siluf_(g1[1]) * u1[1]); w.w = cvt_pk_bf16(siluf_(g1[2]) * u1[2], siluf_(g1[3]) * u1[3]);
                *(u32x4*)rowp = w;
            }
        return;
    }
    if (g.mode == EM_MOE2) {
        const bool lo = fr < 8;
        const int chA = lo ? fq : 4 + fq, chB = lo ? 4 + fq : fq;
        bf16_t* q = g.o0 + (size_t)(u.pm * BM + wr * 64) * g.ldc + u.pn * BM + wc * 64;
        bf16_t* pA = q + (size_t)(fr & 7) * g.ldc + chA * 8;
        bf16_t* pB = q + (size_t)(8 + (fr & 7)) * g.ldc + chB * 8;
        u32x4 oa_[2][4], ob_[2][4];
#pragma unroll
        for (int ai = AI_LO; ai < AI_HI; ++ai) {
        if (g.flag) {
#pragma unroll
            for (int m = 0; m < 4; ++m) { const size_t ro = (size_t)(ai * HALF + m * 16) * g.ldc; oa_[ai][m] = *(const u32x4*)(pA + ro); ob_[ai][m] = *(const u32x4*)(pB + ro); }
        }
        __builtin_amdgcn_sched_barrier(0);
#pragma unroll
            for (int m = 0; m < 4; ++m) {
                const size_t ro = (size_t)(ai * HALF + m * 16) * g.ldc;
                float dA[8], dB[8];
#pragma unroll
                for (int j = 0; j < 8; ++j) {
                    const float a0 = acc[ai][0][m][j >> 2][j & 3], a1 = acc[ai][1][m][j >> 2][j & 3];
                    const float p1 = dpp_x8f(a1);
                    dA[j] = lo ? a0 : p1; dB[j] = lo ? p1 : a0;
                }
                if (g.flag) { const u32x4 oa = oa_[ai][m], ob = ob_[ai][m];
                    dA[0] += bflo(oa.x); dA[1] += bfhi(oa.x); dA[2] += bflo(oa.y); dA[3] += bfhi(oa.y); dA[4] += bflo(oa.z); dA[5] += bfhi(oa.z); dA[6] += bflo(oa.w); dA[7] += bfhi(oa.w);
                    dB[0] += bflo(ob.x); dB[1] += bfhi(ob.x); dB[2] += bflo(ob.y); dB[3] += bfhi(ob.y); dB[4] += bflo(ob.z); dB[5] += bfhi(ob.z); dB[6] += bflo(ob.w); dB[7] += bfhi(ob.w); }
                u32x4 wa, wb;
                wa.x = cvt_pk_bf16(dA[0], dA[1]); wa.y = cvt_pk_bf16(dA[2], dA[3]); wa.z = cvt_pk_bf16(dA[4], dA[5]); wa.w = cvt_pk_bf16(dA[6], dA[7]);
                wb.x = cvt_pk_bf16(dB[0], dB[1]); wb.y = cvt_pk_bf16(dB[2], dB[3]); wb.z = cvt_pk_bf16(dB[4], dB[5]); wb.w = cvt_pk_bf16(dB[6], dB[7]);
                *(u32x4*)(pA + ro) = wa; *(u32x4*)(pB + ro) = wb;
            }
        __builtin_amdgcn_sched_barrier(0);
        }
        return;
    }
    int act = 0; bf16_t* base = g.o0; int colt = u.pn * BM; int ldc = g.ldc;
    if (g.mode == EM_MIXIN) colt = (u.pn < 2) ? u.pn * BM : 1024 + (u.pn - 6) * BM;
    else if (g.mode == EM_RKVL) {
        const int pnb = u.pn + g.pn_bias;
        if (pnb < 12) { const int t = pnb >> 2; base = g.o0 + (size_t)t * T * D; colt = (pnb & 3) * BM; }
        else { base = g.o1; colt = (pnb - 12) * BM; ldc = LACT_LD; act = 1; }
    } else if (g.mode == EM_LORA2) {
        const int t = (u.pn + g.pn_bias) >> 2; base = (t == 0) ? g.o0 : (t == 1 ? g.o1 : g.o2); colt = (u.pn & 3) * BM; act = (t == 2) ? 0 : 2 + t;
    }
    const int colw = colt + wc * 64;
    bf16_t* bq = base + (size_t)(u.pm * BM + wr * 64) * ldc + colw;
    if (act == 0) store_tiles<0, AI_LO, AI_HI>(acc, bq, ldc, colw, fr, fq, nullptr);
    else if (act == 1) store_tiles<1, AI_LO, AI_HI>(acc, bq, ldc, colw, fr, fq, nullptr, LACT_W);
    else if (act == 2) store_tiles<2, AI_LO, AI_HI>(acc, bq, ldc, colw, fr, fq, g.p0);
    else store_tiles<3, AI_LO, AI_HI>(acc, bq, ldc, colw, fr, fq, g.p1);
}

template <bool GATHER>
__device__ __forceinline__ void unit_offs_f(const GemmDesc& g, const Unit& u, const int (&Rl)[2], const int (&Cl)[2], unsigned (&o)[2][2]) {
#pragma unroll
    for (int h = 0; h < 2; ++h)
#pragma unroll
        for (int i = 0; i < 2; ++i) {
            if constexpr (GATHER) o[h][i] = (unsigned)g.rowidx[u.pm * BM + h * HALF + Rl[i]] * (unsigned)(g.lda * 2) + (unsigned)(Cl[i] * 2);
            else o[h][i] = (unsigned)(Rl[i] * g.lda + Cl[i]) * 2u;
        }
}
template <bool GATHER>
__device__ __forceinline__ void gemm_phase(LAS unsigned char* lds, const GemmDesc& g, int G, int c, int tid) {
    const int wid = __builtin_amdgcn_readfirstlane(tid >> 6), lane = tid & 63, wr = wid >> 2, wc = wid & 3, fr = lane & 15, fq = lane >> 4;
    const int K = g.K, nt = K / BK, lda = g.lda;
    StaticOrder S; S.init(g.nM, g.nN, G, c);
    int Rl[2], Cl[2]; unsigned voffB[2];
    unsigned offc[2][2], offn[2][2];
#pragma unroll
    for (int i = 0; i < 2; ++i) { int R, C; stage_rc(tid * 16 + i * 8192, R, C); const int Rb = (R & ~31) + perm32(R & 31);
        Rl[i] = R; Cl[i] = C; voffB[i] = (unsigned)(Rb * K + C) * 2u; }
    const size_t kstep = (size_t)(BK * 2);
    const size_t hstepB = (size_t)HALF * K * 2;
    const size_t hstepA = GATHER ? (size_t)0 : (size_t)HALF * lda * 2;
    const unsigned ldsw = (unsigned)wid * 1024u;
    const int aoff = lds_byte(wr * 64 + fr, fq * 8), boff = lds_byte((wc & 1) * 64 + fr, fq * 8); const int bh = wc >> 1;
#define PG8_SA(b, h) (((b) * 2 + (h)) * HTB)
#define PG8_SB(b, h) ((4 + (b) * 2 + (h)) * HTB)
#define PG8_STAGE(bufoff, gbase, voff) do { _Pragma("unroll") for (int _i = 0; _i < 2; ++_i) \
        __builtin_amdgcn_global_load_lds((const unsigned*)((const char*)(gbase) + (voff)[_i]), (LAS unsigned*)(lds + (bufoff) + ldsw + _i * 8192), 16, 0, 0); } while (0)
#define PG8_LDA(dst, b, h) do { _Pragma("unroll") for (int m = 0; m < 4; ++m) _Pragma("unroll") for (int k = 0; k < 2; ++k) dst[m][k] = *(const LAS bf16x8*)(lds + PG8_SA(b, h) + aoff + m * 2048 + k * 1024); } while (0)
#define PG8_LDB(dst, b, h) do { _Pragma("unroll") for (int n = 0; n < 2; ++n) _Pragma("unroll") for (int k = 0; k < 2; ++k) dst[n][k] = *(const LAS bf16x8*)(lds + PG8_SB(b, bh) + boff + (h) * 4096 + n * 2048 + k * 1024); } while (0)
#define PG8_MMA(ai, bj, At, Bt) do { __builtin_amdgcn_s_setprio(1); _Pragma("unroll") for (int m = 0; m < 4; ++m) _Pragma("unroll") for (int n = 0; n < 2; ++n) _Pragma("unroll") for (int k = 0; k < 2; ++k) \
        acc[ai][bj][m][n] = __builtin_amdgcn_mfma_f32_16x16x32_bf16(Bt[n][k], At[m][k], acc[ai][bj][m][n], 0, 0, 0); __builtin_amdgcn_s_setprio(0); } while (0)
#define PG8_WAIT_V(n) asm volatile("s_waitcnt vmcnt(" #n ")" ::: "memory")
#define PG8_WAIT_L(n) asm volatile("s_waitcnt lgkmcnt(" #n ")" ::: "memory")
#define PG8_BAR __builtin_amdgcn_s_barrier()
#define PG8_SCHED __builtin_amdgcn_sched_barrier(0)
    Unit cur, nxt; int ui = 0;
    if (!S.next(0, cur)) return;
    f32x4 acc[2][2][4][2];
#pragma unroll
    for (int a = 0; a < 2; ++a)
#pragma unroll
        for (int b = 0; b < 2; ++b)
#pragma unroll
            for (int m = 0; m < 4; ++m)
#pragma unroll
                for (int n = 0; n < 2; ++n) acc[a][b][m][n] = (f32x4){0.f, 0.f, 0.f, 0.f};
    bf16x8 At[4][2], B0[2][2], B1[2][2];
    unit_offs_f<GATHER>(g, cur, Rl, Cl, offc);
#pragma unroll
    for (int h = 0; h < 2; ++h) { offn[h][0] = offc[h][0]; offn[h][1] = offc[h][1]; }
    const char* cA = (const char*)g.A + (GATHER ? (size_t)0 : a_off_bytes(g, cur)); const char* cB = (const char*)g.Bt + b_off_bytes(g, cur);
    PG8_STAGE(PG8_SB(0, 0), cB, voffB); PG8_STAGE(PG8_SB(0, 1), cB + hstepB, voffB); PG8_STAGE(PG8_SA(0, 0), cA, offc[0]); PG8_STAGE(PG8_SA(0, 1), cA + hstepA, offc[1]);
    if (wr == 1) PG8_BAR;
    PG8_WAIT_V(2); PG8_BAR;
    PG8_STAGE(PG8_SB(1, 0), cB + kstep, voffB); PG8_STAGE(PG8_SA(1, 0), cA + kstep, offc[0]); PG8_STAGE(PG8_SB(1, 1), cB + hstepB + kstep, voffB);
    PG8_WAIT_V(6); PG8_BAR;
    for (;;) {
        const bool has_next = S.next(ui + 1, nxt);
        const char* nA = has_next ? (const char*)g.A + (GATHER ? (size_t)0 : a_off_bytes(g, nxt)) : cA; const char* nB = cB;
        if (g.tile_e) {
            if (has_next && wid == 0) __builtin_amdgcn_global_load_lds((const unsigned*)(g.tile_e + nxt.pm), (LAS unsigned*)(lds + STAGE_BYTES + 1024), 4, 0, 0);
        } else if (has_next) nB = (const char*)g.Bt + (size_t)nxt.pn * BM * (size_t)g.K * 2;
        if constexpr (GATHER) {
            if (has_next && wid == 0) {
#pragma unroll
                for (int q = 0; q < 4; ++q) __builtin_amdgcn_global_load_lds((const unsigned*)(g.rowidx + nxt.pm * BM + q * 64 + lane), (LAS unsigned*)(lds + STAGE_BYTES + q * 256), 4, 0, 0);
            }
        }
        for (int t = 0; t < nt; t += 2) {
            const bool last = (t == nt - 2);
            if (last && has_next && g.tile_e) { const int e = __builtin_amdgcn_readfirstlane(*(const LAS int*)(lds + STAGE_BYTES + 1024));
                nB = (const char*)g.Bt + ((size_t)nxt.pn * BM * (size_t)g.K + (size_t)e * (size_t)g.b_estride) * 2; }
            const char* a1 = cA + (size_t)(t + 1) * kstep;
            const char* a2 = last ? nA : cA + (size_t)(t + 2) * kstep; const char* b2 = last ? nB : cB + (size_t)(t + 2) * kstep;
            const char* a3 = a2 + kstep; const char* b3 = b2 + kstep;
            unsigned o2[2][2];
            if constexpr (GATHER) {
                if (last && has_next) {
                    const LAS int* ridx = (const LAS int*)(lds + STAGE_BYTES);
#pragma unroll
                    for (int h = 0; h < 2; ++h)
#pragma unroll
                        for (int i = 0; i < 2; ++i) offn[h][i] = (unsigned)ridx[h * HALF + Rl[i]] * (unsigned)(g.lda * 2) + (unsigned)(Cl[i] * 2);
                }
#pragma unroll
                for (int h = 0; h < 2; ++h)
#pragma unroll
                    for (int i = 0; i < 2; ++i) o2[h][i] = last ? offn[h][i] : offc[h][i];
            } else {
#pragma unroll
                for (int h = 0; h < 2; ++h)
#pragma unroll
                    for (int i = 0; i < 2; ++i) o2[h][i] = offc[0][i];
            }
            PG8_LDB(B0, 0, 0); PG8_LDB(B1, 0, 1); PG8_SCHED; PG8_LDA(At, 0, 0); PG8_STAGE(PG8_SA(1, 1), a1 + hstepA, offc[1]);
            PG8_WAIT_V(8); PG8_WAIT_L(0); PG8_BAR; PG8_MMA(0, 0, At, B0); PG8_MMA(0, 1, At, B1); PG8_BAR; PG8_SCHED;
            PG8_LDA(At, 0, 1); PG8_STAGE(PG8_SB(0, 0), b2, voffB); PG8_STAGE(PG8_SB(0, 1), b2 + hstepB, voffB); PG8_STAGE(PG8_SA(0, 0), a2, o2[0]);
            PG8_WAIT_V(8); PG8_WAIT_L(0); PG8_BAR; PG8_MMA(1, 0, At, B0); PG8_MMA(1, 1, At, B1); PG8_BAR; PG8_SCHED;
            PG8_LDB(B0, 1, 0); PG8_LDB(B1, 1, 1); PG8_SCHED; PG8_LDA(At, 1, 0); PG8_STAGE(PG8_SA(0, 1), a2 + hstepA, o2[1]);
            PG8_WAIT_V(8); PG8_WAIT_L(0); PG8_BAR; PG8_MMA(0, 0, At, B0); PG8_MMA(0, 1, At, B1); PG8_BAR; PG8_SCHED;
            PG8_LDA(At, 1, 1); PG8_STAGE(PG8_SB(1, 0), b3, voffB); PG8_STAGE(PG8_SB(1, 1), b3 + hstepB, voffB); PG8_STAGE(PG8_SA(1, 0), a3, o2[0]);
            PG8_WAIT_V(8); PG8_WAIT_L(0); PG8_BAR; PG8_MMA(1, 0, At, B0); PG8_MMA(1, 1, At, B1); PG8_BAR; PG8_SCHED;
        }
        if (wr == 0) PG8_BAR;
        epilogue(g, acc, cur, wr, wc, fr, fq);
        if (!has_next) break;
#pragma unroll
        for (int a = 0; a < 2; ++a)
#pragma unroll
            for (int b = 0; b < 2; ++b)
#pragma unroll
                for (int m = 0; m < 4; ++m)
#pragma unroll
                    for (int n = 0; n < 2; ++n) acc[a][b][m][n] = (f32x4){0.f, 0.f, 0.f, 0.f};
        cur = nxt; cA = nA; cB = nB; ++ui;
        if constexpr (GATHER) {
#pragma unroll
            for (int h = 0; h < 2; ++h) { offc[h][0] = offn[h][0]; offc[h][1] = offn[h][1]; }
        }
        if (wr == 1) PG8_BAR;
    }
    PG8_WAIT_V(0);
    PG8_BAR;
#undef PG8_SA
#undef PG8_SB
#undef PG8_STAGE
#undef PG8_LDA
#undef PG8_LDB
#undef PG8_MMA
#undef PG8_WAIT_V
#undef PG8_WAIT_L
#undef PG8_BAR
#undef PG8_SCHED
}
}

#define XB_TMO      128
#define XB_XCNT(j)  (256  + 64 * (j))
#define XB_XSUB(j)  (1280 + 64 * (j))
#define XB_XGEN(j)  (2304 + 64 * (j))
#define XB_TOP      3328
#define XB_TOPGEN   3392
#define XCD_BAR_WORDS 3456
#define XB_SPIN_CAP (1u << 20)
__device__ __forceinline__ unsigned xb_ld(unsigned* p)              { return __hip_atomic_load(p, __ATOMIC_RELAXED, __HIP_MEMORY_SCOPE_AGENT); }
__device__ __forceinline__ unsigned xb_add(unsigned* p, unsigned v) { return __hip_atomic_fetch_add(p, v, __ATOMIC_RELAXED, __HIP_MEMORY_SCOPE_AGENT); }
__device__ __forceinline__ unsigned xb_xcc_id() { return (unsigned)__builtin_amdgcn_s_getreg((3 << 11) | 20) & 0xFu; }
#define XB_SPIN(cond, bar) do { unsigned _sp = 0; while (cond) { __builtin_amdgcn_s_sleep(1); \
    if ((++_sp & 255u) == 0u) { if (xb_ld(&(bar)[XB_TMO])) break; if (_sp > XB_SPIN_CAP) { atomicAdd(&(bar)[XB_TMO], 1u); break; } } } } while (0)
struct XcdBarrier { unsigned* bar; unsigned x; volatile LAS unsigned* st; };
__device__ __forceinline__ XcdBarrier xcd_barrier_post(unsigned* bar, volatile LAS unsigned* st) {
    XcdBarrier b; b.bar = bar; b.x = xb_xcc_id(); b.st = st;
    if (threadIdx.x == 0) (void)xb_add(&bar[XB_XCNT(b.x)], 1u);
    return b;
}
__device__ __forceinline__ void xcd_barrier_complete(unsigned* bar, unsigned x, unsigned& nloc, unsigned& nx) {
    const unsigned G = gridDim.x * gridDim.y * gridDim.z;
    unsigned sum, cnt, mine, sp = 0u;
    for (;;) {
        sum = 0u; cnt = 0u; mine = 0u;
#pragma unroll
        for (unsigned j = 0; j < 16; ++j) { const unsigned c = xb_ld(&bar[XB_XCNT(j)]); sum += c; cnt += (c > 0u) ? 1u : 0u; mine = (j == x) ? c : mine; }
        if (sum == G) break;
        __builtin_amdgcn_s_sleep(1);
        if ((++sp & 255u) == 0u) { if (xb_ld(&bar[XB_TMO])) break; if (sp > XB_SPIN_CAP) { atomicAdd(&bar[XB_TMO], 1u); break; } }
    }
    nloc = mine > 0u ? mine : 1u; nx = cnt > 0u ? cnt : 1u;
}
__device__ __forceinline__ void xcd_barrier(const XcdBarrier& b) {
    asm volatile("s_waitcnt vmcnt(0)" ::: "memory");
    __syncthreads();
    if (threadIdx.x == 0) {
        unsigned* bar = b.bar;
        __builtin_amdgcn_s_waitcnt(0);
        unsigned nloc = b.st[0], nx = b.st[1];
        if (nloc == 0u) { xcd_barrier_complete(bar, b.x, nloc, nx); b.st[0] = nloc; b.st[1] = nx; }
        const unsigned old = xb_add(&bar[XB_XSUB(b.x)], 1u);
        const unsigned gen = old / nloc;
        if (old + 1u == (gen + 1u) * nloc) {
            __builtin_amdgcn_fence(__ATOMIC_RELEASE, "agent");
            asm volatile("s_waitcnt vmcnt(0)" ::: "memory");
            const unsigned og = xb_add(&bar[XB_TOP], 1u);
            const unsigned tg = og / nx;
            if (og + 1u == (tg + 1u) * nx) xb_add(&bar[XB_TOPGEN], 1u);
            else XB_SPIN(xb_ld(&bar[XB_TOPGEN]) == tg, bar);
            __builtin_amdgcn_fence(__ATOMIC_ACQUIRE, "agent");
            asm volatile("s_waitcnt vmcnt(0)" ::: "memory");
        } else {
            XB_SPIN(xb_ld(&bar[XB_TOPGEN]) == gen, bar);
            __builtin_amdgcn_fence(__ATOMIC_ACQUIRE, "agent");
            asm volatile("s_waitcnt vmcnt(0)" ::: "memory");
        }
    }
    __syncthreads();
}

constexpr int RING_BYTES = 131072;
constexpr int LDS_BYTES = 163840;
constexpr int MISC_OFF = LDS_BYTES - 1024;

struct Args {
    const float* in[35]; float* out; unsigned char* ws; int ph_lo, ph_hi;
};
enum { I_X = 0, I_C, I_ADAW, I_ADAB, I_NORMG, I_MIXWIN, I_CONVW, I_POOLW, I_POOLS, I_MIXWOUT, I_FFG, I_FFU, I_FFD, I_MU, I_WR, I_WK, I_WV, I_WO, I_W0, I_W1, I_W2, I_A0, I_A1, I_A2, I_G1, I_G2,
       I_KK, I_KA, I_RK, I_LNG, I_LNB, I_ROUTER, I_MOEG, I_MOEU, I_MOED };

struct Frame {
    LAS unsigned char* lds;
    int tid, lane, wave, vcu, G;
    unsigned char* ws;
};

struct ConvJob {
    const float* src; int src_ld;
    int n0s;
    int nK, nN;
    int k_lo, k_hi;
    bf16_t* dst; int dst_ld; int dst_r0, dst_c0;
    const float* scale; int smode;
    int remap;
};
__device__ __forceinline__ int conv_items(const ConvJob& j) { return (j.nK / 64) * (j.nN / 32); }
__device__ __forceinline__ void conv_item(const ConvJob& j, LAS float* scr, int item, int lane) {
    const int nblk = j.nN / 32, kb = item / nblk, nb = item % nblk, k0 = 64 * kb, n0 = 32 * nb;
    f32x4 v[8];
#pragma unroll
    for (int i = 0; i < 8; ++i) { const int kk = 8 * i + (lane >> 3); const int k = k0 + kk; v[i] = (f32x4){0.f, 0.f, 0.f, 0.f};
        if (k >= j.k_lo && k < j.k_hi) { const int sr = k - j.k_lo; v[i] = *(const f32x4*)(j.src + (size_t)sr * j.src_ld + j.n0s + n0 + 4 * (lane & 7));
            if (j.smode == 1) v[i] = v[i] * j.scale[sr]; else if (j.smode == 2) v[i] = v[i] * (1.0f - j.scale[sr]); } }
#pragma unroll
    for (int i = 0; i < 8; ++i) { const int kk = 8 * i + (lane >> 3); LAS float* d = scr + kk * 33 + 4 * (lane & 7); d[0] = v[i][0]; d[1] = v[i][1]; d[2] = v[i][2]; d[3] = v[i][3]; }
    asm volatile("s_waitcnt lgkmcnt(0)" ::: "memory");
    const int c = lane & 7;
#pragma unroll
    for (int q = 0; q < 4; ++q) { const int n = (lane >> 3) + 8 * q; const LAS float* s = scr + (8 * c) * 33 + n;
        u32x4 o; o.x = pk2(s[0 * 33], s[1 * 33]); o.y = pk2(s[2 * 33], s[3 * 33]); o.z = pk2(s[4 * 33], s[5 * 33]); o.w = pk2(s[6 * 33], s[7 * 33]);
        const int nl = n0 + n; int drow = j.dst_r0 + nl; if (j.remap) drow = j.dst_r0 + 256 * (nl >> 7) + 64 * ((nl & 127) >> 5) + (j.remap == 2 ? 32 : 0) + (nl & 31);
        *(GAS u32x4*)(j.dst + (size_t)drow * j.dst_ld + j.dst_c0 + k0 + 8 * c) = o; }
    asm volatile("s_waitcnt lgkmcnt(0)" ::: "memory");
}
__device__ __forceinline__ ConvJob mkjob(const float* src, int src_ld, int n0s, int nK, int nN, int k_lo, int k_hi, bf16_t* dst, int dst_ld, int dst_r0, int dst_c0, const float* scale, int smode, int remap) {
    ConvJob j; j.src = src; j.src_ld = src_ld; j.n0s = n0s; j.nK = nK; j.nN = nN; j.k_lo = k_lo; j.k_hi = k_hi; j.dst = dst; j.dst_ld = dst_ld; j.dst_r0 = dst_r0; j.dst_c0 = dst_c0; j.scale = scale; j.smode = smode; j.remap = remap; return j;
}
#define RUN_JOB(J) do { const ConvJob _j = (J); const int _n = conv_items(_j); for (int _it = (gw + NGW - (itbase % NGW)) % NGW; _it < _n; _it += NGW) conv_item(_j, scr, _it, F.lane); itbase += _n; } while (0)

__device__ __forceinline__ void phase_prologue(Frame& F, const Args& A) {
    unsigned char* ws = F.ws;
    LAS float* scr = (LAS float*)(F.lds + F.wave * 16384);
    const int gw = F.vcu * NWAVES + F.wave, NGW = F.G * NWAVES;
    {
        float* mod = (float*)(ws + WS_MOD);
        LAS float* red = (LAS float*)(F.lds);
        LAS float* sc_ = (LAS float*)(F.lds + 8192);
        for (int i = F.tid; i < 4 * D; i += NTHREADS) sc_[i] = siluf_(A.in[I_C][i]);
        __syncthreads();
        for (int task = F.vcu; task < 2 * 96; task += F.G) {
            const int l = task / 96, nb = task % 96, n = nb * 64 + F.lane;
            const float* w = A.in[I_ADAW] + (size_t)l * D * 6144 + n;
            float acc0 = 0.f, acc1 = 0.f, acc2 = 0.f, acc3 = 0.f;
            const int kb = F.wave * 128;
#pragma unroll 32
            for (int k = kb; k < kb + 128; ++k) {
                const float wv = w[(size_t)k * 6144];
                acc0 += sc_[k] * wv; acc1 += sc_[D + k] * wv; acc2 += sc_[2 * D + k] * wv; acc3 += sc_[3 * D + k] * wv;
            }
            red[(F.wave * 4 + 0) * 64 + F.lane] = acc0; red[(F.wave * 4 + 1) * 64 + F.lane] = acc1; red[(F.wave * 4 + 2) * 64 + F.lane] = acc2; red[(F.wave * 4 + 3) * 64 + F.lane] = acc3;
            __syncthreads();
            if (F.wave < 4) { float s = 0.f; for (int w8 = 0; w8 < 8; ++w8) s += red[(w8 * 4 + F.wave) * 64 + F.lane];
                mod[((size_t)l * 4 + F.wave) * 6144 + n] = s + A.in[I_ADAB][l * 6144 + n]; }
            __syncthreads();
        }
    }
    int itbase = 0;
    bf16_t* Win = (bf16_t*)(ws + WS_WIN); bf16_t* Woute = (bf16_t*)(ws + WS_WOUTE); bf16_t* Wfgu = (bf16_t*)(ws + WS_WFGU); bf16_t* Wfd = (bf16_t*)(ws + WS_WFD);
    bf16_t* Wrkv = (bf16_t*)(ws + WS_WRKV); bf16_t* Wlor = (bf16_t*)(ws + WS_WLOR); bf16_t* Wl2 = (bf16_t*)(ws + WS_WL2); bf16_t* Wo = (bf16_t*)(ws + WS_WO);
    RUN_JOB(mkjob(A.in[I_MIXWIN], MIXIN, 0, D, 512, 0, D, Win, D, 0, 0, nullptr, 0, 0));
    RUN_JOB(mkjob(A.in[I_MIXWIN], MIXIN, 512, D, 512, 0, D, Win, D, 512, 0, nullptr, 0, 1));
    RUN_JOB(mkjob(A.in[I_MIXWIN], MIXIN, 1024, D, 512, 0, D, Win, D, 512, 0, nullptr, 0, 2));
    RUN_JOB(mkjob(A.in[I_MIXWIN], MIXIN, 1536, D, 512, 0, D, Win, D, 1536, 0, nullptr, 0, 0));
    RUN_JOB(mkjob(A.in[I_MIXWOUT], D, 0, 512, D, 0, 512, Woute, D, 0, 0, nullptr, 0, 0));
    RUN_JOB(mkjob(A.in[I_FFG], FF, 0, D, FF, 0, D, Wfgu, D, 0, 0, nullptr, 0, 1));
    RUN_JOB(mkjob(A.in[I_FFU], FF, 0, D, FF, 0, D, Wfgu, D, 0, 0, nullptr, 0, 2));
    RUN_JOB(mkjob(A.in[I_FFD], D, 0, FF, D, 0, FF, Wfd, FF, 0, 0, nullptr, 0, 0));
    const float* mu = A.in[I_MU];
    RUN_JOB(mkjob(A.in[I_WR], D, 0, D, D, 0, D, Wrkv, D, 0, 0, nullptr, 0, 0));
    RUN_JOB(mkjob(A.in[I_WK], D, 0, D, D, 0, D, Wrkv, D, D, 0, nullptr, 0, 0));
    RUN_JOB(mkjob(A.in[I_WV], D, 0, D, D, 0, D, Wrkv, D, 2 * D, 0, nullptr, 0, 0));
    RUN_JOB(mkjob(A.in[I_W1], 64, 0, D, 64, 0, D, Wlor, 2 * D, 0, 0, mu + 1 * D, 1, 0));
    RUN_JOB(mkjob(A.in[I_W1], 64, 0, D, 64, 0, D, Wlor, 2 * D, 0, D, mu + 1 * D, 2, 0));
    RUN_JOB(mkjob(A.in[I_A1], 64, 0, D, 64, 0, D, Wlor, 2 * D, 64, 0, mu + 4 * D, 1, 0));
    RUN_JOB(mkjob(A.in[I_A1], 64, 0, D, 64, 0, D, Wlor, 2 * D, 64, D, mu + 4 * D, 2, 0));
    RUN_JOB(mkjob(A.in[I_G1], 160, 0, D, 160, 0, D, Wlor, 2 * D, 128, 0, mu + 5 * D, 1, 0));
    RUN_JOB(mkjob(A.in[I_G1], 160, 0, D, 160, 0, D, Wlor, 2 * D, 128, D, mu + 5 * D, 2, 0));
    RUN_JOB(mkjob(A.in[I_W2], D, 0, 256, D, 0, 64, Wl2, 256, 0, 0, nullptr, 0, 0));
    RUN_JOB(mkjob(A.in[I_A2], D, 0, 256, D, 64, 128, Wl2, 256, D, 0, nullptr, 0, 0));
    RUN_JOB(mkjob(A.in[I_G2], D, 0, 256, D, 0, 160, Wl2, 256, 2 * D, 0, nullptr, 0, 0));
    RUN_JOB(mkjob(A.in[I_WO], D, 0, D, D, 0, D, Wo, D, 0, 0, nullptr, 0, 0));
    { u32x4* z = (u32x4*)(Wlor + (size_t)288 * 2 * D); const int n16 = 224 * 2 * D * 2 / 16;
      for (int i = gw * 64 + F.lane; i < n16; i += NGW * 64) z[i] = (u32x4){0u, 0u, 0u, 0u}; }
    {
        const float* pw = A.in[I_POOLW]; const float* ps = A.in[I_POOLS]; const float* wo = A.in[I_MIXWOUT];
        for (int item = gw; item < 512 * 4; item += NGW) {
            const int kk = item >> 2, db = item & 3, g = kk >> 7, c = kk & 127, d = db * 256 + 4 * F.lane;
            f32x4 s = (f32x4){0.f, 0.f, 0.f, 0.f};
#pragma unroll 32
            for (int c2 = 0; c2 < 128; ++c2) s = s + (pw[((size_t)g * 128 + c) * 128 + c2] * ps[g * 128 + c2]) * *(const f32x4*)(wo + (size_t)(512 + g * 128 + c2) * D + d);
#pragma unroll
            for (int q = 0; q < 4; ++q) Woute[(size_t)(d + q) * D + 512 + kk] = (bf16_t)f2bf(s[q]);
        }
    }
}

__device__ __forceinline__ void moe_convert(Frame& F, const Args& A, int part, int half, bf16_t* dst, int pidx, int np) {
    LAS float* scr = (LAS float*)(F.lds + F.wave * 16384);
    const int gw = pidx * NWAVES + F.wave, NGW = np * NWAVES;
    int itbase = 0;
    for (int e = 0; e < NE; ++e) {
        if (part == 0) {
            RUN_JOB(mkjob(A.in[I_MOEG] + (size_t)e * D * FF, FF, half * FH, D, FH, 0, D, dst, D, e * FF, 0, nullptr, 0, 1));
            RUN_JOB(mkjob(A.in[I_MOEU] + (size_t)e * D * FF, FF, half * FH, D, FH, 0, D, dst, D, e * FF, 0, nullptr, 0, 2));
        } else {
            RUN_JOB(mkjob(A.in[I_MOED] + (size_t)e * FF * D + (size_t)half * FH * D, D, 0, FH, D, 0, FH, dst, FH, e * D, 0, nullptr, 0, 0));
        }
    }
}

constexpr int MCV_ITEMS = 32 * 2816;
struct McvDst { bf16_t* p; };
__device__ __forceinline__ McvDst mcv_load(const Args& A, unsigned char* ws, int id, int lane, float (&v)[8]) {
    const int t = id / 2816, r = id % 2816;
    const float* src; int ld; bf16_t* dst;
    if (t < 16) { const int e = t >> 1, up = t & 1, kb = r / 22, nb = r % 22, nl = nb * 64 + lane;
        src = A.in[up ? I_MOEU : I_MOEG] + (size_t)e * D * FF + (size_t)(kb * 8) * FF + nl; ld = FF;
        dst = (bf16_t*)(ws + WS_WMGU) + (size_t)(e * FF + 256 * (nl >> 7) + 64 * ((nl & 127) >> 5) + (up ? 32 : 0) + (nl & 31)) * D + kb * 8;
    } else { const int half = (t - 16) >> 3, e = (t - 16) & 7, kb = r / 16, nb = r % 16, n = nb * 64 + lane;
        src = A.in[I_MOED] + (size_t)e * FF * D + (size_t)(half * FH + kb * 8) * D + n; ld = D;
        dst = (bf16_t*)(ws + (half ? WS_WMD1 : WS_WMD0)) + (size_t)(e * D + n) * FH + kb * 8; }
#pragma unroll
    for (int i = 0; i < 8; ++i) v[i] = __builtin_nontemporal_load(src + (size_t)i * ld);
    McvDst d; d.p = dst; return d;
}
__device__ __forceinline__ void mcv_store(const McvDst& d, const float (&v)[8]) {
    *(u32x4*)(d.p) = (u32x4){pk2(v[0], v[1]), pk2(v[2], v[3]), pk2(v[4], v[5]), pk2(v[6], v[7])};
}

struct RowP {
    const float* xin; float* xout;
    const bf16_t* y;
    const float* gate; const float* gpost;
    const float* gpre; const float* sc; const float* sh;
    bf16_t* hout; int hpad;
    float* xh;
    int xin_b, xout_b;
};
struct RowIn { f32x4 xf[4]; u32x2 xb[4]; u32x2 yw[4]; };
__device__ __forceinline__ void row_load(const RowP& P, int t, int lane, RowIn& in, const float* xrow = nullptr) {
    if (P.xin_b && !xrow) {
        const GAS u32x2* xr = (const GAS u32x2*)((const bf16_t*)P.xin + (size_t)t * 2048 + 1024) + lane;
#pragma unroll
        for (int j = 0; j < 4; ++j) in.xb[j] = xr[64 * j];
    } else {
        const GAS f32x4* xr = (const GAS f32x4*)(xrow ? xrow : P.xin + (size_t)t * D) + lane;
#pragma unroll
        for (int j = 0; j < 4; ++j) in.xf[j] = xr[64 * j];
    }
    if (P.y) {
        const GAS u32x2* yr = (const GAS u32x2*)(P.y + (size_t)t * D) + lane;
#pragma unroll
        for (int j = 0; j < 4; ++j) in.yw[j] = yr[64 * j];
    }
}
__device__ __forceinline__ void row_compute(const RowP& P, int t, int lane, const RowIn& in, f32x4 (&hv)[4], bool want_h, bool halo = false) {
    const int b = t / SEQ;
    f32x4 x[4];
    if (P.xin_b && !halo) {
#pragma unroll
        for (int j = 0; j < 4; ++j) { const u32x2 w = in.xb[j]; x[j] = (f32x4){bflo(w.x), bfhi(w.x), bflo(w.y), bfhi(w.y)}; }
    } else {
#pragma unroll
        for (int j = 0; j < 4; ++j) x[j] = in.xf[j];
    }
    if (P.y) {
        f32x4 yv[4]; float ss = 0.f;
#pragma unroll
        for (int j = 0; j < 4; ++j) { const u32x2 w = in.yw[j]; yv[j] = (f32x4){bflo(w.x), bfhi(w.x), bflo(w.y), bfhi(w.y)}; ss += (yv[j].x * yv[j].x + yv[j].y * yv[j].y) + (yv[j].z * yv[j].z + yv[j].w * yv[j].w); }
        const float rs = rsqrtf(wave_sum(ss) * (1.0f / D) + RMS_EPS);
#pragma unroll
        for (int j = 0; j < 4; ++j) { const f32x4 gt = *((const f32x4*)(P.gate + (size_t)b * 6144) + lane + 64 * j); const f32x4 gp = *((const f32x4*)P.gpost + lane + 64 * j);
            x[j] = x[j] + gt * gp * yv[j] * rs; }
    }
    if (P.xout_b) {
        u32x2 w[4];
#pragma unroll
        for (int j = 0; j < 4; ++j) { w[j] = (u32x2){pk2(x[j].x, x[j].y), pk2(x[j].z, x[j].w)}; x[j] = (f32x4){bflo(w[j].x), bfhi(w[j].x), bflo(w[j].y), bfhi(w[j].y)}; }
        if (!halo) { GAS u32x2* xo = (GAS u32x2*)((bf16_t*)P.xout + (size_t)t * 2048 + 1024) + lane;
#pragma unroll
            for (int j = 0; j < 4; ++j) xo[64 * j] = w[j]; }
    } else if (P.xout && !halo) { GAS f32x4* xo = (GAS f32x4*)(P.xout + (size_t)t * D) + lane;
#pragma unroll
        for (int j = 0; j < 4; ++j) xo[64 * j] = x[j]; }
    if (P.xh && (t & 15) == 15) { GAS f32x4* xo = (GAS f32x4*)(P.xh + (size_t)(t >> 4) * D) + lane;
#pragma unroll
        for (int j = 0; j < 4; ++j) xo[64 * j] = x[j]; }
    if (want_h) {
        float ss = 0.f;
#pragma unroll
        for (int j = 0; j < 4; ++j) ss += (x[j].x * x[j].x + x[j].y * x[j].y) + (x[j].z * x[j].z + x[j].w * x[j].w);
        const float rs = rsqrtf(wave_sum(ss) * (1.0f / D) + RMS_EPS);
#pragma unroll
        for (int j = 0; j < 4; ++j) { const f32x4 gp = *((const f32x4*)P.gpre + lane + 64 * j); const f32x4 sc = *((const f32x4*)(P.sc + (size_t)b * 6144) + lane + 64 * j); const f32x4 sh = *((const f32x4*)(P.sh + (size_t)b * 6144) + lane + 64 * j);
            hv[j] = x[j] * rs * gp * (1.0f + sc) + sh; }
        if (P.hout && !halo) { const size_t hr = P.hpad ? (size_t)b * (SEQ + 1) + (size_t)(t - b * SEQ) + 1 : (size_t)t;
            GAS u32x2* ho = (GAS u32x2*)(P.hout + hr * D) + lane;
#pragma unroll
            for (int j = 0; j < 4; ++j) ho[64 * j] = (u32x2){pk2(hv[j].x, hv[j].y), pk2(hv[j].z, hv[j].w)}; }
    }
}
__device__ __forceinline__ void phase_rows(Frame& F, const RowP& P) {
    const int gw = F.vcu * NWAVES + F.wave, NGW = F.G * NWAVES;
    f32x4 hv[4];
    RowIn cur, nxt;
    int t = gw; if (t < T) row_load(P, t, F.lane, cur);
    for (; t < T; t += NGW) { if (t + NGW < T) row_load(P, t + NGW, F.lane, nxt); row_compute(P, t, F.lane, cur, hv, P.gpre != nullptr); cur = nxt; }
}

__device__ __forceinline__ void phase_post2(Frame& F, const Args& A, const RowP& P) {
    const int g = F.vcu * NWAVES + F.wave, lane = F.lane;
    const float* mu = A.in[I_MU];
    f32x4 mur[4], muk[4], muv[4];
#pragma unroll
    for (int j = 0; j < 4; ++j) { mur[j] = *((const f32x4*)(mu + 0 * D) + lane + 64 * j); muk[j] = *((const f32x4*)(mu + 2 * D) + lane + 64 * j); muv[j] = *((const f32x4*)(mu + 3 * D) + lane + 64 * j); }
    bf16_t* XR = (bf16_t*)(F.ws + WS_XR); bf16_t* XK = (bf16_t*)(F.ws + WS_XK); bf16_t* XV = (bf16_t*)(F.ws + WS_XV);
    const int t0 = 16 * g;
    f32x4 hp[4];
    if (t0 % SEQ == 0) {
#pragma unroll
        for (int j = 0; j < 4; ++j) hp[j] = (f32x4){0.f, 0.f, 0.f, 0.f};
    } else { RowIn hin; row_load(P, t0 - 1, lane, hin, (const float*)(F.ws + WS_XH) + (size_t)(g - 1) * D); row_compute(P, t0 - 1, lane, hin, hp, true, true); }
    RowIn cur, nxt; row_load(P, t0, lane, cur);
#pragma unroll 1
    for (int t = t0; t < t0 + 16; ++t) {
        if (t + 1 < t0 + 16) row_load(P, t + 1, lane, nxt);
        f32x4 hv[4]; row_compute(P, t, lane, cur, hv, true); cur = nxt;
        GAS u32x2* pr = (GAS u32x2*)(XR + (size_t)t * D) + lane; GAS u32x2* pk = (GAS u32x2*)(XK + (size_t)t * D) + lane; GAS u32x2* pv = (GAS u32x2*)(XV + (size_t)t * D) + lane;
#pragma unroll
        for (int j = 0; j < 4; ++j) { const f32x4 d = hp[j] - hv[j];
            const f32x4 a = hv[j] + d * mur[j], b = hv[j] + d * muk[j], c = hv[j] + d * muv[j];
            pr[64 * j] = (u32x2){pk2(a.x, a.y), pk2(a.z, a.w)}; pk[64 * j] = (u32x2){pk2(b.x, b.y), pk2(b.z, b.w)}; pv[64 * j] = (u32x2){pk2(c.x, c.y), pk2(c.z, c.w)};
            hp[j] = hv[j]; }
    }
}

__device__ __forceinline__ void phase_mix(Frame& F, const Args& A) {
    const bf16_t* __restrict__ Z = (const bf16_t*)(F.ws + WS_Z); bf16_t* __restrict__ A2 = (bf16_t*)(F.ws + WS_A2);
    constexpr int TB = 32;
    const int tid = F.tid;
    for (int blk = F.vcu; blk < T / TB; blk += F.G) {
        const int t0 = blk * TB, b = t0 / SEQ, tb0 = t0 - b * SEQ;
        if (tid < 256) {
            const int c = 2 * tid;
            const float w00 = A.in[I_CONVW][c], w01 = A.in[I_CONVW][c + 1], w10 = A.in[I_CONVW][512 + c], w11 = A.in[I_CONVW][512 + c + 1], w20 = A.in[I_CONVW][1024 + c], w21 = A.in[I_CONVW][1024 + c + 1];
            float um2_0 = 0.f, um2_1 = 0.f, um1_0 = 0.f, um1_1 = 0.f;
            for (int s = -2; s < 0; ++s) if (tb0 + s >= 0) { const bf16_t* zr = Z + (size_t)(t0 + s) * ZLD;
                const unsigned uw = *(const unsigned*)(zr + 512 + c);
                const float u0 = bflo(uw), u1 = bfhi(uw);
                if (s == -2) { um2_0 = u0; um2_1 = u1; } else { um1_0 = u0; um1_1 = u1; } }
            unsigned bgv[2][8], uvv[2][8];
#pragma unroll
            for (int q = 0; q < 8; ++q) { const bf16_t* zr = Z + (size_t)(t0 + q) * ZLD; bgv[0][q] = *(const unsigned*)(zr + c); uvv[0][q] = *(const unsigned*)(zr + 512 + c); }
#pragma unroll
            for (int grp = 0; grp < TB / 8; ++grp) {
                const int cu = grp & 1, nx = cu ^ 1;
                if (grp + 1 < TB / 8) {
#pragma unroll
                    for (int q = 0; q < 8; ++q) { const bf16_t* zr = Z + (size_t)(t0 + 8 * (grp + 1) + q) * ZLD; bgv[nx][q] = *(const unsigned*)(zr + c); uvv[nx][q] = *(const unsigned*)(zr + 512 + c); }
                }
                __builtin_amdgcn_sched_barrier(0);
#pragma unroll
                for (int q = 0; q < 8; ++q) { const int s = 8 * grp + q; const unsigned bg = bgv[cu][q], uw = uvv[cu][q];
                    const float u0 = bflo(uw), u1 = bfhi(uw);
                    const float y0 = bflo(bg) * (w00 * um2_0 + w10 * um1_0 + w20 * u0), y1 = bfhi(bg) * (w01 * um2_1 + w11 * um1_1 + w21 * u1);
                    *(unsigned*)(A2 + (size_t)(t0 + s) * D + c) = pk2(y0, y1);
                    um2_0 = um1_0; um2_1 = um1_1; um1_0 = u0; um1_1 = u1; }
                __builtin_amdgcn_sched_barrier(0);
            }
        } else {
            const int c = 2 * (tid - 256), win = 2 << (c >> 7);
            float s0 = 0.f, s1 = 0.f;
            for (int s = -win + 1; s < 0; ++s) if (tb0 + s >= 0) { const unsigned v = *(const unsigned*)(Z + (size_t)(t0 + s) * ZLD + 1024 + c); s0 += bflo(v); s1 += bfhi(v); }
            unsigned vv[2][8], ov[2][8];
#pragma unroll
            for (int q = 0; q < 8; ++q) { vv[0][q] = *(const unsigned*)(Z + (size_t)(t0 + q) * ZLD + 1024 + c);
                ov[0][q] = (tb0 + q - win + 1 >= 0) ? *(const unsigned*)(Z + (size_t)(t0 + q - win + 1) * ZLD + 1024 + c) : 0u; }
#pragma unroll
            for (int grp = 0; grp < TB / 8; ++grp) {
                const int cu = grp & 1, nx = cu ^ 1;
                if (grp + 1 < TB / 8) {
#pragma unroll
                    for (int q = 0; q < 8; ++q) { const int s = 8 * (grp + 1) + q; vv[nx][q] = *(const unsigned*)(Z + (size_t)(t0 + s) * ZLD + 1024 + c);
                        ov[nx][q] = (tb0 + s - win + 1 >= 0) ? *(const unsigned*)(Z + (size_t)(t0 + s - win + 1) * ZLD + 1024 + c) : 0u; }
                }
                __builtin_amdgcn_sched_barrier(0);
#pragma unroll
                for (int q = 0; q < 8; ++q) { const int s = 8 * grp + q;
                    const unsigned v = vv[cu][q]; const float v0 = bflo(v), v1 = bfhi(v);
                    s0 += v0; s1 += v1;
                    const int pos = tb0 + s; const float icnt = __builtin_amdgcn_rcpf((float)((pos + 1 < win) ? pos + 1 : win));
                    *(unsigned*)(A2 + (size_t)(t0 + s) * D + 512 + c) = pk2(s0 * icnt - v0, s1 * icnt - v1);
                    const unsigned o = ov[cu][q]; s0 -= bflo(o); s1 -= bfhi(o);
                }
                __builtin_amdgcn_sched_barrier(0);
            }
        }
    }
}

namespace sm {
typedef LAS unsigned char* lp;
constexpr int TL = 8192;
constexpr int O_RAW = 0;
constexpr int O_LC = 40960;
constexpr int LCS = 68;
constexpr int O_TM = O_LC + 64 * LCS * 4;
constexpr int O_CM = O_TM + 4 * TL;
constexpr int O_X = O_CM + 4 * TL;
constexpr int O_S = O_X + 2 * TL;
constexpr int O_TB = O_S + 2 * TL;
constexpr int O_F = O_TB + 2048;
constexpr int O_END = O_F + (3 * 64 + 8 * 64 + 5 * 64) * 4;
static_assert(O_END <= MISC_OFF, "scan LDS map");
__device__ __forceinline__ int toff(int r, int c16) { return r * 128 + ((c16 ^ (r & 7)) << 4); }
typedef __bf16 bf16x2_t __attribute__((ext_vector_type(2)));
__device__ __forceinline__ unsigned cvtpk_s(float lo, float hi) { f32x2 v = {lo, hi}; bf16x2_t b = __builtin_convertvector(v, bf16x2_t); return __builtin_bit_cast(unsigned, b); }
__device__ __forceinline__ bf16x8 ldfrag(lp tile, int row, int c16) { return *(const LAS bf16x8*)(tile + toff(row, c16)); }
__device__ __forceinline__ f32x4 mm64(f32x4 acc, lp At, int m0, lp Bt, int n0, int lane) {
    const int r = lane & 15, q = lane >> 4;
#pragma unroll
    for (int ks = 0; ks < 2; ++ks) { const bf16x8 a = ldfrag(At, m0 + r, 4 * ks + q), b = ldfrag(Bt, n0 + r, 4 * ks + q); acc = __builtin_amdgcn_mfma_f32_16x16x32_bf16(a, b, acc, 0, 0, 0); }
    return acc;
}
__device__ __forceinline__ void st_nat(lp tile, int m0, int n0, f32x4 v, int lane) {
    const int n = n0 + (lane & 15), m = m0 + 4 * (lane >> 4);
    u32x2 w; w.x = cvtpk_s(v[0], v[1]); w.y = cvtpk_s(v[2], v[3]);
    *(LAS u32x2*)(tile + toff(n, m >> 3) + (m & 7) * 2) = w;
}
__device__ __forceinline__ f32x4 ld_nat(lp tile, int m0, int n0, int lane) {
    const int n = n0 + (lane & 15), m = m0 + 4 * (lane >> 4);
    const u32x2 w = *(const LAS u32x2*)(tile + toff(n, m >> 3) + (m & 7) * 2);
    return (f32x4){bflo(w.x), bfhi(w.x), bflo(w.y), bfhi(w.y)};
}
__device__ __forceinline__ float red8(float v) { return sum8_dpp(v); }
}

#define LBAR() asm volatile("s_waitcnt lgkmcnt(0)\n\ts_barrier" ::: "memory")
namespace sm {
constexpr int A_RAW = 0;
constexpr int A_LC = 4 * TL;
constexpr int A_TM = A_LC + 64 * LCS * 4;
constexpr int A_CM = A_TM + 4 * TL;
constexpr int A_X = A_CM + 4 * TL;
constexpr int A_S = A_X + 2 * TL;
constexpr int A_TB = A_S + 2 * TL;
constexpr int A_F = A_TB + 2048;
static_assert(A_F + 4096 <= MISC_OFF, "scan pass A LDS map");
constexpr int SEQQ = SEQ / 4, NCHQ = SEQQ / 64;
}
__device__ __forceinline__ void phase_scanA(Frame& F, const Args& A) {
    using namespace sm;
    const int unit = F.vcu, bh = unit >> 2, qq = unit & 3, b = bh / NH, h = bh % NH;
    const int tid = F.tid, lane = F.lane, w = F.wave;
    const int tA = tid >> 3, jsA = tid & 7;
    const int jB = tid & 63, qB = tid >> 6;
    lp L = F.lds;
    lp RAWk = L + A_RAW, RAWv = RAWk + TL, RAWw = RAWv + TL, RAWa = RAWw + TL;
    lp MabT = L + A_RAW, MkaT = MabT + TL, NbrT = MkaT + TL, NkrT = NbrT + TL; lp TG = MabT, TS = MkaT;
    LAS float* LC = (LAS float*)(L + A_LC); lp YT = L + A_LC, ZC = YT + TL;
    lp AtM = L + A_TM, RtM = AtM + TL, BtM = RtM + TL, KtM = BtM + TL; lp ZT = AtM, GcT = BtM;
    lp AtT = L + A_CM, BtT = AtT + TL, KtT = BtT + TL, VT = KtT + TL;
    lp XP = L + A_X, XQ = XP + TL;
    lp SG = L + A_S, SL = SG + TL;
    lp TB = L + A_TB;
    LAS float* FS = (LAS float*)(L + A_F); LAS float* DCv = FS; LAS float* INV = FS + 64; LAS float* BSC = FS + 128; LAS float* TOT = FS + 192; LAS float* PRM = FS + 192 + 512;
    if (tid < 64) { const int ch = h * HS + tid; PRM[tid] = A.in[I_KK][ch]; PRM[64 + tid] = A.in[I_KA][ch]; PRM[128 + tid] = A.in[I_RK][ch]; PRM[192 + tid] = A.in[I_W0][ch]; PRM[256 + tid] = A.in[I_A0][ch]; }
    { *(LAS u32x4*)(SG + tid * 16) = (u32x4){0u, 0u, 0u, 0u}; *(LAS u32x4*)(SL + tid * 16) = (u32x4){0u, 0u, 0u, 0u}; }
    LBAR();
    if (tid < 64) *(LAS bf16_t*)(SG + toff(tid, tid >> 3) + (tid & 7) * 2) = (bf16_t)0x3F80;
    const bf16_t* gR = (const bf16_t*)(F.ws + WS_R); const bf16_t* gK = (const bf16_t*)(F.ws + WS_K); const bf16_t* gV = (const bf16_t*)(F.ws + WS_V);
    const bf16_t* gL = (const bf16_t*)A.out;
    bf16_t* gYL = (bf16_t*)(F.ws + WS_R); bf16_t* gZC = (bf16_t*)(F.ws + WS_K); float* gBS = (float*)(F.ws + WS_BSC);
    const size_t trow0 = (size_t)b * SEQ + (size_t)qq * SEQQ;
    const size_t rowbase = (trow0 + tA) * D + h * HS + jsA * 8;
    const size_t lbase = (trow0 + tA) * LACT_LD + jsA * 8;
    u32x4 nr = *(const u32x4*)(gR + rowbase), nk = *(const u32x4*)(gK + rowbase), nv = *(const u32x4*)(gV + rowbase), nw = *(const u32x4*)(gL + lbase), na = *(const u32x4*)(gL + lbase + 64);
    const float kkwB = A.in[I_KK][h * HS + jB], kawB = A.in[I_KA][h * HS + jB];
    { const int o = toff(tA, jsA); *(LAS u32x4*)(AtM + o) = nw; *(LAS u32x4*)(RtM + o) = na; }
    const int l2kind = w >> 2, l2jb = w & 3;
    bf16x8 l2frag[2];
    { const bf16_t* l2W = (const bf16_t*)(F.ws + WS_WL2) + (size_t)((l2kind ? D : 0) + h * HS + 16 * l2jb + (lane & 15)) * 256 + (l2kind ? 64 : 0) + 8 * (lane >> 4);
      l2frag[0] = *(const bf16x8*)(l2W); l2frag[1] = *(const bf16x8*)(l2W + 32); }
    LBAR();
#pragma unroll 1
    for (int c = 0; c < NCHQ; ++c) {
        int tl_ = tid; asm volatile("" : "+v"(tl_));
        const int tid = tl_, lane = tl_ & 63, tA = tl_ >> 3, jsA = tl_ & 7, jB = tl_ & 63, qB = tl_ >> 6;
        const u32x4 cr = nr, ck = nk, cv = nv;
        { const int o = toff(tA, jsA); *(LAS u32x4*)(RAWk + o) = ck; *(LAS u32x4*)(RAWv + o) = cv; }
        if (c + 1 < NCHQ) { const size_t o = rowbase + (size_t)(c + 1) * 64 * D; nr = *(const u32x4*)(gR + o); nk = *(const u32x4*)(gK + o); nv = *(const u32x4*)(gV + o); nw = *(const u32x4*)(gL + lbase + (size_t)(c + 1) * 64 * LACT_LD); na = *(const u32x4*)(gL + lbase + (size_t)(c + 1) * 64 * LACT_LD + 64); }
        {
            lp Ht = l2kind ? RtM : AtM; lp Ot = l2kind ? RAWa : RAWw;
#pragma unroll
            for (int tb = 0; tb < 4; ++tb) {
                f32x4 acc = *(const LAS f32x4*)(PRM + (3 + l2kind) * 64 + 16 * l2jb + 4 * (lane >> 4));
#pragma unroll
                for (int ks = 0; ks < 2; ++ks) acc = __builtin_amdgcn_mfma_f32_16x16x32_bf16(l2frag[ks], ldfrag(Ht, 16 * tb + (lane & 15), 4 * ks + (lane >> 4)), acc, 0, 0, 0);
#pragma unroll
                for (int e = 0; e < 4; ++e) { const float sg = sigmoidf_(acc[e]); acc[e] = l2kind ? sg : -0.60653066f * sg; }
                st_nat(Ot, 16 * l2jb, 16 * tb, acc, lane);
            }
        }
        LBAR();
        const u32x4 cw = *(const LAS u32x4*)(RAWw + toff(tA, jsA)), ca = *(const LAS u32x4*)(RAWa + toff(tA, jsA));
        float kf[8], af[8], rf[8], wf[8];
        { const unsigned kw[4] = {ck.x, ck.y, ck.z, ck.w}, aw[4] = {ca.x, ca.y, ca.z, ca.w}, rw[4] = {cr.x, cr.y, cr.z, cr.w}, ww[4] = {cw.x, cw.y, cw.z, cw.w};
#pragma unroll
          for (int p = 0; p < 4; ++p) { kf[2 * p] = bflo(kw[p]); kf[2 * p + 1] = bfhi(kw[p]); af[2 * p] = bflo(aw[p]); af[2 * p + 1] = bfhi(aw[p]); rf[2 * p] = bflo(rw[p]); rf[2 * p + 1] = bfhi(rw[p]); wf[2 * p] = bflo(ww[p]); wf[2 * p + 1] = bfhi(ww[p]); } }
        float kkA[8], kpA[8];
        { const f32x4 k0 = *(const LAS f32x4*)(PRM + 8 * jsA), k1 = *(const LAS f32x4*)(PRM + 8 * jsA + 4), a0 = *(const LAS f32x4*)(PRM + 64 + 8 * jsA), a1 = *(const LAS f32x4*)(PRM + 64 + 8 * jsA + 4), r0 = *(const LAS f32x4*)(PRM + 128 + 8 * jsA), r1 = *(const LAS f32x4*)(PRM + 128 + 8 * jsA + 4);
          float ss = 0.f, bs = 0.f;
#pragma unroll
          for (int p = 0; p < 8; ++p) { const float kkw = p < 4 ? k0[p & 3] : k1[p & 3], kaw = p < 4 ? a0[p & 3] : a1[p & 3], rkw = p < 4 ? r0[p & 3] : r1[p & 3];
              kkA[p] = kf[p] * kkw; ss += kkA[p] * kkA[p]; kpA[p] = kf[p] * (1.0f + (af[p] - 1.0f) * kaw); bs += rf[p] * kpA[p] * rkw; }
          ss = red8(ss); bs = red8(bs);
          if (jsA == 0) { INV[tA] = 1.0f / fmaxf(sqrtf(ss), 1e-12f); BSC[tA] = bs; } }
        {
            float pw[8], wlv[8];
            float run = 0.f;
#pragma unroll
            for (int p = 0; p < 8; ++p) { const int t = 8 * qB + p; wlv[p] = bf1(*(const LAS bf16_t*)(RAWw + toff(t, jB >> 3) + (jB & 7) * 2)); run += wlv[p]; pw[p] = run; }
            TOT[qB * 64 + jB] = run;
            LBAR();
            float off = 0.f;
#pragma unroll
            for (int q2 = 0; q2 < 7; ++q2) off += (q2 < qB) ? TOT[q2 * 64 + jB] : 0.f;
            unsigned oa[4], ob[4], ok[4], ov[4];
            float pa = 0.f, pb = 0.f, pk = 0.f, pv = 0.f;
#pragma unroll
            for (int p = 0; p < 8; ++p) { const int t = 8 * qB + p; const int eo = toff(t, jB >> 3) + (jB & 7) * 2;
                const float kv = bf1(*(const LAS bf16_t*)(RAWk + eo)), av = bf1(*(const LAS bf16_t*)(RAWa + eo)), vv = bf1(*(const LAS bf16_t*)(RAWv + eo));
                const float lc = off + pw[p], lx = lc - wlv[p]; LC[t * LCS + jB] = lc;
                const float kkn = kv * kkwB * INV[t], kp = kv * (1.0f + (av - 1.0f) * kawB), em = __expf(-lc);
                const float xa = -kkn * __expf(lx), xb = kkn * av * em, xk = kp * em;
                if (p & 1) { oa[p >> 1] = pk2(pa, xa); ob[p >> 1] = pk2(pb, xb); ok[p >> 1] = pk2(pk, xk); ov[p >> 1] = pk2(pv, vv); } else { pa = xa; pb = xb; pk = xk; pv = vv; }
                if (t == 63) DCv[jB] = __expf(lc); }
            const int o = toff(jB, qB);
            *(LAS u32x4*)(AtT + o) = (u32x4){oa[0], oa[1], oa[2], oa[3]}; *(LAS u32x4*)(BtT + o) = (u32x4){ob[0], ob[1], ob[2], ob[3]}; *(LAS u32x4*)(KtT + o) = (u32x4){ok[0], ok[1], ok[2], ok[3]}; *(LAS u32x4*)(VT + o) = (u32x4){ov[0], ov[1], ov[2], ov[3]};
        }
        LBAR();
        {
            const f32x4 l0 = *(const LAS f32x4*)(LC + tA * LCS + 8 * jsA), l1 = *(const LAS f32x4*)(LC + tA * LCS + 8 * jsA + 4);
            const float inv = INV[tA];
            float xa[8], xr[8], xb[8], xk[8];
#pragma unroll
            for (int p = 0; p < 8; ++p) { const float lc = p < 4 ? l0[p & 3] : l1[p & 3]; const float em = __expf(-lc), ep = __expf(lc), kkn = kkA[p] * inv;
                xa[p] = -kkn * __expf(lc - wf[p]); xr[p] = rf[p] * ep; xb[p] = kkn * af[p] * em; xk[p] = kpA[p] * em; }
            const int o = toff(tA, jsA);
            *(LAS u32x4*)(AtM + o) = (u32x4){pk2(xa[0], xa[1]), pk2(xa[2], xa[3]), pk2(xa[4], xa[5]), pk2(xa[6], xa[7])};
            *(LAS u32x4*)(RtM + o) = (u32x4){pk2(xr[0], xr[1]), pk2(xr[2], xr[3]), pk2(xr[4], xr[5]), pk2(xr[6], xr[7])};
            *(LAS u32x4*)(BtM + o) = (u32x4){pk2(xb[0], xb[1]), pk2(xb[2], xb[3]), pk2(xb[4], xb[5]), pk2(xb[6], xb[7])};
            *(LAS u32x4*)(KtM + o) = (u32x4){pk2(xk[0], xk[1]), pk2(xk[2], xk[3]), pk2(xk[4], xk[5]), pk2(xk[6], xk[7])};
        }
        LBAR();
        float mcv[8]; McvDst mcd; const int mcid = (2 * c) * (256 * NWAVES) + unit * NWAVES + w; const bool mcon = mcid + 256 * NWAVES < MCV_ITEMS + 256 * NWAVES && mcid < MCV_ITEMS;
        if (mcon) mcd = mcv_load(A, F.ws, mcid, lane, mcv);
#pragma unroll 1
        for (int it = 0; it < 5; ++it) {
            const int n = w + 8 * it, X = n / 10, p = n % 10;
            const int tb = (p >= 6) ? 3 : (p >= 3) ? 2 : (p >= 1) ? 1 : 0, sb = p - (tb * (tb + 1)) / 2;
            lp Am = (X & 1) ? KtM : BtM; lp Bm = (X & 2) ? RtM : AtM; lp Om = L + A_RAW + X * TL;
            f32x4 acc = (f32x4){0.f, 0.f, 0.f, 0.f};
            acc = mm64(acc, Am, 16 * sb, Bm, 16 * tb, lane);
            if (sb == tb) { const int tin = lane & 15, s0 = 4 * (lane >> 4);
#pragma unroll
                for (int e = 0; e < 4; ++e) { const bool keep = (X & 2) ? (s0 + e <= tin) : (s0 + e < tin); if (!keep) acc[e] = 0.f; } }
            st_nat(Om, 16 * sb, 16 * tb, acc, lane);
        }
#pragma unroll 1
        for (int it = 0; it < 3; ++it) {
            const int n = w + 8 * it, X = n / 6, p = n % 6;
            const int tb = (p >= 5) ? 2 : (p >= 3) ? 1 : 0, sb = (tb == 0) ? p + 1 : (tb == 1) ? p - 1 : 3;
            st_nat(L + A_RAW + X * TL, 16 * sb, 16 * tb, (f32x4){0.f, 0.f, 0.f, 0.f}, lane);
        }
        LBAR();
        f32x4 rhs[4];
        if (w < 4) {
            if (lane < 16) {
                const int bb = w, r = lane; float Tr[16];
#pragma unroll
                for (int t = 0; t < 16; ++t) {
                    const u32x4 m0 = *(const LAS u32x4*)(MabT + toff(16 * bb + t, 2 * bb)), m1 = *(const LAS u32x4*)(MabT + toff(16 * bb + t, 2 * bb + 1));
                    const unsigned mw[8] = {m0.x, m0.y, m0.z, m0.w, m1.x, m1.y, m1.z, m1.w};
                    float acc = (r == t) ? 1.f : 0.f;
#pragma unroll
                    for (int s2 = 0; s2 < 16; ++s2) if (s2 < t) acc += Tr[s2] * ((s2 & 1) ? bfhi(mw[s2 >> 1]) : bflo(mw[s2 >> 1]));
                    Tr[t] = acc;
                }
#pragma unroll
                for (int t2 = 0; t2 < 16; ++t2) *(LAS bf16_t*)(TB + bb * 512 + t2 * 32 + r * 2) = (bf16_t)f2bf(Tr[t2]);
            }
#pragma unroll
            for (int bb = 0; bb < 4; ++bb) rhs[bb] = ld_nat(AtT, 16 * bb, 16 * w, lane);
        } else {
#pragma unroll
            for (int bb = 0; bb < 4; ++bb) rhs[bb] = mm64((f32x4){0.f, 0.f, 0.f, 0.f}, MkaT, 16 * bb, VT, 16 * (w - 4), lane);
        }
        { lp Xw = (w < 4 ? XP : XQ) + (16 * (w & 3)) * 128; *(LAS u32x4*)(Xw + lane * 32) = (u32x4){0u, 0u, 0u, 0u}; *(LAS u32x4*)(Xw + lane * 32 + 16) = (u32x4){0u, 0u, 0u, 0u}; }
        LBAR();
        {
            lp Xt = (w < 4) ? XP : XQ; const int r0 = 16 * (w & 3); const int q = lane >> 4, rr = lane & 15;
#pragma unroll
            for (int bb = 0; bb < 4; ++bb) {
                f32x4 acc = rhs[bb];
                if (bb > 0) acc = mm64(acc, MabT, 16 * bb, Xt, r0, lane);
                st_nat(Xt, 16 * bb, r0, acc, lane);
                asm volatile("s_waitcnt lgkmcnt(0)" ::: "memory");
                bf16x8 ta = (bf16x8){0, 0, 0, 0, 0, 0, 0, 0}, xb = ta;
                if (q < 2) { ta = *(const LAS bf16x8*)(TB + bb * 512 + rr * 32 + q * 16); xb = ldfrag(Xt, r0 + rr, 2 * bb + q); }
                const f32x4 d2 = __builtin_amdgcn_mfma_f32_16x16x32_bf16(ta, xb, (f32x4){0.f, 0.f, 0.f, 0.f}, 0, 0, 0);
                st_nat(Xt, 16 * bb, r0, d2, lane);
                asm volatile("s_waitcnt lgkmcnt(0)" ::: "memory");
            }
        }
        LBAR();
        if (mcon) mcv_store(mcd, mcv);
        const bool mcon2 = mcid + 256 * NWAVES < MCV_ITEMS;
        if (mcon2) mcd = mcv_load(A, F.ws, mcid + 256 * NWAVES, lane, mcv);
#pragma unroll 2
        for (int it = 0; it < 4; ++it) {
            const int id = 4 * w + it, nb = (id >> 2) & 3, mb = id & 3;
            if (id < 16) { f32x4 acc = ld_nat(RtM, 16 * mb, 16 * nb, lane);
                acc = mm64(acc, XP, 16 * mb, NbrT, 16 * nb, lane); st_nat(ZT, 16 * mb, 16 * nb, acc, lane); }
            else { f32x4 acc = mm64((f32x4){0.f, 0.f, 0.f, 0.f}, XP, 16 * mb, BtT, 16 * nb, lane);
                const int jn = 16 * nb + (lane & 15), jm = 16 * mb + 4 * (lane >> 4); const float dc = DCv[jn];
#pragma unroll
                for (int e = 0; e < 4; ++e) acc[e] = (acc[e] + ((jm + e == jn) ? 1.f : 0.f)) * dc;
                st_nat(GcT, 16 * mb, 16 * nb, acc, lane); }
        }
        LBAR();
#pragma unroll 2
        for (int it = 0; it < 8; ++it) {
            const int kind = it & 3, ti = (it >> 2) * 8 + w, nb = ti >> 2, mb = ti & 3;
            if (kind == 0) { f32x4 acc = mm64((f32x4){0.f, 0.f, 0.f, 0.f}, XQ, 16 * mb, NbrT, 16 * nb, lane); acc = mm64(acc, VT, 16 * mb, NkrT, 16 * nb, lane); acc = mm64(acc, SL, 16 * mb, ZT, 16 * nb, lane);
                st_nat(YT, 16 * mb, 16 * nb, acc, lane); }
            else if (kind == 1) { f32x4 acc = mm64((f32x4){0.f, 0.f, 0.f, 0.f}, BtT, 16 * mb, XQ, 16 * nb, lane); acc = mm64(acc, KtT, 16 * mb, VT, 16 * nb, lane);
                const f32x4 dc = *(const LAS f32x4*)(DCv + 16 * mb + 4 * (lane >> 4)); acc = acc * dc;
                acc = mm64(acc, GcT, 16 * mb, SL, 16 * nb, lane); st_nat(TS, 16 * mb, 16 * nb, acc, lane); }
            else if (kind == 2) { const f32x4 acc = mm64((f32x4){0.f, 0.f, 0.f, 0.f}, SG, 16 * mb, ZT, 16 * nb, lane); st_nat(ZC, 16 * mb, 16 * nb, acc, lane); }
            else { const f32x4 acc = mm64((f32x4){0.f, 0.f, 0.f, 0.f}, GcT, 16 * mb, SG, 16 * nb, lane); st_nat(TG, 16 * mb, 16 * nb, acc, lane); }
        }
        LBAR();
        {
            const int o = toff(tA, jsA);
            const u32x4 y16 = *(const LAS u32x4*)(YT + o), z16 = *(const LAS u32x4*)(ZC + o);
            const u32x4 g16 = *(const LAS u32x4*)(TG + tid * 16), s16 = *(const LAS u32x4*)(TS + tid * 16);
            const size_t go = rowbase + (size_t)c * 64 * D;
            *(u32x4*)(gYL + go) = y16; *(u32x4*)(gZC + go) = z16;
            if (jsA == 0) gBS[(trow0 + (size_t)c * 64 + tA) * NH + h] = BSC[tA];
            *(LAS u32x4*)(SG + tid * 16) = g16; *(LAS u32x4*)(SL + tid * 16) = s16;
            if (c + 1 < NCHQ) { *(LAS u32x4*)(AtM + o) = nw; *(LAS u32x4*)(RtM + o) = na; }
        }
        if (mcon2) mcv_store(mcd, mcv);
        LBAR();
    }
    { u32x4* seg = (u32x4*)(F.ws + WS_SEG) + (size_t)unit * 1024; seg[tid] = *(const LAS u32x4*)(SG + tid * 16); seg[512 + tid] = *(const LAS u32x4*)(SL + tid * 16); }
}
__device__ __forceinline__ void phase_scanB(Frame& F, const Args& A) {
    using namespace sm;
    const int unit = F.vcu, bh = unit >> 2, qq = unit & 3, b = bh / NH, h = bh % NH;
    const int tid = F.tid, lane = F.lane, w = F.wave;
    const int tA = tid >> 3, jsA = tid & 7;
    lp L = F.lds;
    LAS float* Sf = (LAS float*)L;
    LAS float* Gf = Sf + 64 * 65;
    lp SS = L + 40960, YLt = SS + TL, ZCt = YLt + TL; LAS float* LCy = (LAS float*)(ZCt + TL);
    LAS float* PRM = LCy + 64 * LCS;
    if (tid < 64) { const int ch = h * HS + tid; PRM[tid] = A.in[I_LNG][ch]; PRM[64 + tid] = A.in[I_LNB][ch]; }
    lp LgT = L + 90112, W2T = LgT + 3 * TL; LAS float* Gy = (LAS float*)(W2T + 3 * TL);
    { const bf16_t* W2 = (const bf16_t*)(F.ws + WS_WL2) + (size_t)(2 * D + h * HS + tA) * 256 + 8 * jsA;
#pragma unroll
      for (int i = 0; i < 3; ++i) *(LAS u32x4*)(W2T + i * TL + toff(tA, jsA)) = *(const u32x4*)(W2 + 64 * i); }
    const bf16_t* gL = (const bf16_t*)A.out;
    const int ci = tid >> 3, cj0 = (tid & 7) * 8;
    float sv[8];
#pragma unroll
    for (int p = 0; p < 8; ++p) sv[p] = 0.f;
    for (int q2 = 0; q2 < qq; ++q2) {
        const unsigned char* seg = (const unsigned char*)(F.ws + WS_SEG) + (size_t)(bh * 4 + q2) * 16384;
        const u32x4 g16 = *(const u32x4*)(seg + toff(ci, cj0 >> 3)), h16 = *(const u32x4*)(seg + 8192 + toff(ci, cj0 >> 3));
#pragma unroll
        for (int p = 0; p < 8; ++p) Sf[ci * 65 + cj0 + p] = sv[p];
        { const unsigned gw[4] = {g16.x, g16.y, g16.z, g16.w};
#pragma unroll
          for (int p = 0; p < 4; ++p) { Gf[ci * 64 + cj0 + 2 * p] = bflo(gw[p]); Gf[ci * 64 + cj0 + 2 * p + 1] = bfhi(gw[p]); } }
        LBAR();
        const unsigned hw[4] = {h16.x, h16.y, h16.z, h16.w};
        float o[8] = {bflo(hw[0]), bfhi(hw[0]), bflo(hw[1]), bfhi(hw[1]), bflo(hw[2]), bfhi(hw[2]), bflo(hw[3]), bfhi(hw[3])};
#pragma unroll 8
        for (int k = 0; k < 64; ++k) { const float sk = Sf[ci * 65 + k]; const f32x4 g0 = *(const LAS f32x4*)(Gf + k * 64 + cj0), g1 = *(const LAS f32x4*)(Gf + k * 64 + cj0 + 4);
            o[0] += sk * g0[0]; o[1] += sk * g0[1]; o[2] += sk * g0[2]; o[3] += sk * g0[3]; o[4] += sk * g1[0]; o[5] += sk * g1[1]; o[6] += sk * g1[2]; o[7] += sk * g1[3]; }
#pragma unroll
        for (int p = 0; p < 8; ++p) sv[p] = o[p];
        LBAR();
    }
    *(LAS u32x4*)(SS + toff(ci, cj0 >> 3)) = (u32x4){pk2(sv[0], sv[1]), pk2(sv[2], sv[3]), pk2(sv[4], sv[5]), pk2(sv[6], sv[7])};
    const bf16_t* gYL = (const bf16_t*)(F.ws + WS_R); const bf16_t* gZC = (const bf16_t*)(F.ws + WS_K); const bf16_t* gV = (const bf16_t*)(F.ws + WS_V); const bf16_t* gG = (const bf16_t*)(F.ws + WS_GG);
    const float* gBS = (const float*)(F.ws + WS_BSC); bf16_t* gO = (bf16_t*)(F.ws + WS_R);
    const size_t trow0 = (size_t)b * SEQ + (size_t)qq * SEQQ;
    const size_t rowbase = (trow0 + tA) * D + h * HS + jsA * 8;
    u32x4 ny = *(const u32x4*)(gYL + rowbase), nz = *(const u32x4*)(gZC + rowbase), nv = *(const u32x4*)(gV + rowbase), ng0, ng1, ng2; float nbs = gBS[(trow0 + tA) * NH + h];
    const size_t lbase = (trow0 + tA) * LACT_LD + 128 + jsA * 8;
    ng0 = *(const u32x4*)(gL + lbase); ng1 = *(const u32x4*)(gL + lbase + 64); ng2 = *(const u32x4*)(gL + lbase + 128);
    LBAR();
#pragma unroll 1
    for (int c = 0; c < NCHQ; ++c) {
        const u32x4 cy = ny, cz = nz, cv = nv; const float bs = nbs;
        { const int o = toff(tA, jsA); *(LAS u32x4*)(YLt + o) = cy; *(LAS u32x4*)(ZCt + o) = cz; *(LAS u32x4*)(LgT + o) = ng0; *(LAS u32x4*)(LgT + TL + o) = ng1; *(LAS u32x4*)(LgT + 2 * TL + o) = ng2; }
        if (c + 1 < NCHQ) { const size_t o = rowbase + (size_t)(c + 1) * 64 * D; ny = *(const u32x4*)(gYL + o); nz = *(const u32x4*)(gZC + o); nv = *(const u32x4*)(gV + o); nbs = gBS[(trow0 + (size_t)(c + 1) * 64 + tA) * NH + h];
            const size_t lo = lbase + (size_t)(c + 1) * 64 * LACT_LD; ng0 = *(const u32x4*)(gL + lo); ng1 = *(const u32x4*)(gL + lo + 64); ng2 = *(const u32x4*)(gL + lo + 128); }
        LBAR();
#pragma unroll
        for (int it = 0; it < 2; ++it) { const int mb = w & 3, nb = 2 * (w >> 2) + it;
            f32x4 acc = ld_nat(YLt, 16 * mb, 16 * nb, lane); acc = mm64(acc, SS, 16 * mb, ZCt, 16 * nb, lane);
            *(LAS f32x4*)(LCy + (16 * nb + (lane & 15)) * LCS + 16 * mb + 4 * (lane >> 4)) = acc;
            f32x4 ga = (f32x4){0.f, 0.f, 0.f, 0.f};
#pragma unroll
            for (int i = 0; i < 3; ++i) ga = mm64(ga, W2T + i * TL, 16 * mb, LgT + i * TL, 16 * nb, lane);
            *(LAS f32x4*)(Gy + (16 * nb + (lane & 15)) * LCS + 16 * mb + 4 * (lane >> 4)) = ga; }
        LBAR();
        {
            const f32x4 y0 = *(const LAS f32x4*)(LCy + tA * LCS + 8 * jsA), y1 = *(const LAS f32x4*)(LCy + tA * LCS + 8 * jsA + 4);
            float yv[8] = {y0[0], y0[1], y0[2], y0[3], y1[0], y1[1], y1[2], y1[3]};
            float s1 = 0.f;
#pragma unroll
            for (int p = 0; p < 8; ++p) s1 += yv[p];
            const float mean = red8(s1) * (1.0f / 64.0f); float s2 = 0.f;
#pragma unroll
            for (int p = 0; p < 8; ++p) { yv[p] -= mean; s2 += yv[p] * yv[p]; }
            const float rstd = rsqrtf(red8(s2) * (1.0f / 64.0f) + LNX_EPS);
            const f32x4 g0 = *(const LAS f32x4*)(PRM + 8 * jsA), g1 = *(const LAS f32x4*)(PRM + 8 * jsA + 4), b0 = *(const LAS f32x4*)(PRM + 64 + 8 * jsA), b1 = *(const LAS f32x4*)(PRM + 64 + 8 * jsA + 4);
            const unsigned vw[4] = {cv.x, cv.y, cv.z, cv.w};
            const f32x4 gq0 = *(const LAS f32x4*)(Gy + tA * LCS + 8 * jsA), gq1 = *(const LAS f32x4*)(Gy + tA * LCS + 8 * jsA + 4);
            float ov[8];
#pragma unroll
            for (int p = 0; p < 8; ++p) { const float lg = p < 4 ? g0[p & 3] : g1[p & 3], lb = p < 4 ? b0[p & 3] : b1[p & 3];
                const float vv = (p & 1) ? bfhi(vw[p >> 1]) : bflo(vw[p >> 1]), gg = p < 4 ? gq0[p & 3] : gq1[p & 3];
                ov[p] = (yv[p] * rstd * lg + lb + bs * vv) * gg; }
            *(u32x4*)(gO + rowbase + (size_t)c * 64 * D) = (u32x4){pk2(ov[0], ov[1]), pk2(ov[2], ov[3]), pk2(ov[4], ov[5]), pk2(ov[6], ov[7])};
        }
    }
}

__device__ __forceinline__ void phase_post3(Frame& F, const Args& A, const RowP& P) {
    LAS float* rt = (LAS float*)F.lds;
    LAS int* sel = (LAS int*)(F.lds + 32768);
    LAS int* cnts = (LAS int*)(F.lds + 32768 + 1024);
    LAS int* bef = (LAS int*)(F.lds + 32768 + 2048);
    for (int i = F.tid; i < D * NE / 4; i += NTHREADS) ((LAS f32x4*)rt)[i] = ((const f32x4*)A.in[I_ROUTER])[i];
    __syncthreads();
    int* toke = (int*)(F.ws + WS_TOKE); float* tokw = (float*)(F.ws + WS_TOKW); int* tokli = (int*)(F.ws + WS_TOKLI); int* cnt = (int*)(F.ws + WS_CNT);
    const int wgi = blockIdx.x;
    RowIn cur, nxt; row_load(P, wgi * 128 + F.wave * 16, F.lane, cur);
    for (int s = 0; s < 16; ++s) {
        const int tl = F.wave * 16 + s, t = wgi * 128 + tl;
        if (s + 1 < 16) row_load(P, t + 1, F.lane, nxt);
        f32x4 hv[4]; row_compute(P, t, F.lane, cur, hv, true); cur = nxt;
        float lg[8];
#pragma unroll
        for (int e = 0; e < 8; ++e) lg[e] = 0.f;
#pragma unroll
        for (int j = 0; j < 4; ++j)
#pragma unroll
            for (int q = 0; q < 4; ++q) { const int c = 4 * F.lane + 256 * j + q; const f32x4 r0 = *(const LAS f32x4*)(rt + c * 8), r1 = *(const LAS f32x4*)(rt + c * 8 + 4); const float hvv = hv[j][q];
                lg[0] += hvv * r0[0]; lg[1] += hvv * r0[1]; lg[2] += hvv * r0[2]; lg[3] += hvv * r0[3]; lg[4] += hvv * r1[0]; lg[5] += hvv * r1[1]; lg[6] += hvv * r1[2]; lg[7] += hvv * r1[3]; }
        {
            const bool h5 = F.lane & 32, h4 = F.lane & 16, h3 = F.lane & 8;
            float a4[4];
#pragma unroll
            for (int i = 0; i < 4; ++i) { const float mine = h5 ? lg[i + 4] : lg[i], send = h5 ? lg[i] : lg[i + 4]; a4[i] = mine + __shfl_xor(send, 32); }
            float a2[2];
#pragma unroll
            for (int i = 0; i < 2; ++i) { const float mine = h4 ? a4[i + 2] : a4[i], send = h4 ? a4[i] : a4[i + 2]; a2[i] = mine + __shfl_xor(send, 16); }
            float a1 = (h3 ? a2[1] : a2[0]) + __shfl_xor(h3 ? a2[0] : a2[1], 8);
            a1 += __shfl_xor(a1, 1); a1 += __shfl_xor(a1, 2); a1 += __shfl_xor(a1, 4);
#pragma unroll
            for (int e = 0; e < 8; ++e) lg[e] = __builtin_bit_cast(float, __builtin_amdgcn_readlane(__builtin_bit_cast(int, a1), e * 8));
        }
        int e0 = 0; float m0 = lg[0];
#pragma unroll
        for (int e = 1; e < 8; ++e) if (lg[e] > m0) { m0 = lg[e]; e0 = e; }
        int e1 = -1; float m1 = -3.0e38f;
#pragma unroll
        for (int e = 0; e < 8; ++e) if (e != e0 && lg[e] > m1) { m1 = lg[e]; e1 = e; }
        const float w1 = 1.0f / (1.0f + __expf(m0 - m1)), w0 = 1.0f - w1;
        if (F.lane == 0) { toke[2 * t] = e0; toke[2 * t + 1] = e1; tokw[2 * t] = w0; tokw[2 * t + 1] = w1; sel[2 * tl] = e0; sel[2 * tl + 1] = e1; }
    }
    __syncthreads();
    if (F.tid < 256) {
        const int e = sel[F.tid];
        int before = 0;
#pragma unroll
        for (int q = 0; q < 8; ++q) { const unsigned long long mk = __ballot(e == q); if (e == q) before = __popcll(mk & ((1ull << F.lane) - 1ull)); if (F.lane == 0) cnts[F.wave * 8 + q] = __popcll(mk); }
        bef[F.tid] = before;
    }
    __syncthreads();
    if (F.tid < 256) {
        const int p = F.tid, tl = p >> 1, t = wgi * 128 + tl; const int e = sel[p];
        int base = 0; for (int w = 0; w < F.wave; ++w) base += cnts[w * 8 + e];
        tokli[2 * t + (p & 1)] = base + bef[p];
    }
    if (F.tid < 8) cnt[wgi * 8 + F.tid] = cnts[F.tid] + cnts[8 + F.tid] + cnts[16 + F.tid] + cnts[24 + F.tid];
}
__device__ __forceinline__ void phase_route(Frame& F) {
    LAS int* tot = (LAS int*)F.lds;
    const int* cnt = (const int*)(F.ws + WS_CNT); const int wgi = blockIdx.x;
    { const int e = F.wave; int s = 0, pre = 0;
      for (int v = F.lane; v < 256; v += 64) { const int c = cnt[v * 8 + e]; s += c; if (v < wgi) pre += c; }
      s = (int)wave_sum((float)s); pre = (int)wave_sum((float)pre);
      if (F.lane == 0) { tot[e] = s; tot[8 + e] = pre; } }
    __syncthreads();
    if (F.tid == 0) { int st = 0; for (int e = 0; e < 8; ++e) { tot[16 + e] = st; st += ((tot[e] + 255) >> 8) << 8; } tot[24] = st; }
    __syncthreads();
    const int* toke = (const int*)(F.ws + WS_TOKE); const int* tokli = (const int*)(F.ws + WS_TOKLI); int* tokslot = (int*)(F.ws + WS_TOKSLOT); int* rowidx = (int*)(F.ws + WS_ROWIDX); int* tilee = (int*)(F.ws + WS_TILEE);
    if (F.tid < 256) { const int p = F.tid, t = wgi * 128 + (p >> 1), e = toke[2 * t + (p & 1)]; const int slot = tot[16 + e] + tot[8 + e] + tokli[2 * t + (p & 1)];
        tokslot[2 * t + (p & 1)] = slot; rowidx[slot] = t; }
    if (wgi < 8) { const int e = wgi; const int s0 = tot[16 + e] + tot[e], s1 = tot[16 + e] + (((tot[e] + 255) >> 8) << 8); for (int s = s0 + F.tid; s < s1; s += NTHREADS) rowidx[s] = 0; }
    if (wgi == 8) { const int nt = tot[24] >> 8; for (int i = F.tid; i < nt; i += NTHREADS) { int e = 0; for (int q = 1; q < 8; ++q) if (i * 256 >= tot[16 + q]) e = q; tilee[i] = e; }
        if (F.tid == 0) ((unsigned*)(F.ws + WS_CTL))[CW_MOE_NM] = (unsigned)nt; }
}
struct FinIn { u32x2 xw[4]; u32x2 a[4]; u32x2 c[4]; };
__device__ __forceinline__ void fin_load(FinIn& in, const float* out, const bf16_t* Y2, int t, int s0, int s1, int lane) {
    const GAS u32x2* xb = (const GAS u32x2*)((const bf16_t*)out + (size_t)t * 2048 + 1024) + lane;
    const GAS u32x2* y0 = (const GAS u32x2*)(Y2 + (size_t)s0 * D) + lane; const GAS u32x2* y1 = (const GAS u32x2*)(Y2 + (size_t)s1 * D) + lane;
#pragma unroll
    for (int j = 0; j < 4; ++j) in.xw[j] = xb[64 * j];
#pragma unroll
    for (int j = 0; j < 4; ++j) { in.a[j] = y0[64 * j]; in.c[j] = y1[64 * j]; }
}
__device__ __forceinline__ void phase_final(Frame& F, float* out, const float* gate, const float* gpost) {
    const int gw = F.vcu * NWAVES + F.wave, NGW = F.G * NWAVES; const int lane = F.lane;
    const int* tokslot = (const int*)(F.ws + WS_TOKSLOT); const float* tokw = (const float*)(F.ws + WS_TOKW); const bf16_t* Y2 = (const bf16_t*)(F.ws + WS_Y2);
    int t = gw; if (t >= T) return;
    FinIn cur, nxt;
    float w0 = tokw[2 * t], w1 = tokw[2 * t + 1];
    fin_load(cur, out, Y2, t, tokslot[2 * t], tokslot[2 * t + 1], lane);
    int tn = t + NGW;
    int s0n = 0, s1n = 0; float w0n = 0.f, w1n = 0.f;
    if (tn < T) { s0n = tokslot[2 * tn]; s1n = tokslot[2 * tn + 1]; w0n = tokw[2 * tn]; w1n = tokw[2 * tn + 1]; }
#pragma unroll 1
    for (; t < T; t = tn, tn += NGW) {
        int s0f = 0, s1f = 0; float w0f = 0.f, w1f = 0.f;
        if (tn < T) fin_load(nxt, out, Y2, tn, s0n, s1n, lane);
        { const int tf = tn + NGW; if (tf < T) { s0f = tokslot[2 * tf]; s1f = tokslot[2 * tf + 1]; w0f = tokw[2 * tf]; w1f = tokw[2 * tf + 1]; } }
        const int b = t / SEQ;
        f32x4 yv[4]; float ss = 0.f;
#pragma unroll
        for (int j = 0; j < 4; ++j) { const u32x2 a = cur.a[j], c = cur.c[j];
            yv[j] = (f32x4){w0 * bflo(a.x) + w1 * bflo(c.x), w0 * bfhi(a.x) + w1 * bfhi(c.x), w0 * bflo(a.y) + w1 * bflo(c.y), w0 * bfhi(a.y) + w1 * bfhi(c.y)};
            ss += (yv[j].x * yv[j].x + yv[j].y * yv[j].y) + (yv[j].z * yv[j].z + yv[j].w * yv[j].w); }
        const float rs = rsqrtf(wave_sum(ss) * (1.0f / D) + RMS_EPS);
        GAS f32x4* xo = (GAS f32x4*)(out + (size_t)t * D) + lane;
        asm volatile("" :: "v"(cur.xw[0].x), "v"(cur.xw[0].y), "v"(cur.xw[1].x), "v"(cur.xw[1].y), "v"(cur.xw[2].x), "v"(cur.xw[2].y), "v"(cur.xw[3].x), "v"(cur.xw[3].y) : "memory");
#pragma unroll
        for (int j = 0; j < 4; ++j) { const f32x4 gt = *((const f32x4*)(gate + (size_t)b * 6144) + lane + 64 * j); const f32x4 gp = *((const f32x4*)gpost + lane + 64 * j);
            const f32x4 xv = (f32x4){bflo(cur.xw[j].x), bfhi(cur.xw[j].x), bflo(cur.xw[j].y), bfhi(cur.xw[j].y)};
            xo[64 * j] = xv + gt * gp * yv[j] * rs; }
        cur = nxt; w0 = w0n; w1 = w1n; s0n = s0f; s1n = s1f; w0n = w0f; w1n = w1f;
    }
}
__device__ __forceinline__ void zero_h2_rows(Frame& F) {
    bf16_t* H2 = (bf16_t*)(F.ws + WS_H2);
    if (F.vcu < BATCH && F.tid < 128) ((u32x4*)(H2 + (size_t)F.vcu * (SEQ + 1) * D))[F.tid] = (u32x4){0u, 0u, 0u, 0u};
}

__device__ __forceinline__ bool launder(Frame& F) { int t = F.tid; asm volatile("" : "+v"(t)); F.tid = t; F.lane = t & 63; return true; }
constexpr int NPHASE = 22;
__device__ __forceinline__ pg8::GemmDesc mkdesc(const bf16_t* A, int lda, const bf16_t* Bt, int K, int nM, int nN, int mode, bf16_t* o0, int ldc) {
    pg8::GemmDesc g; g.A = A; g.Bt = Bt; g.lda = lda; g.K = K; g.nM = nM; g.nN = nN; g.a_bt = 0; g.a_bx = 0; g.a_pn_split = 1 << 30; g.a_pn_coloff = 0; g.a_pn_div = 1 << 30; g.a_pn_stride = 0; g.pn_bias = 0; g.rowidx = nullptr; g.tile_e = nullptr; g.b_estride = 0;
    g.mode = mode; g.o0 = o0; g.o1 = nullptr; g.o2 = nullptr; g.ldc = ldc; g.p0 = nullptr; g.p1 = nullptr; g.flag = 0; return g;
}

__global__ void __launch_bounds__(NTHREADS, 2) fwd_kernel(Args args) {
    extern __shared__ __attribute__((aligned(16))) unsigned char lds_raw[];
    Frame F;
    F.lds = (LAS unsigned char*)lds_raw;
    F.tid = threadIdx.x; F.lane = F.tid & 63; F.wave = __builtin_amdgcn_readfirstlane(F.tid >> 6);
    F.G = gridDim.x; { const int bx = blockIdx.x; F.vcu = (F.G % 8 == 0) ? (bx % 8) * (F.G / 8) + bx / 8 : bx; }
    F.ws = args.ws;
    volatile LAS unsigned* MISC = (volatile LAS unsigned*)(F.lds + MISC_OFF);
    if (F.tid < 16) MISC[F.tid] = 0u;
    __syncthreads();
    unsigned* ctl = (unsigned*)(F.ws + WS_CTL);
    XcdBarrier bar; bar.bar = ctl + CW_BAR; bar.x = 0; bar.st = nullptr;
#if N_LAUNCH_MODE == 0
    bar = xcd_barrier_post(ctl + CW_BAR, MISC + 8);
#endif
    unsigned char* ws = F.ws;
    const float* mod = (const float*)(ws + WS_MOD);
    const float* ng = args.in[I_NORMG];
    const int lo = args.ph_lo, hi = args.ph_hi;
    const int cid = (int)blockIdx.x;
#define MODP(l, ch) (mod + (size_t)(l) * 4 * 6144 + (ch) * D)
    bf16_t* H = (bf16_t*)(ws + WS_H);

#define PHASE(k) if (lo <= (k) && (k) < hi && launder(F))
#define INP(k) (lo <= (k) && (k) < hi)
#define SEAM(k) do { if (INP(k) && INP((k) + 1)) xcd_barrier(bar); } while (0)
#define GEMM(GATH, g) pg8::gemm_phase<GATH>(F.lds, g, F.G, cid, F.tid)
    PHASE(0) { phase_prologue(F, args); } SEAM(0);
    PHASE(1) { RowP P{args.in[I_X], nullptr, nullptr, nullptr, nullptr, ng + 0 * D, MODP(0, 1), MODP(0, 0), H, 0, nullptr, 0, 0}; phase_rows(F, P); } SEAM(1);
    PHASE(2) { pg8::GemmDesc g = mkdesc(H, D, (const bf16_t*)(ws + WS_WIN), D, T / 256, MIXIN / 256, pg8::EM_MIXIN, (bf16_t*)(ws + WS_Z), ZLD); GEMM(false, g); } SEAM(2);
    PHASE(3) { phase_mix(F, args); } SEAM(3);
    PHASE(4) { pg8::GemmDesc g = mkdesc((const bf16_t*)(ws + WS_A2), D, (const bf16_t*)(ws + WS_WOUTE), D, T / 256, D / 256, pg8::EM_BF16, (bf16_t*)(ws + WS_Y0), D); GEMM(false, g); } SEAM(4);
    PHASE(5) { RowP P{args.in[I_X], args.out, (const bf16_t*)(ws + WS_Y0), MODP(0, 2), ng + 1 * D, ng + 2 * D, MODP(0, 4), MODP(0, 3), H, 0, (float*)(ws + WS_XH), 0, 1}; phase_rows(F, P); } SEAM(5);
    PHASE(6) { pg8::GemmDesc g = mkdesc(H, D, (const bf16_t*)(ws + WS_WFGU), D, T / 256, 2 * FF / 256, pg8::EM_SWIGLU, (bf16_t*)(ws + WS_HFF), FF); GEMM(false, g); } SEAM(6);
    PHASE(7) { pg8::GemmDesc g = mkdesc((const bf16_t*)(ws + WS_HFF), FF, (const bf16_t*)(ws + WS_WFD), FF, T / 256, D / 256, pg8::EM_BF16, (bf16_t*)(ws + WS_Y0), D); GEMM(false, g); } SEAM(7);
    PHASE(8) { RowP P{args.out, args.out, (const bf16_t*)(ws + WS_Y0), MODP(0, 5), ng + 3 * D, ng + 4 * D, MODP(1, 1), MODP(1, 0), (bf16_t*)(ws + WS_H2), 1, nullptr, 1, 1}; phase_post2(F, args, P); zero_h2_rows(F); } SEAM(8);
    PHASE(9) {
        { pg8::GemmDesc g = mkdesc((const bf16_t*)(ws + WS_XR), D, (const bf16_t*)(ws + WS_WRKV), D, T / 256, 12, pg8::EM_RKVL, (bf16_t*)(ws + WS_R), D);
          g.a_pn_div = 4; g.a_pn_stride = (long)T * D; GEMM(false, g); }
        { pg8::GemmDesc g = mkdesc((const bf16_t*)(ws + WS_H2), D, (const bf16_t*)(ws + WS_WLOR), 2 * D, T / 256, 2, pg8::EM_RKVL, (bf16_t*)(ws + WS_R), D);
          g.a_bt = SEQ / 256; g.a_bx = 1; g.o1 = (bf16_t*)args.out; g.pn_bias = 12; GEMM(false, g); } } SEAM(9);
    PHASE(11) { phase_scanA(F, args); } SEAM(11);
    PHASE(12) { phase_scanB(F, args); } SEAM(12);
    PHASE(14) { pg8::GemmDesc g = mkdesc((const bf16_t*)(ws + WS_R), D, (const bf16_t*)(ws + WS_WO), D, T / 256, D / 256, pg8::EM_BF16, (bf16_t*)(ws + WS_Y1), D); GEMM(false, g);
        } SEAM(14);
    PHASE(15) { RowP P{args.out, args.out, (const bf16_t*)(ws + WS_Y1), MODP(1, 2), ng + 5 * D, ng + 6 * D, MODP(1, 4), MODP(1, 3), (bf16_t*)(ws + WS_H3), 0, nullptr, 1, 1}; phase_post3(F, args, P); } SEAM(15);
    PHASE(16) { phase_route(F); } SEAM(16);
#define MOE1(p1) PHASE(p1) { const int moe_nm = (int)__hip_atomic_load(ctl + CW_MOE_NM, __ATOMIC_RELAXED, __HIP_MEMORY_SCOPE_AGENT); \
        pg8::GemmDesc g = mkdesc((const bf16_t*)(ws + WS_H3), D, (const bf16_t*)(ws + WS_WMGU), D, moe_nm, 2 * FH / 256, pg8::EM_SWIGLU, (bf16_t*)(ws + WS_HM), FH); \
        g.rowidx = (const int*)(ws + WS_ROWIDX); g.tile_e = (const int*)(ws + WS_TILEE); g.b_estride = (long)FF * D; GEMM(true, g); } SEAM(p1)
#define MOE2(p2, half) PHASE(p2) { const int moe_nm = (int)__hip_atomic_load(ctl + CW_MOE_NM, __ATOMIC_RELAXED, __HIP_MEMORY_SCOPE_AGENT); \
        pg8::GemmDesc g = mkdesc((const bf16_t*)(ws + WS_HM), FH, (const bf16_t*)(ws + (half ? WS_WMD1 : WS_WMD0)), FH, moe_nm, D / 256, pg8::EM_MOE2, (bf16_t*)(ws + WS_Y2), D); \
        g.tile_e = (const int*)(ws + WS_TILEE); g.b_estride = (long)D * FH; g.flag = half; GEMM(false, g); \
        if (half == 0) { __syncthreads();     \
            const int nbusy = (moe_nm * (D / 256)) % F.G; const bool excl = nbusy > 0 && nbusy <= 64; \
            if (!(excl && cid < nbusy)) moe_convert(F, args, 0, 1, (bf16_t*)(ws + WS_WMGU), excl ? cid - nbusy : F.vcu, excl ? F.G - nbusy : F.G); \
            __syncthreads(); } } SEAM(p2)
    MOE1(17); MOE2(18, 0); MOE1(19); MOE2(20, 1);
#undef MOE1
#undef MOE2
    PHASE(21) { phase_final(F, args.out, MODP(1, 5), ng + 7 * D); }
#undef PHASE
#undef INP
#undef SEAM
#undef GEMM
#undef MODP
}

extern "C" void kernel_launch(void* const* d_in, const int* in_sizes, int n_in, void* d_out, int out_size, void* d_ws, size_t ws_size, hipStream_t stream) {
    static int grid = 0;
    if (grid == 0) {
        if (n_in != 35 || in_sizes[0] != T * D || out_size != T * D || ws_size < WS_END) { fprintf(stderr, "kernel_launch: unexpected shapes: n_in %d in0 %d out %d ws %zu (need %zu)\n", n_in, n_in > 0 ? in_sizes[0] : -1, out_size, ws_size, (size_t)WS_END); grid = -1; return; }
        int dev = 0, cus = 0, per_cu = 0;
        if (hipGetDevice(&dev) != hipSuccess || hipDeviceGetAttribute(&cus, hipDeviceAttributeMultiprocessorCount, dev) != hipSuccess) { grid = -1; return; }
        if (hipFuncSetAttribute((const void*)fwd_kernel, hipFuncAttributeMaxDynamicSharedMemorySize, LDS_BYTES) != hipSuccess) { fprintf(stderr, "kernel_launch: hipFuncSetAttribute failed\n"); grid = -1; return; }
        if (hipOccupancyMaxActiveBlocksPerMultiprocessor(&per_cu, (const void*)fwd_kernel, NTHREADS, LDS_BYTES) != hipSuccess || per_cu < 1) fprintf(stderr, "kernel_launch: occupancy query reports %d\n", per_cu);
        (void)hipGetLastError();
        grid = cus;
        if (grid != 256) fprintf(stderr, "kernel_launch: %d CUs (built for 256)\n", grid);
    }
    if (grid < 0) return;
    (void)hipMemsetAsync((char*)d_ws + WS_CTL, 0, CTL_ZERO_BYTES, stream);
    Args a{};
    for (int i = 0; i < 35; ++i) a.in[i] = (const float*)d_in[i];
    a.out = (float*)d_out; a.ws = (unsigned char*)d_ws;
#if N_LAUNCH_MODE == 0
    a.ph_lo = 0; a.ph_hi = NPHASE;
    hipLaunchKernelGGL(fwd_kernel, dim3(grid), dim3(NTHREADS), LDS_BYTES, stream, a);
#else
    for (int p = 0; p < NPHASE; ++p) { a.ph_lo = p; a.ph_hi = p + 1; hipLaunchKernelGGL(fwd_kernel, dim3(grid), dim3(NTHREADS), LDS_BYTES, stream, a); }
#endif
}
```

```cpp
#include <hip/hip_runtime.h>
#include <cstdio>
#include <cstdint>

#ifndef N_LAUNCH_MODE
#define N_LAUNCH_MODE 0
#endif

#define LAS __attribute__((address_space(3)))
#define GAS __attribute__((address_space(1)))
typedef unsigned short bf16_t;
typedef short bf16x8 __attribute__((ext_vector_type(8)));
typedef float f32x4 __attribute__((ext_vector_type(4)));
typedef float f32x2 __attribute__((ext_vector_type(2)));
typedef unsigned u32x4 __attribute__((ext_vector_type(4)));
typedef unsigned u32x2 __attribute__((ext_vector_type(2)));

constexpr int D = 1024, BATCH = 4, SEQ = 8192, T = BATCH * SEQ, FF = 2816, FH = FF / 2, NE = 8, NH = 16, HS = 64;
constexpr int MIXIN = 2048, DCONV = 512, DPOOL = 512;
constexpr int ZLD = 1536;
constexpr float RMS_EPS = 1e-6f, LNX_EPS = 64e-5f;
constexpr int NWAVES = 8, NTHREADS = 512;
constexpr int MOE_MAXROWS = 2 * T + NE * 256;
constexpr int H2ROWS = BATCH * (SEQ + 1);

constexpr size_t MiB = 1u << 20;
constexpr size_t WS_CTL = 0, CTL_ZERO_BYTES = 256 * 1024;
constexpr size_t WS_MOD = 1 * MiB;
constexpr size_t WS_TOKE = 2 * MiB;
constexpr size_t WS_TOKW = WS_TOKE + (size_t)T * 8;
constexpr size_t WS_TOKLI = WS_TOKW + (size_t)T * 8;
constexpr size_t WS_TOKSLOT = WS_TOKLI + (size_t)T * 8;
constexpr size_t WS_CNT = WS_TOKSLOT + (size_t)T * 8;
constexpr size_t WS_ROWIDX = WS_CNT + 8192;
constexpr size_t WS_TILEE = WS_ROWIDX + (size_t)MOE_MAXROWS * 4;
static_assert(WS_TILEE + 4096 <= 4 * MiB, "route tables");
constexpr size_t WS_WIN = 4 * MiB, WS_WOUTE = 8 * MiB, WS_WFGU = 10 * MiB, WS_WFD = 21 * MiB, WS_WRKV = 26 * MiB + 512 * 1024, WS_WLOR = 32 * MiB + 512 * 1024, WS_WL2 = 504 * MiB, WS_WO = 493 * MiB;
constexpr size_t WS_WMGU = 4 * MiB, WS_WMD0 = 48 * MiB, WS_WMD1 = 70 * MiB;
constexpr size_t WS_H = 44 * MiB, WS_Z = 172 * MiB, WS_A2 = 300 * MiB, WS_HFF = 172 * MiB, WS_Y0 = 364 * MiB;
constexpr size_t WS_H2 = 44 * MiB, WS_XR = 109 * MiB, WS_XK = 173 * MiB, WS_XV = 237 * MiB, WS_R = 301 * MiB, WS_K = 365 * MiB, WS_V = 429 * MiB, WS_LACT = 4 * MiB, WS_WLOG = 109 * MiB, WS_AA = 173 * MiB, WS_GG = 237 * MiB, WS_Y1 = 173 * MiB;
constexpr size_t WS_XH = 495 * MiB;
constexpr int LACT_LD = 2048, LACT_W = 384;
constexpr size_t WS_BSC = 495 * MiB, WS_SEG = 497 * MiB;
constexpr size_t WS_H3 = 446 * MiB, WS_HM = 264 * MiB, WS_Y2 = 132 * MiB, WS_END = 510 * MiB;
static_assert(WS_H2 + (size_t)H2ROWS * D * 2 <= WS_XR, "h2");
static_assert(WS_HM + (size_t)MOE_MAXROWS * FH * 2 <= WS_H3, "hm");
static_assert(WS_Y2 + (size_t)MOE_MAXROWS * D * 2 <= WS_HM, "y2");
constexpr int CW_MOE_NM = 64;
constexpr int CW_BAR = 4096;

__device__ __forceinline__ unsigned f2bf(float f) { unsigned u = __builtin_bit_cast(unsigned, f); return (u + 0x7fffu + ((u >> 16) & 1u)) >> 16; }
typedef __bf16 bf16x2_hw __attribute__((ext_vector_type(2)));
typedef float f32x2_hw __attribute__((ext_vector_type(2)));
__device__ __forceinline__ unsigned pk2(float lo, float hi) { f32x2_hw v = {lo, hi}; return __builtin_bit_cast(unsigned, __builtin_convertvector(v, bf16x2_hw)); }
__device__ __forceinline__ float bflo(unsigned w) { return __builtin_bit_cast(float, w << 16); }
__device__ __forceinline__ float bfhi(unsigned w) { return __builtin_bit_cast(float, w & 0xffff0000u); }
__device__ __forceinline__ float bf1(bf16_t b) { return __builtin_bit_cast(float, (unsigned)b << 16); }
template <int CTRL> __device__ __forceinline__ float dppf(float v) { return __builtin_bit_cast(float, __builtin_amdgcn_update_dpp(0, __builtin_bit_cast(int, v), CTRL, 0xF, 0xF, true)); }
__device__ __forceinline__ float sum8_dpp(float v) { v += dppf<0xB1>(v); v += dppf<0x4E>(v); v += dppf<0x141>(v); return v; }
__device__ __forceinline__ float wave_sum(float v) { v = sum8_dpp(v); v += dppf<0x140>(v); v += __shfl_xor(v, 16); v += __shfl_xor(v, 32); return v; }
__device__ __forceinline__ float sigmoidf_(float x) { return __builtin_amdgcn_rcpf(1.0f + __expf(-x)); }
__device__ __forceinline__ float siluf_(float x) { return x * __builtin_amdgcn_rcpf(1.0f + __expf(-x)); }
__device__ __forceinline__ float tanhf_(float x) { const float e = __expf(-2.0f * fabsf(x)); const float t = (1.0f - e) * __builtin_amdgcn_rcpf(1.0f + e); return x < 0.f ? -t : t; }
__device__ __forceinline__ float softplusf_(float z) { return fmaxf(z, 0.f) + log1pf(__expf(-fabsf(z))); }

namespace pg8 {
constexpr int BM = 256, BK = 64, HALF = 128, HTB = HALF * BK * 2, STAGE_BYTES = 8 * HTB, NXCD = 8, WGM = 8;
__host__ __device__ __forceinline__ int lds_byte(int r, int c) { const int st = (r >> 4) * 2 + (c >> 5), rr = r & 15, cc = c & 31, ob = rr * 64 + cc * 2; return st * 1024 + (ob ^ (((ob >> 9) & 1) << 5)); }
__host__ __device__ __forceinline__ void stage_rc(int b, int& R, int& C) { const int st = b / 1024, sb = b % 1024, swz = sb ^ (((sb >> 9) & 1) << 5); R = (st >> 1) * 16 + swz / 64; C = (st & 1) * 32 + (swz % 64) / 2; }
__host__ __device__ __forceinline__ int perm32(int rho) { const int n = rho >> 4, i = rho & 15; return 8 * (i >> 2) + 4 * n + (i & 3); }

struct Unit { int pm, pn; };
enum { EM_BF16 = 0, EM_SWIGLU = 1, EM_RKVL = 2, EM_LORA2 = 3, EM_MOE2 = 4, EM_MIXIN = 5 };
struct GemmDesc {
    const bf16_t* A; const bf16_t* Bt;
    int lda, K, nM, nN;
    int a_bt, a_bx;
    int a_pn_split, a_pn_coloff;
    int a_pn_div; long a_pn_stride;
    int pn_bias;
    const int* rowidx;
    const int* tile_e; long b_estride;
    int mode;
    bf16_t* o0; bf16_t* o1; bf16_t* o2; int ldc;
    const float* p0;
    const float* p1;
    int flag;
};
__device__ __forceinline__ size_t a_off_bytes(const GemmDesc& g, const Unit& u) {
    size_t rows = (size_t)u.pm * BM; if (g.a_bt) rows += (size_t)(u.pm / g.a_bt) * g.a_bx;
    size_t o = rows * (size_t)g.lda; if (u.pn >= g.a_pn_split) o += g.a_pn_coloff; o += (size_t)(u.pn / g.a_pn_div) * (size_t)g.a_pn_stride; return o * 2;
}
__device__ __forceinline__ size_t b_off_bytes(const GemmDesc& g, const Unit& u) {
    size_t o = (size_t)u.pn * BM * (size_t)g.K; if (g.tile_e) o += (size_t)__builtin_amdgcn_readfirstlane(g.tile_e[u.pm]) * (size_t)g.b_estride; return o * 2;
}
struct StaticOrder {
    int nM, nN, nwg, G, c;
    __device__ void init(int nM_, int nN_, int G_, int c_) { nM = nM_; nN = nN_; nwg = nM * nN; G = G_; c = c_; }
    __device__ bool next(int i, Unit& u) const {
        const long L = (long)i * G + c; if (L >= nwg) return false;
        int wgid = (int)L; { const int q = nwg / NXCD, r = nwg % NXCD, xcd = wgid % NXCD, off = wgid / NXCD; wgid = (xcd < r ? xcd * (q + 1) : r * (q + 1) + (xcd - r) * q) + off; }
        const int nig = WGM * nN, gid = wgid / nig, fm = gid * WGM, gsz = (nM - fm) < WGM ? (nM - fm) : WGM;
        u.pm = fm + ((wgid % nig) % gsz); u.pn = (wgid % nig) / gsz; return true;
    }
};
typedef __bf16 bf16x2_t_ __attribute__((ext_vector_type(2)));
__device__ __forceinline__ unsigned cvt_pk_bf16(float lo, float hi) { f32x2 v = {lo, hi}; bf16x2_t_ b = __builtin_convertvector(v, bf16x2_t_); return __builtin_bit_cast(unsigned, b); }

__device__ __forceinline__ unsigned dpp_x8(unsigned x) { return (unsigned)__builtin_amdgcn_update_dpp(0, (int)x, 0x128, 0xF, 0xF, true); }
__device__ __forceinline__ float dpp_x8f(float x) { return __builtin_bit_cast(float, dpp_x8(__builtin_bit_cast(unsigned, x))); }
template <int ACT, int AI_LO, int AI_HI>
__device__ __forceinline__ void store_tiles(f32x4 (&acc)[2][2][4][2], bf16_t* bq, int ldc, int colw, int fr, int fq, const float* bias, int climit = 1 << 30) {
    const bool lo = fr < 8;
    const int chA = lo ? fq : 4 + fq, chB = lo ? 4 + fq : fq;
    bf16_t* pA = bq + (size_t)(fr & 7) * ldc + chA * 8;
    bf16_t* pB = bq + (size_t)(8 + (fr & 7)) * ldc + chB * 8;
    const bool okA = (ACT != 1) || (colw + chA * 8 < climit), okB = (ACT != 1) || (colw + chB * 8 < climit);
    f32x4 bb[2][2];
    int cls[2];
#pragma unroll
    for (int bj = 0; bj < 2; ++bj) {
        const int col = colw + bj * 32 + 8 * fq;
        bb[bj][0] = (f32x4){0.f, 0.f, 0.f, 0.f}; bb[bj][1] = bb[bj][0];
        if (ACT >= 2) { bb[bj][0] = *(const f32x4*)(bias + col); bb[bj][1] = *(const f32x4*)(bias + col + 4); }
        cls[bj] = (ACT == 1) ? (col < 64 ? 0 : (col < 128 ? 1 : (col < 288 ? 2 : 3))) : 0;
    }
#pragma unroll
    for (int ai = AI_LO; ai < AI_HI; ++ai)
#pragma unroll
        for (int m = 0; m < 4; ++m) {
            u32x4 w[2];
#pragma unroll
            for (int bj = 0; bj < 2; ++bj) {
                float v[8];
#pragma unroll
                for (int j = 0; j < 4; ++j) { v[j] = acc[ai][bj][m][0][j]; v[4 + j] = acc[ai][bj][m][1][j]; }
                acc[ai][bj][m][0] = (f32x4){0.f, 0.f, 0.f, 0.f}; acc[ai][bj][m][1] = (f32x4){0.f, 0.f, 0.f, 0.f};
#pragma unroll
                for (int j = 0; j < 8; ++j) {
                    const float b_ = (j < 4) ? bb[bj][0][j & 3] : bb[bj][1][j & 3];
                    if (ACT == 1) { const float x = v[j]; v[j] = (cls[bj] == 0) ? tanhf_(x) : (cls[bj] == 1 ? x : (cls[bj] == 2 ? sigmoidf_(x) : 0.f)); }
                    else if (ACT == 2) v[j] = -0.60653066f * sigmoidf_(b_ + v[j]);
                    else if (ACT == 3) v[j] = sigmoidf_(b_ + v[j]);
                }
                w[bj].x = cvt_pk_bf16(v[0], v[1]); w[bj].y = cvt_pk_bf16(v[2], v[3]); w[bj].z = cvt_pk_bf16(v[4], v[5]); w[bj].w = cvt_pk_bf16(v[6], v[7]);
            }
            u32x4 p1; p1.x = dpp_x8(w[1].x); p1.y = dpp_x8(w[1].y); p1.z = dpp_x8(w[1].z); p1.w = dpp_x8(w[1].w);
            u32x4 dA, dB;
            dA.x = lo ? w[0].x : p1.x; dA.y = lo ? w[0].y : p1.y; dA.z = lo ? w[0].z : p1.z; dA.w = lo ? w[0].w : p1.w;
            dB.x = lo ? p1.x : w[0].x; dB.y = lo ? p1.y : w[0].y; dB.z = lo ? p1.z : w[0].z; dB.w = lo ? p1.w : w[0].w;
            const size_t ro = (size_t)(ai * HALF + m * 16) * ldc;
            if (okA) *(u32x4*)(pA + ro) = dA;
            if (okB) *(u32x4*)(pB + ro) = dB;
        }
}
template <int AI_LO = 0, int AI_HI = 2>
__device__ __forceinline__ void epilogue(const GemmDesc& g, f32x4 (&acc)[2][2][4][2], const Unit& u, int wr, int wc, int fr, int fq) {
    const int row0 = u.pm * BM + wr * 64 + fr;
    const int cin = wc * 32 + 8 * fq;
    if (g.mode == EM_MIXIN && u.pn >= 2 && u.pn < 6) {
#pragma unroll
        for (int ai = AI_LO; ai < AI_HI; ++ai)
#pragma unroll
            for (int m = 0; m < 4; ++m) {
                bf16_t* rowp = g.o0 + (size_t)(row0 + ai * HALF + m * 16) * g.ldc + 512 + (u.pn - 2) * HALF + cin;
                const f32x4 g0 = acc[ai][0][m][0], g1 = acc[ai][0][m][1], u0 = acc[ai][1][m][0], u1 = acc[ai][1][m][1];
                acc[ai][0][m][0] = (f32x4){0.f, 0.f, 0.f, 0.f}; acc[ai][0][m][1] = (f32x4){0.f, 0.f, 0.f, 0.f}; acc[ai][1][m][0] = (f32x4){0.f, 0.f, 0.f, 0.f}; acc[ai][1][m][1] = (f32x4){0.f, 0.f, 0.f, 0.f};
                u32x4 w;
                w.x = cvt_pk_bf16(g0[0] * u0[0], g0[1] * u0[1]); w.y = cvt_pk_bf16(g0[2] * u0[2], g0[3] * u0[3]);
                w.z = cvt_pk_bf16(g1[0] * u1[0], g1[1] * u1[1]); w.w = cvt_pk_bf16(g1[2] * u1[2], g1[3] * u1[3]);
                *(u32x4*)rowp = w;
            }
        return;
    }
    if (g.mode == EM_SWIGLU) {
#pragma unroll
        for (int ai = AI_LO; ai < AI_HI; ++ai)
#pragma unroll
            for (int m = 0; m < 4; ++m) {
                bf16_t* rowp = g.o0 + (size_t)(row0 + ai * HALF + m * 16) * g.ldc + u.pn * HALF + cin;
                const f32x4 g0 = acc[ai][0][m][0], g1 = acc[ai][0][m][1], u0 = acc[ai][1][m][0], u1 = acc[ai][1][m][1];
                acc[ai][0][m][0] = (f32x4){0.f, 0.f, 0.f, 0.f}; acc[ai][0][m][1] = (f32x4){0.f, 0.f, 0.f, 0.f}; acc[ai][1][m][0] = (f32x4){0.f, 0.f, 0.f, 0.f}; acc[ai][1][m][1] = (f32x4){0.f, 0.f, 0.f, 0.f};
                u32x4 w;
                w.x = cvt_pk_bf16(siluf_(g0[0]) * u0[0], siluf_(g0[1]) * u0[1]); w.y = cvt_pk_bf16(siluf_(g0[2]) * u0[2], siluf_(g0[3]) * u0[3]);
                w.z = cvt_pk_bf16(siluf_(g1[0]) * u1[0], siluf_(g1[1]) * u1[1]); w.w = cvt_pk_bf16(siluf_(g1[2]) * u1[2], siluf_(g1[3]) * u1[3]);
                *(u32x4*)rowp = w;
            }
        return;
    }
    if (g.mode == EM_MOE2) {
        const bool lo = fr < 8;
        const int chA = lo ? fq : 4 + fq, chB = lo ? 4 + fq : fq;
        bf16_t* q = g.o0 + (size_t)(u.pm * BM + wr * 64) * g.ldc + u.pn * BM + wc * 64;
        bf16_t* pA = q + (size_t)(fr & 7) * g.ldc + chA * 8;
        bf16_t* pB = q + (size_t)(8 + (fr & 7)) * g.ldc + chB * 8;
        u32x4 oa_[2][4], ob_[2][4];
#pragma unroll
        for (int ai = AI_LO; ai < AI_HI; ++ai) {
        if (g.flag) {
#pragma unroll
            for (int m = 0; m < 4; ++m) { const size_t ro = (size_t)(ai * HALF + m * 16) * g.ldc; oa_[ai][m] = *(const u32x4*)(pA + ro); ob_[ai][m] = *(const u32x4*)(pB + ro); }
        }
        __builtin_amdgcn_sched_barrier(0);
#pragma unroll
            for (int m = 0; m < 4; ++m) {
                const size_t ro = (size_t)(ai * HALF + m * 16) * g.ldc;
                float dA[8], dB[8];
#pragma unroll
                for (int j = 0; j < 8; ++j) {
                    const float a0 = acc[ai][0][m][j >> 2][j & 3], a1 = acc[ai][1][m][j >> 2][j & 3];
                    const float p1 = dpp_x8f(a1);
                    dA[j] = lo ? a0 : p1; dB[j] = lo ? p1 : a0;
                }
                acc[ai][0][m][0] = (f32x4){0.f, 0.f, 0.f, 0.f}; acc[ai][0][m][1] = (f32x4){0.f, 0.f, 0.f, 0.f}; acc[ai][1][m][0] = (f32x4){0.f, 0.f, 0.f, 0.f}; acc[ai][1][m][1] = (f32x4){0.f, 0.f, 0.f, 0.f};
                if (g.flag) { const u32x4 oa = oa_[ai][m], ob = ob_[ai][m];
                    dA[0] += bflo(oa.x); dA[1] += bfhi(oa.x); dA[2] += bflo(oa.y); dA[3] += bfhi(oa.y); dA[4] += bflo(oa.z); dA[5] += bfhi(oa.z); dA[6] += bflo(oa.w); dA[7] += bfhi(oa.w);
                    dB[0] += bflo(ob.x); dB[1] += bfhi(ob.x); dB[2] += bflo(ob.y); dB[3] += bfhi(ob.y); dB[4] += bflo(ob.z); dB[5] += bfhi(ob.z); dB[6] += bflo(ob.w); dB[7] += bfhi(ob.w); }
                u32x4 wa, wb;
                wa.x = cvt_pk_bf16(dA[0], dA[1]); wa.y = cvt_pk_bf16(dA[2], dA[3]); wa.z = cvt_pk_bf16(dA[4], dA[5]); wa.w = cvt_pk_bf16(dA[6], dA[7]);
                wb.x = cvt_pk_bf16(dB[0], dB[1]); wb.y = cvt_pk_bf16(dB[2], dB[3]); wb.z = cvt_pk_bf16(dB[4], dB[5]); wb.w = cvt_pk_bf16(dB[6], dB[7]);
                *(u32x4*)(pA + ro) = wa; *(u32x4*)(pB + ro) = wb;
            }
        __builtin_amdgcn_sched_barrier(0);
        }
        return;
    }
    int act = 0; bf16_t* base = g.o0; int colt = u.pn * BM; int ldc = g.ldc;
    if (g.mode == EM_MIXIN) colt = (u.pn < 2) ? u.pn * BM : 1024 + (u.pn - 6) * BM;
    else if (g.mode == EM_RKVL) {
        const int pnb = u.pn + g.pn_bias;
        if (pnb < 12) { const int t = pnb >> 2; base = g.o0 + (size_t)t * T * D; colt = (pnb & 3) * BM; }
        else { base = g.o1; colt = (pnb - 12) * BM; ldc = LACT_LD; act = 1; }
    } else if (g.mode == EM_LORA2) {
        const int t = (u.pn + g.pn_bias) >> 2; base = (t == 0) ? g.o0 : (t == 1 ? g.o1 : g.o2); colt = (u.pn & 3) * BM; act = (t == 2) ? 0 : 2 + t;
    }
    const int colw = colt + wc * 64;
    bf16_t* bq = base + (size_t)(u.pm * BM + wr * 64) * ldc + colw;
    if (act == 0) store_tiles<0, AI_LO, AI_HI>(acc, bq, ldc, colw, fr, fq, nullptr);
    else if (act == 1) store_tiles<1, AI_LO, AI_HI>(acc, bq, ldc, colw, fr, fq, nullptr, LACT_W);
    else if (act == 2) store_tiles<2, AI_LO, AI_HI>(acc, bq, ldc, colw, fr, fq, g.p0);
    else store_tiles<3, AI_LO, AI_HI>(acc, bq, ldc, colw, fr, fq, g.p1);
}

template <bool GATHER>
__device__ __forceinline__ void unit_offs_f(const GemmDesc& g, const Unit& u, const int (&Rl)[2], const int (&Cl)[2], unsigned (&o)[2][2]) {
#pragma unroll
    for (int h = 0; h < 2; ++h)
#pragma unroll
        for (int i = 0; i < 2; ++i) {
            if constexpr (GATHER) o[h][i] = (unsigned)g.rowidx[u.pm * BM + h * HALF + Rl[i]] * (unsigned)(g.lda * 2) + (unsigned)(Cl[i] * 2);
            else o[h][i] = (unsigned)(Rl[i] * g.lda + Cl[i]) * 2u;
        }
}
template <bool GATHER>
__device__ __forceinline__ void gemm_phase(LAS unsigned char* lds, const GemmDesc& g, int G, int c, int tid) {
    const int wid = __builtin_amdgcn_readfirstlane(tid >> 6), lane = tid & 63, wr = wid >> 2, wc = wid & 3, fr = lane & 15, fq = lane >> 4;
    const int K = g.K, nt = K / BK, lda = g.lda;
    StaticOrder S; S.init(g.nM, g.nN, G, c);
    int Rl[2], Cl[2]; unsigned voffB[2];
    unsigned offc[2][2], offn[2][2];
#pragma unroll
    for (int i = 0; i < 2; ++i) { int R, C; stage_rc(tid * 16 + i * 8192, R, C); const int Rb = (R & ~31) + perm32(R & 31);
        Rl[i] = R; Cl[i] = C; voffB[i] = (unsigned)(Rb * K + C) * 2u; }
    const size_t kstep = (size_t)(BK * 2);
    const size_t hstepB = (size_t)HALF * K * 2;
    const size_t hstepA = GATHER ? (size_t)0 : (size_t)HALF * lda * 2;
    const unsigned ldsw = (unsigned)wid * 1024u;
    const int aoff = lds_byte(wr * 64 + fr, fq * 8), boff = lds_byte((wc & 1) * 64 + fr, fq * 8); const int bh = wc >> 1;
#define PG8_SA(b, h) (((b) * 2 + (h)) * HTB)
#define PG8_SB(b, h) ((4 + (b) * 2 + (h)) * HTB)
#define PG8_STAGE(bufoff, gbase, voff) do { _Pragma("unroll") for (int _i = 0; _i < 2; ++_i) \
        __builtin_amdgcn_global_load_lds((const unsigned*)((const char*)(gbase) + (voff)[_i]), (LAS unsigned*)(lds + (bufoff) + ldsw + _i * 8192), 16, 0, 0); } while (0)
#define PG8_LDA(dst, b, h) do { _Pragma("unroll") for (int m = 0; m < 4; ++m) _Pragma("unroll") for (int k = 0; k < 2; ++k) dst[m][k] = *(const LAS bf16x8*)(lds + PG8_SA(b, h) + aoff + m * 2048 + k * 1024); } while (0)
#define PG8_LDB(dst, b, h) do { _Pragma("unroll") for (int n = 0; n < 2; ++n) _Pragma("unroll") for (int k = 0; k < 2; ++k) dst[n][k] = *(const LAS bf16x8*)(lds + PG8_SB(b, bh) + boff + (h) * 4096 + n * 2048 + k * 1024); } while (0)
#define PG8_MMA(ai, bj, At, Bt) do { __builtin_amdgcn_s_setprio(1); _Pragma("unroll") for (int m = 0; m < 4; ++m) _Pragma("unroll") for (int n = 0; n < 2; ++n) _Pragma("unroll") for (int k = 0; k < 2; ++k) \
        acc[ai][bj][m][n] = __builtin_amdgcn_mfma_f32_16x16x32_bf16(Bt[n][k], At[m][k], acc[ai][bj][m][n], 0, 0, 0); __builtin_amdgcn_s_setprio(0); } while (0)
#define PG8_WAIT_V(n) asm volatile("s_waitcnt vmcnt(" #n ")" ::: "memory")
#define PG8_WAIT_L(n) asm volatile("s_waitcnt lgkmcnt(" #n ")" ::: "memory")
#define PG8_BAR __builtin_amdgcn_s_barrier()
#define PG8_SCHED __builtin_amdgcn_sched_barrier(0)
    Unit cur, nxt; int ui = 0;
    if (!S.next(0, cur)) return;
    f32x4 acc[2][2][4][2];
#pragma unroll
    for (int a = 0; a < 2; ++a)
#pragma unroll
        for (int b = 0; b < 2; ++b)
#pragma unroll
            for (int m = 0; m < 4; ++m)
#pragma unroll
                for (int n = 0; n < 2; ++n) acc[a][b][m][n] = (f32x4){0.f, 0.f, 0.f, 0.f};
    bf16x8 At[4][2], B0[2][2], B1[2][2];
    unit_offs_f<GATHER>(g, cur, Rl, Cl, offc);
#pragma unroll
    for (int h = 0; h < 2; ++h) { offn[h][0] = offc[h][0]; offn[h][1] = offc[h][1]; }
    const char* cA = (const char*)g.A + (GATHER ? (size_t)0 : a_off_bytes(g, cur)); const char* cB = (const char*)g.Bt + b_off_bytes(g, cur);
    PG8_STAGE(PG8_SB(0, 0), cB, voffB); PG8_STAGE(PG8_SB(0, 1), cB + hstepB, voffB); PG8_STAGE(PG8_SA(0, 0), cA, offc[0]); PG8_STAGE(PG8_SA(0, 1), cA + hstepA, offc[1]);
    if (wr == 1) PG8_BAR;
    PG8_WAIT_V(2); PG8_BAR;
    PG8_STAGE(PG8_SB(1, 0), cB + kstep, voffB); PG8_STAGE(PG8_SA(1, 0), cA + kstep, offc[0]); PG8_STAGE(PG8_SB(1, 1), cB + hstepB + kstep, voffB);
    PG8_WAIT_V(6); PG8_BAR;
    for (;;) {
        const bool has_next = S.next(ui + 1, nxt);
        const char* nA = has_next ? (const char*)g.A + (GATHER ? (size_t)0 : a_off_bytes(g, nxt)) : cA; const char* nB = cB;
        if (g.tile_e) {
            if (has_next && wid == 0) __builtin_amdgcn_global_load_lds((const unsigned*)(g.tile_e + nxt.pm), (LAS unsigned*)(lds + STAGE_BYTES + 1024), 4, 0, 0);
        } else if (has_next) nB = (const char*)g.Bt + (size_t)nxt.pn * BM * (size_t)g.K * 2;
        if constexpr (GATHER) {
            if (has_next && wid == 0) {
#pragma unroll
                for (int q = 0; q < 4; ++q) __builtin_amdgcn_global_load_lds((const unsigned*)(g.rowidx + nxt.pm * BM + q * 64 + lane), (LAS unsigned*)(lds + STAGE_BYTES + q * 256), 4, 0, 0);
            }
        }
        for (int t = 0; t < nt; t += 2) {
            const bool last = (t == nt - 2);
            if (last && has_next && g.tile_e) { const int e = __builtin_amdgcn_readfirstlane(*(const LAS int*)(lds + STAGE_BYTES + 1024));
                nB = (const char*)g.Bt + ((size_t)nxt.pn * BM * (size_t)g.K + (size_t)e * (size_t)g.b_estride) * 2; }
            const char* a1 = cA + (size_t)(t + 1) * kstep;
            const char* a2 = last ? nA : cA + (size_t)(t + 2) * kstep; const char* b2 = last ? nB : cB + (size_t)(t + 2) * kstep;
            const char* a3 = a2 + kstep; const char* b3 = b2 + kstep;
            unsigned o2[2][2];
            if constexpr (GATHER) {
                if (last && has_next) {
                    const LAS int* ridx = (const LAS int*)(lds + STAGE_BYTES);
#pragma unroll
                    for (int h = 0; h < 2; ++h)
#pragma unroll
                        for (int i = 0; i < 2; ++i) offn[h][i] = (unsigned)ridx[h * HALF + Rl[i]] * (unsigned)(g.lda * 2) + (unsigned)(Cl[i] * 2);
                }
#pragma unroll
                for (int h = 0; h < 2; ++h)
#pragma unroll
                    for (int i = 0; i < 2; ++i) o2[h][i] = last ? offn[h][i] : offc[h][i];
            } else {
#pragma unroll
                for (int h = 0; h < 2; ++h)
#pragma unroll
                    for (int i = 0; i < 2; ++i) o2[h][i] = offc[0][i];
            }
            PG8_LDB(B0, 0, 0); PG8_LDB(B1, 0, 1); PG8_SCHED; PG8_LDA(At, 0, 0); PG8_STAGE(PG8_SA(1, 1), a1 + hstepA, offc[1]);
            PG8_WAIT_V(8); PG8_WAIT_L(0); PG8_BAR; PG8_MMA(0, 0, At, B0); PG8_MMA(0, 1, At, B1); PG8_BAR; PG8_SCHED;
            PG8_LDA(At, 0, 1); PG8_STAGE(PG8_SB(0, 0), b2, voffB); PG8_STAGE(PG8_SB(0, 1), b2 + hstepB, voffB); PG8_STAGE(PG8_SA(0, 0), a2, o2[0]);
            PG8_WAIT_V(8); PG8_WAIT_L(0); PG8_BAR; PG8_MMA(1, 0, At, B0); PG8_MMA(1, 1, At, B1); PG8_BAR; PG8_SCHED;
            PG8_LDB(B0, 1, 0); PG8_LDB(B1, 1, 1); PG8_SCHED; PG8_LDA(At, 1, 0); PG8_STAGE(PG8_SA(0, 1), a2 + hstepA, o2[1]);
            PG8_WAIT_V(8); PG8_WAIT_L(0); PG8_BAR; PG8_MMA(0, 0, At, B0); PG8_MMA(0, 1, At, B1); PG8_BAR; PG8_SCHED;
            PG8_LDA(At, 1, 1); PG8_STAGE(PG8_SB(1, 0), b3, voffB); PG8_STAGE(PG8_SB(1, 1), b3 + hstepB, voffB); PG8_STAGE(PG8_SA(1, 0), a3, o2[0]);
            PG8_WAIT_V(8); PG8_WAIT_L(0); PG8_BAR; PG8_MMA(1, 0, At, B0); PG8_MMA(1, 1, At, B1); PG8_BAR; PG8_SCHED;
        }
        if (wr == 0) PG8_BAR;
        epilogue(g, acc, cur, wr, wc, fr, fq);
        if (!has_next) break;
        cur = nxt; cA = nA; cB = nB; ++ui;
        if constexpr (GATHER) {
#pragma unroll
            for (int h = 0; h < 2; ++h) { offc[h][0] = offn[h][0]; offc[h][1] = offn[h][1]; }
        }
        if (wr == 1) PG8_BAR;
    }
    PG8_WAIT_V(0);
    PG8_BAR;
#undef PG8_SA
#undef PG8_SB
#undef PG8_STAGE
#undef PG8_LDA
#undef PG8_LDB
#undef PG8_MMA
#undef PG8_WAIT_V
#undef PG8_WAIT_L
#undef PG8_BAR
#undef PG8_SCHED
}
}

#define XB_TMO      128
#define XB_XCNT(j)  (256  + 64 * (j))
#define XB_XSUB(j)  (1280 + 64 * (j))
#define XB_XGEN(j)  (2304 + 64 * (j))
#define XB_TOP      3328
#define XB_TOPGEN   3392
#define XCD_BAR_WORDS 3456
#define XB_SPIN_CAP (1u << 20)
__device__ __forceinline__ unsigned xb_ld(unsigned* p)              { return __hip_atomic_load(p, __ATOMIC_RELAXED, __HIP_MEMORY_SCOPE_AGENT); }
__device__ __forceinline__ unsigned xb_add(unsigned* p, unsigned v) { return __hip_atomic_fetch_add(p, v, __ATOMIC_RELAXED, __HIP_MEMORY_SCOPE_AGENT); }
__device__ __forceinline__ unsigned xb_xcc_id() { return (unsigned)__builtin_amdgcn_s_getreg((3 << 11) | 20) & 0xFu; }
#define XB_SPIN(cond, bar) do { unsigned _sp = 0; while (cond) { __builtin_amdgcn_s_sleep(1); \
    if ((++_sp & 255u) == 0u) { if (xb_ld(&(bar)[XB_TMO])) break; if (_sp > XB_SPIN_CAP) { atomicAdd(&(bar)[XB_TMO], 1u); break; } } } } while (0)
struct XcdBarrier { unsigned* bar; unsigned x; volatile LAS unsigned* st; };
__device__ __forceinline__ XcdBarrier xcd_barrier_post(unsigned* bar, volatile LAS unsigned* st) {
    XcdBarrier b; b.bar = bar; b.x = xb_xcc_id(); b.st = st;
    if (threadIdx.x == 0) (void)xb_add(&bar[XB_XCNT(b.x)], 1u);
    return b;
}
__device__ __forceinline__ void xcd_barrier_complete(unsigned* bar, unsigned x, unsigned& nloc, unsigned& nx) {
    const unsigned G = gridDim.x * gridDim.y * gridDim.z;
    unsigned sum, cnt, mine, sp = 0u;
    for (;;) {
        sum = 0u; cnt = 0u; mine = 0u;
#pragma unroll
        for (unsigned j = 0; j < 16; ++j) { const unsigned c = xb_ld(&bar[XB_XCNT(j)]); sum += c; cnt += (c > 0u) ? 1u : 0u; mine = (j == x) ? c : mine; }
        if (sum == G) break;
        __builtin_amdgcn_s_sleep(1);
        if ((++sp & 255u) == 0u) { if (xb_ld(&bar[XB_TMO])) break; if (sp > XB_SPIN_CAP) { atomicAdd(&bar[XB_TMO], 1u); break; } }
    }
    nloc = mine > 0u ? mine : 1u; nx = cnt > 0u ? cnt : 1u;
}
__device__ __forceinline__ void xcd_barrier(const XcdBarrier& b) {
    asm volatile("s_waitcnt vmcnt(0)" ::: "memory");
    __syncthreads();
    if (threadIdx.x == 0) {
        unsigned* bar = b.bar;
        __builtin_amdgcn_s_waitcnt(0);
        unsigned nloc = b.st[0], nx = b.st[1];
        if (nloc == 0u) { xcd_barrier_complete(bar, b.x, nloc, nx); b.st[0] = nloc; b.st[1] = nx; }
        const unsigned old = xb_add(&bar[XB_XSUB(b.x)], 1u);
        const unsigned gen = old / nloc;
        if (old + 1u == (gen + 1u) * nloc) {
            __builtin_amdgcn_fence(__ATOMIC_RELEASE, "agent");
            asm volatile("s_waitcnt vmcnt(0)" ::: "memory");
            const unsigned og = xb_add(&bar[XB_TOP], 1u);
            const unsigned tg = og / nx;
            if (og + 1u == (tg + 1u) * nx) xb_add(&bar[XB_TOPGEN], 1u);
            else XB_SPIN(xb_ld(&bar[XB_TOPGEN]) == tg, bar);
            __builtin_amdgcn_fence(__ATOMIC_ACQUIRE, "agent");
            asm volatile("s_waitcnt vmcnt(0)" ::: "memory");
        } else {
            XB_SPIN(xb_ld(&bar[XB_TOPGEN]) == gen, bar);
            __builtin_amdgcn_fence(__ATOMIC_ACQUIRE, "agent");
            asm volatile("s_waitcnt vmcnt(0)" ::: "memory");
        }
    }
    __syncthreads();
}

constexpr int RING_BYTES = 131072;
constexpr int LDS_BYTES = 163840;
constexpr int MISC_OFF = LDS_BYTES - 1024;

struct Args {
    const float* in[35]; float* out; unsigned char* ws; int ph_lo, ph_hi;
};
enum { I_X = 0, I_C, I_ADAW, I_ADAB, I_NORMG, I_MIXWIN, I_CONVW, I_POOLW, I_POOLS, I_MIXWOUT, I_FFG, I_FFU, I_FFD, I_MU, I_WR, I_WK, I_WV, I_WO, I_W0, I_W1, I_W2, I_A0, I_A1, I_A2, I_G1, I_G2,
       I_KK, I_KA, I_RK, I_LNG, I_LNB, I_ROUTER, I_MOEG, I_MOEU, I_MOED };

struct Frame {
    LAS unsigned char* lds;
    int tid, lane, wave, vcu, G;
    unsigned char* ws;
};

struct ConvJob {
    const float* src; int src_ld;
    int n0s;
    int nK, nN;
    int k_lo, k_hi;
    bf16_t* dst; int dst_ld; int dst_r0, dst_c0;
    const float* scale; int smode;
    int remap;
};
__device__ __forceinline__ int conv_items(const ConvJob& j) { return (j.nK / 64) * (j.nN / 32); }
__device__ __forceinline__ void conv_item(const ConvJob& j, LAS float* scr, int item, int lane) {
    const int nblk = j.nN / 32, kb = item / nblk, nb = item % nblk, k0 = 64 * kb, n0 = 32 * nb;
    f32x4 v[8];
#pragma unroll
    for (int i = 0; i < 8; ++i) { const int kk = 8 * i + (lane >> 3); const int k = k0 + kk; v[i] = (f32x4){0.f, 0.f, 0.f, 0.f};
        if (k >= j.k_lo && k < j.k_hi) { const int sr = k - j.k_lo; v[i] = *(const f32x4*)(j.src + (size_t)sr * j.src_ld + j.n0s + n0 + 4 * (lane & 7));
            if (j.smode == 1) v[i] = v[i] * j.scale[sr]; else if (j.smode == 2) v[i] = v[i] * (1.0f - j.scale[sr]); } }
#pragma unroll
    for (int i = 0; i < 8; ++i) { const int kk = 8 * i + (lane >> 3); LAS float* d = scr + kk * 33 + 4 * (lane & 7); d[0] = v[i][0]; d[1] = v[i][1]; d[2] = v[i][2]; d[3] = v[i][3]; }
    asm volatile("s_waitcnt lgkmcnt(0)" ::: "memory");
    const int c = lane & 7;
#pragma unroll
    for (int q = 0; q < 4; ++q) { const int n = (lane >> 3) + 8 * q; const LAS float* s = scr + (8 * c) * 33 + n;
        u32x4 o; o.x = pk2(s[0 * 33], s[1 * 33]); o.y = pk2(s[2 * 33], s[3 * 33]); o.z = pk2(s[4 * 33], s[5 * 33]); o.w = pk2(s[6 * 33], s[7 * 33]);
        const int nl = n0 + n; int drow = j.dst_r0 + nl; if (j.remap) drow = j.dst_r0 + 256 * (nl >> 7) + 64 * ((nl & 127) >> 5) + (j.remap == 2 ? 32 : 0) + (nl & 31);
        *(GAS u32x4*)(j.dst + (size_t)drow * j.dst_ld + j.dst_c0 + k0 + 8 * c) = o; }
    asm volatile("s_waitcnt lgkmcnt(0)" ::: "memory");
}
__device__ __forceinline__ ConvJob mkjob(const float* src, int src_ld, int n0s, int nK, int nN, int k_lo, int k_hi, bf16_t* dst, int dst_ld, int dst_r0, int dst_c0, const float* scale, int smode, int remap) {
    ConvJob j; j.src = src; j.src_ld = src_ld; j.n0s = n0s; j.nK = nK; j.nN = nN; j.k_lo = k_lo; j.k_hi = k_hi; j.dst = dst; j.dst_ld = dst_ld; j.dst_r0 = dst_r0; j.dst_c0 = dst_c0; j.scale = scale; j.smode = smode; j.remap = remap; return j;
}
#define RUN_JOB(J) do { const ConvJob _j = (J); const int _n = conv_items(_j); for (int _it = (gw + NGW - (itbase % NGW)) % NGW; _it < _n; _it += NGW) conv_item(_j, scr, _it, F.lane); itbase += _n; } while (0)

__device__ __forceinline__ void phase_prologue(Frame& F, const Args& A) {
    unsigned char* ws = F.ws;
    LAS float* scr = (LAS float*)(F.lds + F.wave * 16384);
    const int gw = F.vcu * NWAVES + F.wave, NGW = F.G * NWAVES;
    {
        float* mod = (float*)(ws + WS_MOD);
        LAS float* red = (LAS float*)(F.lds);
        LAS float* sc_ = (LAS float*)(F.lds + 8192);
        for (int i = F.tid; i < 4 * D; i += NTHREADS) sc_[i] = siluf_(A.in[I_C][i]);
        __syncthreads();
        for (int task = F.vcu; task < 2 * 96; task += F.G) {
            const int l = task / 96, nb = task % 96, n = nb * 64 + F.lane;
            const float* w = A.in[I_ADAW] + (size_t)l * D * 6144 + n;
            float acc0 = 0.f, acc1 = 0.f, acc2 = 0.f, acc3 = 0.f;
            const int kb = F.wave * 128;
#pragma unroll 32
            for (int k = kb; k < kb + 128; ++k) {
                const float wv = w[(size_t)k * 6144];
                acc0 += sc_[k] * wv; acc1 += sc_[D + k] * wv; acc2 += sc_[2 * D + k] * wv; acc3 += sc_[3 * D + k] * wv;
            }
            red[(F.wave * 4 + 0) * 64 + F.lane] = acc0; red[(F.wave * 4 + 1) * 64 + F.lane] = acc1; red[(F.wave * 4 + 2) * 64 + F.lane] = acc2; red[(F.wave * 4 + 3) * 64 + F.lane] = acc3;
            __syncthreads();
            if (F.wave < 4) { float s = 0.f; for (int w8 = 0; w8 < 8; ++w8) s += red[(w8 * 4 + F.wave) * 64 + F.lane];
                mod[((size_t)l * 4 + F.wave) * 6144 + n] = s + A.in[I_ADAB][l * 6144 + n]; }
            __syncthreads();
        }
    }
    int itbase = 0;
    bf16_t* Win = (bf16_t*)(ws + WS_WIN); bf16_t* Woute = (bf16_t*)(ws + WS_WOUTE); bf16_t* Wfgu = (bf16_t*)(ws + WS_WFGU); bf16_t* Wfd = (bf16_t*)(ws + WS_WFD);
    bf16_t* Wrkv = (bf16_t*)(ws + WS_WRKV); bf16_t* Wlor = (bf16_t*)(ws + WS_WLOR); bf16_t* Wl2 = (bf16_t*)(ws + WS_WL2); bf16_t* Wo = (bf16_t*)(ws + WS_WO);
    RUN_JOB(mkjob(A.in[I_MIXWIN], MIXIN, 0, D, 512, 0, D, Win, D, 0, 0, nullptr, 0, 0));
    RUN_JOB(mkjob(A.in[I_MIXWIN], MIXIN, 512, D, 512, 0, D, Win, D, 512, 0, nullptr, 0, 1));
    RUN_JOB(mkjob(A.in[I_MIXWIN], MIXIN, 1024, D, 512, 0, D, Win, D, 512, 0, nullptr, 0, 2));
    RUN_JOB(mkjob(A.in[I_MIXWIN], MIXIN, 1536, D, 512, 0, D, Win, D, 1536, 0, nullptr, 0, 0));
    RUN_JOB(mkjob(A.in[I_MIXWOUT], D, 0, 512, D, 0, 512, Woute, D, 0, 0, nullptr, 0, 0));
    RUN_JOB(mkjob(A.in[I_FFG], FF, 0, D, FF, 0, D, Wfgu, D, 0, 0, nullptr, 0, 1));
    RUN_JOB(mkjob(A.in[I_FFU], FF, 0, D, FF, 0, D, Wfgu, D, 0, 0, nullptr, 0, 2));
    RUN_JOB(mkjob(A.in[I_FFD], D, 0, FF, D, 0, FF, Wfd, FF, 0, 0, nullptr, 0, 0));
    const float* mu = A.in[I_MU];
    RUN_JOB(mkjob(A.in[I_WR], D, 0, D, D, 0, D, Wrkv, D, 0, 0, nullptr, 0, 0));
    RUN_JOB(mkjob(A.in[I_WK], D, 0, D, D, 0, D, Wrkv, D, D, 0, nullptr, 0, 0));
    RUN_JOB(mkjob(A.in[I_WV], D, 0, D, D, 0, D, Wrkv, D, 2 * D, 0, nullptr, 0, 0));
    RUN_JOB(mkjob(A.in[I_W1], 64, 0, D, 64, 0, D, Wlor, 2 * D, 0, 0, mu + 1 * D, 1, 0));
    RUN_JOB(mkjob(A.in[I_W1], 64, 0, D, 64, 0, D, Wlor, 2 * D, 0, D, mu + 1 * D, 2, 0));
    RUN_JOB(mkjob(A.in[I_A1], 64, 0, D, 64, 0, D, Wlor, 2 * D, 64, 0, mu + 4 * D, 1, 0));
    RUN_JOB(mkjob(A.in[I_A1], 64, 0, D, 64, 0, D, Wlor, 2 * D, 64, D, mu + 4 * D, 2, 0));
    RUN_JOB(mkjob(A.in[I_G1], 160, 0, D, 160, 0, D, Wlor, 2 * D, 128, 0, mu + 5 * D, 1, 0));
    RUN_JOB(mkjob(A.in[I_G1], 160, 0, D, 160, 0, D, Wlor, 2 * D, 128, D, mu + 5 * D, 2, 0));
    RUN_JOB(mkjob(A.in[I_W2], D, 0, 256, D, 0, 64, Wl2, 256, 0, 0, nullptr, 0, 0));
    RUN_JOB(mkjob(A.in[I_A2], D, 0, 256, D, 64, 128, Wl2, 256, D, 0, nullptr, 0, 0));
    RUN_JOB(mkjob(A.in[I_G2], D, 0, 256, D, 0, 160, Wl2, 256, 2 * D, 0, nullptr, 0, 0));
    RUN_JOB(mkjob(A.in[I_WO], D, 0, D, D, 0, D, Wo, D, 0, 0, nullptr, 0, 0));
    { u32x4* z = (u32x4*)(Wlor + (size_t)288 * 2 * D); const int n16 = 224 * 2 * D * 2 / 16;
      for (int i = gw * 64 + F.lane; i < n16; i += NGW * 64) z[i] = (u32x4){0u, 0u, 0u, 0u}; }
    {
        const float* pw = A.in[I_POOLW]; const float* ps = A.in[I_POOLS]; const float* wo = A.in[I_MIXWOUT];
        for (int item = gw; item < 512 * 4; item += NGW) {
            const int kk = item >> 2, db = item & 3, g = kk >> 7, c = kk & 127, d = db * 256 + 4 * F.lane;
            f32x4 s = (f32x4){0.f, 0.f, 0.f, 0.f};
#pragma unroll 32
            for (int c2 = 0; c2 < 128; ++c2) s = s + (pw[((size_t)g * 128 + c) * 128 + c2] * ps[g * 128 + c2]) * *(const f32x4*)(wo + (size_t)(512 + g * 128 + c2) * D + d);
#pragma unroll
            for (int q = 0; q < 4; ++q) Woute[(size_t)(d + q) * D + 512 + kk] = (bf16_t)f2bf(s[q]);
        }
    }
}

__device__ __forceinline__ void moe_convert(Frame& F, const Args& A, int part, int half, bf16_t* dst, int pidx, int np) {
    LAS float* scr = (LAS float*)(F.lds + F.wave * 16384);
    const int gw = pidx * NWAVES + F.wave, NGW = np * NWAVES;
    int itbase = 0;
    for (int e = 0; e < NE; ++e) {
        if (part == 0) {
            RUN_JOB(mkjob(A.in[I_MOEG] + (size_t)e * D * FF, FF, half * FH, D, FH, 0, D, dst, D, e * FF, 0, nullptr, 0, 1));
            RUN_JOB(mkjob(A.in[I_MOEU] + (size_t)e * D * FF, FF, half * FH, D, FH, 0, D, dst, D, e * FF, 0, nullptr, 0, 2));
        } else {
            RUN_JOB(mkjob(A.in[I_MOED] + (size_t)e * FF * D + (size_t)half * FH * D, D, 0, FH, D, 0, FH, dst, FH, e * D, 0, nullptr, 0, 0));
        }
    }
}

constexpr int MCV_ITEMS = 32 * 2816;
struct McvDst { bf16_t* p; };
__device__ __forceinline__ McvDst mcv_load(const Args& A, unsigned char* ws, int id, int lane, float (&v)[8]) {
    const int t = id / 2816, r = id % 2816;
    const float* src; int ld; bf16_t* dst;
    if (t < 16) { const int e = t >> 1, up = t & 1, kb = r / 22, nb = r % 22, nl = nb * 64 + lane;
        src = A.in[up ? I_MOEU : I_MOEG] + (size_t)e * D * FF + (size_t)(kb * 8) * FF + nl; ld = FF;
        dst = (bf16_t*)(ws + WS_WMGU) + (size_t)(e * FF + 256 * (nl >> 7) + 64 * ((nl & 127) >> 5) + (up ? 32 : 0) + (nl & 31)) * D + kb * 8;
    } else { const int half = (t - 16) >> 3, e = (t - 16) & 7, kb = r / 16, nb = r % 16, n = nb * 64 + lane;
        src = A.in[I_MOED] + (size_t)e * FF * D + (size_t)(half * FH + kb * 8) * D + n; ld = D;
        dst = (bf16_t*)(ws + (half ? WS_WMD1 : WS_WMD0)) + (size_t)(e * D + n) * FH + kb * 8; }
#pragma unroll
    for (int i = 0; i < 8; ++i) v[i] = __builtin_nontemporal_load(src + (size_t)i * ld);
    McvDst d; d.p = dst; return d;
}
__device__ __forceinline__ void mcv_store(const McvDst& d, const float (&v)[8]) {
    *(u32x4*)(d.p) = (u32x4){pk2(v[0], v[1]), pk2(v[2], v[3]), pk2(v[4], v[5]), pk2(v[6], v[7])};
}

struct RowP {
    const float* xin; float* xout;
    const bf16_t* y;
    const float* gate; const float* gpost;
    const float* gpre; const float* sc; const float* sh;
    bf16_t* hout; int hpad;
    float* xh;
    int xin_b, xout_b;
};
struct RowIn { f32x4 xf[4]; u32x2 xb[4]; u32x2 yw[4]; };
__device__ __forceinline__ void row_load(const RowP& P, int t, int lane, RowIn& in, const float* xrow = nullptr) {
    if (P.xin_b && !xrow) {
        const GAS u32x2* xr = (const GAS u32x2*)((const bf16_t*)P.xin + (size_t)t * 2048 + 1024) + lane;
#pragma unroll
        for (int j = 0; j < 4; ++j) in.xb[j] = xr[64 * j];
    } else {
        const GAS f32x4* xr = (const GAS f32x4*)(xrow ? xrow : P.xin + (size_t)t * D) + lane;
#pragma unroll
        for (int j = 0; j < 4; ++j) in.xf[j] = xr[64 * j];
    }
    if (P.y) {
        const GAS u32x2* yr = (const GAS u32x2*)(P.y + (size_t)t * D) + lane;
#pragma unroll
        for (int j = 0; j < 4; ++j) in.yw[j] = yr[64 * j];
    }
}
__device__ __forceinline__ void row_compute(const RowP& P, int t, int lane, const RowIn& in, f32x4 (&hv)[4], bool want_h, bool halo = false) {
    const int b = t / SEQ;
    f32x4 x[4];
    if (P.xin_b && !halo) {
#pragma unroll
        for (int j = 0; j < 4; ++j) { const u32x2 w = in.xb[j]; x[j] = (f32x4){bflo(w.x), bfhi(w.x), bflo(w.y), bfhi(w.y)}; }
    } else {
#pragma unroll
        for (int j = 0; j < 4; ++j) x[j] = in.xf[j];
    }
    if (P.y) {
        f32x4 yv[4]; float ss = 0.f;
#pragma unroll
        for (int j = 0; j < 4; ++j) { const u32x2 w = in.yw[j]; yv[j] = (f32x4){bflo(w.x), bfhi(w.x), bflo(w.y), bfhi(w.y)}; ss += (yv[j].x * yv[j].x + yv[j].y * yv[j].y) + (yv[j].z * yv[j].z + yv[j].w * yv[j].w); }
        const float rs = rsqrtf(wave_sum(ss) * (1.0f / D) + RMS_EPS);
#pragma unroll
        for (int j = 0; j < 4; ++j) { const f32x4 gt = *((const f32x4*)(P.gate + (size_t)b * 6144) + lane + 64 * j); const f32x4 gp = *((const f32x4*)P.gpost + lane + 64 * j);
            x[j] = x[j] + gt * gp * yv[j] * rs; }
    }
    if (P.xout_b) {
        u32x2 w[4];
#pragma unroll
        for (int j = 0; j < 4; ++j) { w[j] = (u32x2){pk2(x[j].x, x[j].y), pk2(x[j].z, x[j].w)}; x[j] = (f32x4){bflo(w[j].x), bfhi(w[j].x), bflo(w[j].y), bfhi(w[j].y)}; }
        if (!halo) { GAS u32x2* xo = (GAS u32x2*)((bf16_t*)P.xout + (size_t)t * 2048 + 1024) + lane;
#pragma unroll
            for (int j = 0; j < 4; ++j) xo[64 * j] = w[j]; }
    } else if (P.xout && !halo) { GAS f32x4* xo = (GAS f32x4*)(P.xout + (size_t)t * D) + lane;
#pragma unroll
        for (int j = 0; j < 4; ++j) xo[64 * j] = x[j]; }
    if (P.xh && (t & 15) == 15) { GAS f32x4* xo = (GAS f32x4*)(P.xh + (size_t)(t >> 4) * D) + lane;
#pragma unroll
        for (int j = 0; j < 4; ++j) xo[64 * j] = x[j]; }
    if (want_h) {
        float ss = 0.f;
#pragma unroll
        for (int j = 0; j < 4; ++j) ss += (x[j].x * x[j].x + x[j].y * x[j].y) + (x[j].z * x[j].z + x[j].w * x[j].w);
        const float rs = rsqrtf(wave_sum(ss) * (1.0f / D) + RMS_EPS);
#pragma unroll
        for (int j = 0; j < 4; ++j) { const f32x4 gp = *((const f32x4*)P.gpre + lane + 64 * j); const f32x4 sc = *((const f32x4*)(P.sc + (size_t)b * 6144) + lane + 64 * j); const f32x4 sh = *((const f32x4*)(P.sh + (size_t)b * 6144) + lane + 64 * j);
            hv[j] = x[j] * rs * gp * (1.0f + sc) + sh; }
        if (P.hout && !halo) { const size_t hr = P.hpad ? (size_t)b * (SEQ + 1) + (size_t)(t - b * SEQ) + 1 : (size_t)t;
            GAS u32x2* ho = (GAS u32x2*)(P.hout + hr * D) + lane;
#pragma unroll
            for (int j = 0; j < 4; ++j) ho[64 * j] = (u32x2){pk2(hv[j].x, hv[j].y), pk2(hv[j].z, hv[j].w)}; }
    }
}
__device__ __forceinline__ void phase_rows(Frame& F, const RowP& P) {
    const int gw = F.vcu * NWAVES + F.wave, NGW = F.G * NWAVES;
    f32x4 hv[4];
    RowIn cur, nxt;
    int t = gw; if (t < T) row_load(P, t, F.lane, cur);
    for (; t < T; t += NGW) { if (t + NGW < T) row_load(P, t + NGW, F.lane, nxt); row_compute(P, t, F.lane, cur, hv, P.gpre != nullptr); cur = nxt; }
}

__device__ __forceinline__ void phase_post2(Frame& F, const Args& A, const RowP& P) {
    const int g = F.vcu * NWAVES + F.wave, lane = F.lane;
    const float* mu = A.in[I_MU];
    f32x4 mur[4], muk[4], muv[4];
#pragma unroll
    for (int j = 0; j < 4; ++j) { mur[j] = *((const f32x4*)(mu + 0 * D) + lane + 64 * j); muk[j] = *((const f32x4*)(mu + 2 * D) + lane + 64 * j); muv[j] = *((const f32x4*)(mu + 3 * D) + lane + 64 * j); }
    bf16_t* XR = (bf16_t*)(F.ws + WS_XR); bf16_t* XK = (bf16_t*)(F.ws + WS_XK); bf16_t* XV = (bf16_t*)(F.ws + WS_XV);
    const int t0 = 16 * g;
    f32x4 hp[4];
    if (t0 % SEQ == 0) {
#pragma unroll
        for (int j = 0; j < 4; ++j) hp[j] = (f32x4){0.f, 0.f, 0.f, 0.f};
    } else { RowIn hin; row_load(P, t0 - 1, lane, hin, (const float*)(F.ws + WS_XH) + (size_t)(g - 1) * D); row_compute(P, t0 - 1, lane, hin, hp, true, true); }
    RowIn cur, nxt; row_load(P, t0, lane, cur);
#pragma unroll 1
    for (int t = t0; t < t0 + 16; ++t) {
        if (t + 1 < t0 + 16) row_load(P, t + 1, lane, nxt);
        f32x4 hv[4]; row_compute(P, t, lane, cur, hv, true); cur = nxt;
        GAS u32x2* pr = (GAS u32x2*)(XR + (size_t)t * D) + lane; GAS u32x2* pk = (GAS u32x2*)(XK + (size_t)t * D) + lane; GAS u32x2* pv = (GAS u32x2*)(XV + (size_t)t * D) + lane;
#pragma unroll
        for (int j = 0; j < 4; ++j) { const f32x4 d = hp[j] - hv[j];
            const f32x4 a = hv[j] + d * mur[j], b = hv[j] + d * muk[j], c = hv[j] + d * muv[j];
            pr[64 * j] = (u32x2){pk2(a.x, a.y), pk2(a.z, a.w)}; pk[64 * j] = (u32x2){pk2(b.x, b.y), pk2(b.z, b.w)}; pv[64 * j] = (u32x2){pk2(c.x, c.y), pk2(c.z, c.w)};
            hp[j] = hv[j]; }
    }
}

__device__ __forceinline__ void phase_mix(Frame& F, const Args& A) {
    const bf16_t* __restrict__ Z = (const bf16_t*)(F.ws + WS_Z); bf16_t* __restrict__ A2 = (bf16_t*)(F.ws + WS_A2);
    constexpr int TB = 32;
    const int tid = F.tid;
    for (int blk = F.vcu; blk < T / TB; blk += F.G) {
        const int t0 = blk * TB, b = t0 / SEQ, tb0 = t0 - b * SEQ;
        if (tid < 256) {
            const int c = 2 * tid;
            const float w00 = A.in[I_CONVW][c], w01 = A.in[I_CONVW][c + 1], w10 = A.in[I_CONVW][512 + c], w11 = A.in[I_CONVW][512 + c + 1], w20 = A.in[I_CONVW][1024 + c], w21 = A.in[I_CONVW][1024 + c + 1];
            float um2_0 = 0.f, um2_1 = 0.f, um1_0 = 0.f, um1_1 = 0.f;
            for (int s = -2; s < 0; ++s) if (tb0 + s >= 0) { const bf16_t* zr = Z + (size_t)(t0 + s) * ZLD;
                const unsigned uw = *(const unsigned*)(zr + 512 + c);
                const float u0 = bflo(uw), u1 = bfhi(uw);
                if (s == -2) { um2_0 = u0; um2_1 = u1; } else { um1_0 = u0; um1_1 = u1; } }
            unsigned bgv[2][8], uvv[2][8];
#pragma unroll
            for (int q = 0; q < 8; ++q) { const bf16_t* zr = Z + (size_t)(t0 + q) * ZLD; bgv[0][q] = *(const unsigned*)(zr + c); uvv[0][q] = *(const unsigned*)(zr + 512 + c); }
#pragma unroll
            for (int grp = 0; grp < TB / 8; ++grp) {
                const int cu = grp & 1, nx = cu ^ 1;
                if (grp + 1 < TB / 8) {
#pragma unroll
                    for (int q = 0; q < 8; ++q) { const bf16_t* zr = Z + (size_t)(t0 + 8 * (grp + 1) + q) * ZLD; bgv[nx][q] = *(const unsigned*)(zr + c); uvv[nx][q] = *(const unsigned*)(zr + 512 + c); }
                }
                __builtin_amdgcn_sched_barrier(0);
#pragma unroll
                for (int q = 0; q < 8; ++q) { const int s = 8 * grp + q; const unsigned bg = bgv[cu][q], uw = uvv[cu][q];
                    const float u0 = bflo(uw), u1 = bfhi(uw);
                    const float y0 = bflo(bg) * (w00 * um2_0 + w10 * um1_0 + w20 * u0), y1 = bfhi(bg) * (w01 * um2_1 + w11 * um1_1 + w21 * u1);
                    *(unsigned*)(A2 + (size_t)(t0 + s) * D + c) = pk2(y0, y1);
                    um2_0 = um1_0; um2_1 = um1_1; um1_0 = u0; um1_1 = u1; }
                __builtin_amdgcn_sched_barrier(0);
            }
        } else {
            const int c = 2 * (tid - 256), win = 2 << (c >> 7);
            float s0 = 0.f, s1 = 0.f;
            for (int s = -win + 1; s < 0; ++s) if (tb0 + s >= 0) { const unsigned v = *(const unsigned*)(Z + (size_t)(t0 + s) * ZLD + 1024 + c); s0 += bflo(v); s1 += bfhi(v); }
            unsigned vv[2][8], ov[2][8];
#pragma unroll
            for (int q = 0; q < 8; ++q) { vv[0][q] = *(const unsigned*)(Z + (size_t)(t0 + q) * ZLD + 1024 + c);
                ov[0][q] = (tb0 + q - win + 1 >= 0) ? *(const unsigned*)(Z + (size_t)(t0 + q - win + 1) * ZLD + 1024 + c) : 0u; }
#pragma unroll
            for (int grp = 0; grp < TB / 8; ++grp) {
                const int cu = grp & 1, nx = cu ^ 1;
                if (grp + 1 < TB / 8) {
#pragma unroll
                    for (int q = 0; q < 8; ++q) { const int s = 8 * (grp + 1) + q; vv[nx][q] = *(const unsigned*)(Z + (size_t)(t0 + s) * ZLD + 1024 + c);
                        ov[nx][q] = (tb0 + s - win + 1 >= 0) ? *(const unsigned*)(Z + (size_t)(t0 + s - win + 1) * ZLD + 1024 + c) : 0u; }
                }
                __builtin_amdgcn_sched_barrier(0);
#pragma unroll
                for (int q = 0; q < 8; ++q) { const int s = 8 * grp + q;
                    const unsigned v = vv[cu][q]; const float v0 = bflo(v), v1 = bfhi(v);
                    s0 += v0; s1 += v1;
                    const int pos = tb0 + s; const float icnt = __builtin_amdgcn_rcpf((float)((pos + 1 < win) ? pos + 1 : win));
                    *(unsigned*)(A2 + (size_t)(t0 + s) * D + 512 + c) = pk2(s0 * icnt - v0, s1 * icnt - v1);
                    const unsigned o = ov[cu][q]; s0 -= bflo(o); s1 -= bfhi(o);
                }
                __builtin_amdgcn_sched_barrier(0);
            }
        }
    }
}

namespace sm {
typedef LAS unsigned char* lp;
constexpr int TL = 8192;
constexpr int O_RAW = 0;
constexpr int O_LC = 40960;
constexpr int LCS = 68;
constexpr int O_TM = O_LC + 64 * LCS * 4;
constexpr int O_CM = O_TM + 4 * TL;
constexpr int O_X = O_CM + 4 * TL;
constexpr int O_S = O_X + 2 * TL;
constexpr int O_TB = O_S + 2 * TL;
constexpr int O_F = O_TB + 2048;
constexpr int O_END = O_F + (3 * 64 + 8 * 64 + 5 * 64) * 4;
static_assert(O_END <= MISC_OFF, "scan LDS map");
__device__ __forceinline__ int toff(int r, int c16) { return r * 128 + ((c16 ^ (r & 7)) << 4); }
typedef __bf16 bf16x2_t __attribute__((ext_vector_type(2)));
__device__ __forceinline__ unsigned cvtpk_s(float lo, float hi) { f32x2 v = {lo, hi}; bf16x2_t b = __builtin_convertvector(v, bf16x2_t); return __builtin_bit_cast(unsigned, b); }
__device__ __forceinline__ bf16x8 ldfrag(lp tile, int row, int c16) { return *(const LAS bf16x8*)(tile + toff(row, c16)); }
__device__ __forceinline__ f32x4 mm64(f32x4 acc, lp At, int m0, lp Bt, int n0, int lane) {
    const int r = lane & 15, q = lane >> 4;
#pragma unroll
    for (int ks = 0; ks < 2; ++ks) { const bf16x8 a = ldfrag(At, m0 + r, 4 * ks + q), b = ldfrag(Bt, n0 + r, 4 * ks + q); acc = __builtin_amdgcn_mfma_f32_16x16x32_bf16(a, b, acc, 0, 0, 0); }
    return acc;
}
__device__ __forceinline__ void st_nat(lp tile, int m0, int n0, f32x4 v, int lane) {
    const int n = n0 + (lane & 15), m = m0 + 4 * (lane >> 4);
    u32x2 w; w.x = cvtpk_s(v[0], v[1]); w.y = cvtpk_s(v[2], v[3]);
    *(LAS u32x2*)(tile + toff(n, m >> 3) + (m & 7) * 2) = w;
}
__device__ __forceinline__ f32x4 ld_nat(lp tile, int m0, int n0, int lane) {
    const int n = n0 + (lane & 15), m = m0 + 4 * (lane >> 4);
    const u32x2 w = *(const LAS u32x2*)(tile + toff(n, m >> 3) + (m & 7) * 2);
    return (f32x4){bflo(w.x), bfhi(w.x), bflo(w.y), bfhi(w.y)};
}
__device__ __forceinline__ float red8(float v) { return sum8_dpp(v); }
}

#define LBAR() asm volatile("s_waitcnt lgkmcnt(0)\n\ts_barrier" ::: "memory")
namespace sm {
constexpr int A_RAW = 0;
constexpr int A_LC = 4 * TL;
constexpr int A_TM = A_LC + 64 * LCS * 4;
constexpr int A_CM = A_TM + 4 * TL;
constexpr int A_X = A_CM + 4 * TL;
constexpr int A_S = A_X + 2 * TL;
constexpr int A_TB = A_S + 2 * TL;
constexpr int A_F = A_TB + 2048;
static_assert(A_F + 4096 <= MISC_OFF, "scan pass A LDS map");
constexpr int SEQQ = SEQ / 4, NCHQ = SEQQ / 64;
}
__device__ __forceinline__ void phase_scanA(Frame& F, const Args& A) {
    using namespace sm;
    const int unit = F.vcu, bh = unit >> 2, qq = unit & 3, b = bh / NH, h = bh % NH;
    const int tid = F.tid, lane = F.lane, w = F.wave;
    const int tA = tid >> 3, jsA = tid & 7;
    const int jB = tid & 63, qB = tid >> 6;
    lp L = F.lds;
    lp RAWk = L + A_RAW, RAWv = RAWk + TL, RAWw = RAWv + TL, RAWa = RAWw + TL;
    lp MabT = L + A_RAW, MkaT = MabT + TL, NbrT = MkaT + TL, NkrT = NbrT + TL; lp TG = MabT, TS = MkaT;
    LAS float* LC = (LAS float*)(L + A_LC); lp YT = L + A_LC, ZC = YT + TL;
    lp AtM = L + A_TM, RtM = AtM + TL, BtM = RtM + TL, KtM = BtM + TL; lp ZT = AtM, GcT = BtM;
    lp AtT = L + A_CM, BtT = AtT + TL, KtT = BtT + TL, VT = KtT + TL;
    lp XP = L + A_X, XQ = XP + TL;
    lp SG = L + A_S, SL = SG + TL;
    lp TB = L + A_TB;
    LAS float* FS = (LAS float*)(L + A_F); LAS float* DCv = FS; LAS float* INV = FS + 64; LAS float* BSC = FS + 128; LAS float* TOT = FS + 192; LAS float* PRM = FS + 192 + 512;
    if (tid < 64) { const int ch = h * HS + tid; PRM[tid] = A.in[I_KK][ch]; PRM[64 + tid] = A.in[I_KA][ch]; PRM[128 + tid] = A.in[I_RK][ch]; PRM[192 + tid] = A.in[I_W0][ch]; PRM[256 + tid] = A.in[I_A0][ch]; }
    { *(LAS u32x4*)(SG + tid * 16) = (u32x4){0u, 0u, 0u, 0u}; *(LAS u32x4*)(SL + tid * 16) = (u32x4){0u, 0u, 0u, 0u}; }
    LBAR();
    if (tid < 64) *(LAS bf16_t*)(SG + toff(tid, tid >> 3) + (tid & 7) * 2) = (bf16_t)0x3F80;
    const bf16_t* gR = (const bf16_t*)(F.ws + WS_R); const bf16_t* gK = (const bf16_t*)(F.ws + WS_K); const bf16_t* gV = (const bf16_t*)(F.ws + WS_V);
    const bf16_t* gL = (const bf16_t*)A.out;
    bf16_t* gYL = (bf16_t*)(F.ws + WS_R); bf16_t* gZC = (bf16_t*)(F.ws + WS_K); float* gBS = (float*)(F.ws + WS_BSC);
    const size_t trow0 = (size_t)b * SEQ + (size_t)qq * SEQQ;
    const size_t rowbase = (trow0 + tA) * D + h * HS + jsA * 8;
    const size_t lbase = (trow0 + tA) * LACT_LD + jsA * 8;
    u32x4 nr = *(const u32x4*)(gR + rowbase), nk = *(const u32x4*)(gK + rowbase), nv = *(const u32x4*)(gV + rowbase), nw = *(const u32x4*)(gL + lbase), na = *(const u32x4*)(gL + lbase + 64);
    const float kkwB = A.in[I_KK][h * HS + jB], kawB = A.in[I_KA][h * HS + jB];
    { const int o = toff(tA, jsA); *(LAS u32x4*)(AtM + o) = nw; *(LAS u32x4*)(RtM + o) = na; }
    const int l2kind = w >> 2, l2jb = w & 3;
    bf16x8 l2frag[2];
    { const bf16_t* l2W = (const bf16_t*)(F.ws + WS_WL2) + (size_t)((l2kind ? D : 0) + h * HS + 16 * l2jb + (lane & 15)) * 256 + (l2kind ? 64 : 0) + 8 * (lane >> 4);
      l2frag[0] = *(const bf16x8*)(l2W); l2frag[1] = *(const bf16x8*)(l2W + 32); }
    LBAR();
#pragma unroll 1
    for (int c = 0; c < NCHQ; ++c) {
        int tl_ = tid; asm volatile("" : "+v"(tl_));
        const int tid = tl_, lane = tl_ & 63, tA = tl_ >> 3, jsA = tl_ & 7, jB = tl_ & 63, qB = tl_ >> 6;
        const u32x4 cr = nr, ck = nk, cv = nv;
        { const int o = toff(tA, jsA); *(LAS u32x4*)(RAWk + o) = ck; *(LAS u32x4*)(RAWv + o) = cv; }
        if (c + 1 < NCHQ) { const size_t o = rowbase + (size_t)(c + 1) * 64 * D; nr = *(const u32x4*)(gR + o); nk = *(const u32x4*)(gK + o); nv = *(const u32x4*)(gV + o); nw = *(const u32x4*)(gL + lbase + (size_t)(c + 1) * 64 * LACT_LD); na = *(const u32x4*)(gL + lbase + (size_t)(c + 1) * 64 * LACT_LD + 64); }
        {
            lp Ht = l2kind ? RtM : AtM; lp Ot = l2kind ? RAWa : RAWw;
#pragma unroll
            for (int tb = 0; tb < 4; ++tb) {
                f32x4 acc = *(const LAS f32x4*)(PRM + (3 + l2kind) * 64 + 16 * l2jb + 4 * (lane >> 4));
#pragma unroll
                for (int ks = 0; ks < 2; ++ks) acc = __builtin_amdgcn_mfma_f32_16x16x32_bf16(l2frag[ks], ldfrag(Ht, 16 * tb + (lane & 15), 4 * ks + (lane >> 4)), acc, 0, 0, 0);
#pragma unroll
                for (int e = 0; e < 4; ++e) { const float sg = sigmoidf_(acc[e]); acc[e] = l2kind ? sg : -0.60653066f * sg; }
                st_nat(Ot, 16 * l2jb, 16 * tb, acc, lane);
            }
        }
        LBAR();
        const u32x4 cw = *(const LAS u32x4*)(RAWw + toff(tA, jsA)), ca = *(const LAS u32x4*)(RAWa + toff(tA, jsA));
        float kf[8], af[8], rf[8], wf[8];
        { const unsigned kw[4] = {ck.x, ck.y, ck.z, ck.w}, aw[4] = {ca.x, ca.y, ca.z, ca.w}, rw[4] = {cr.x, cr.y, cr.z, cr.w}, ww[4] = {cw.x, cw.y, cw.z, cw.w};
#pragma unroll
          for (int p = 0; p < 4; ++p) { kf[2 * p] = bflo(kw[p]); kf[2 * p + 1] = bfhi(kw[p]); af[2 * p] = bflo(aw[p]); af[2 * p + 1] = bfhi(aw[p]); rf[2 * p] = bflo(rw[p]); rf[2 * p + 1] = bfhi(rw[p]); wf[2 * p] = bflo(ww[p]); wf[2 * p + 1] = bfhi(ww[p]); } }
        float kkA[8], kpA[8];
        { const f32x4 k0 = *(const LAS f32x4*)(PRM + 8 * jsA), k1 = *(const LAS f32x4*)(PRM + 8 * jsA + 4), a0 = *(const LAS f32x4*)(PRM + 64 + 8 * jsA), a1 = *(const LAS f32x4*)(PRM + 64 + 8 * jsA + 4), r0 = *(const LAS f32x4*)(PRM + 128 + 8 * jsA), r1 = *(const LAS f32x4*)(PRM + 128 + 8 * jsA + 4);
          float ss = 0.f, bs = 0.f;
#pragma unroll
          for (int p = 0; p < 8; ++p) { const float kkw = p < 4 ? k0[p & 3] : k1[p & 3], kaw = p < 4 ? a0[p & 3] : a1[p & 3], rkw = p < 4 ? r0[p & 3] : r1[p & 3];
              kkA[p] = kf[p] * kkw; ss += kkA[p] * kkA[p]; kpA[p] = kf[p] * (1.0f + (af[p] - 1.0f) * kaw); bs += rf[p] * kpA[p] * rkw; }
          ss = red8(ss); bs = red8(bs);
          if (jsA == 0) { INV[tA] = 1.0f / fmaxf(sqrtf(ss), 1e-12f); BSC[tA] = bs; } }
        {
            float pw[8], wlv[8];
            float run = 0.f;
#pragma unroll
            for (int p = 0; p < 8; ++p) { const int t = 8 * qB + p; wlv[p] = bf1(*(const LAS bf16_t*)(RAWw + toff(t, jB >> 3) + (jB & 7) * 2)); run += wlv[p]; pw[p] = run; }
            TOT[qB * 64 + jB] = run;
            LBAR();
            float off = 0.f;
#pragma unroll
            for (int q2 = 0; q2 < 7; ++q2) off += (q2 < qB) ? TOT[q2 * 64 + jB] : 0.f;
            unsigned oa[4], ob[4], ok[4], ov[4];
            float pa = 0.f, pb = 0.f, pk = 0.f, pv = 0.f;
#pragma unroll
            for (int p = 0; p < 8; ++p) { const int t = 8 * qB + p; const int eo = toff(t, jB >> 3) + (jB & 7) * 2;
                const float kv = bf1(*(const LAS bf16_t*)(RAWk + eo)), av = bf1(*(const LAS bf16_t*)(RAWa + eo)), vv = bf1(*(const LAS bf16_t*)(RAWv + eo));
                const float lc = off + pw[p], lx = lc - wlv[p]; LC[t * LCS + jB] = lc;
                const float kkn = kv * kkwB * INV[t], kp = kv * (1.0f + (av - 1.0f) * kawB), em = __expf(-lc);
                const float xa = -kkn * __expf(lx), xb = kkn * av * em, xk = kp * em;
                if (p & 1) { oa[p >> 1] = pk2(pa, xa); ob[p >> 1] = pk2(pb, xb); ok[p >> 1] = pk2(pk, xk); ov[p >> 1] = pk2(pv, vv); } else { pa = xa; pb = xb; pk = xk; pv = vv; }
                if (t == 63) DCv[jB] = __expf(lc); }
            const int o = toff(jB, qB);
            *(LAS u32x4*)(AtT + o) = (u32x4){oa[0], oa[1], oa[2], oa[3]}; *(LAS u32x4*)(BtT + o) = (u32x4){ob[0], ob[1], ob[2], ob[3]}; *(LAS u32x4*)(KtT + o) = (u32x4){ok[0], ok[1], ok[2], ok[3]}; *(LAS u32x4*)(VT + o) = (u32x4){ov[0], ov[1], ov[2], ov[3]};
        }
        LBAR();
        {
            const f32x4 l0 = *(const LAS f32x4*)(LC + tA * LCS + 8 * jsA), l1 = *(const LAS f32x4*)(LC + tA * LCS + 8 * jsA + 4);
            const float inv = INV[tA];
            float xa[8], xr[8], xb[8], xk[8];
#pragma unroll
            for (int p = 0; p < 8; ++p) { const float lc = p < 4 ? l0[p & 3] : l1[p & 3]; const float em = __expf(-lc), ep = __expf(lc), kkn = kkA[p] * inv;
                xa[p] = -kkn * __expf(lc - wf[p]); xr[p] = rf[p] * ep; xb[p] = kkn * af[p] * em; xk[p] = kpA[p] * em; }
            const int o = toff(tA, jsA);
            *(LAS u32x4*)(AtM + o) = (u32x4){pk2(xa[0], xa[1]), pk2(xa[2], xa[3]), pk2(xa[4], xa[5]), pk2(xa[6], xa[7])};
            *(LAS u32x4*)(RtM + o) = (u32x4){pk2(xr[0], xr[1]), pk2(xr[2], xr[3]), pk2(xr[4], xr[5]), pk2(xr[6], xr[7])};
            *(LAS u32x4*)(BtM + o) = (u32x4){pk2(xb[0], xb[1]), pk2(xb[2], xb[3]), pk2(xb[4], xb[5]), pk2(xb[6], xb[7])};
            *(LAS u32x4*)(KtM + o) = (u32x4){pk2(xk[0], xk[1]), pk2(xk[2], xk[3]), pk2(xk[4], xk[5]), pk2(xk[6], xk[7])};
        }
        LBAR();
        float mcv[8]; McvDst mcd; const int mcid = (2 * c) * (256 * NWAVES) + unit * NWAVES + w; const bool mcon = mcid + 256 * NWAVES < MCV_ITEMS + 256 * NWAVES && mcid < MCV_ITEMS;
        if (mcon) mcd = mcv_load(A, F.ws, mcid, lane, mcv);
#pragma unroll 1
        for (int it = 0; it < 5; ++it) {
            const int n = w + 8 * it, X = n / 10, p = n % 10;
            const int tb = (p >= 6) ? 3 : (p >= 3) ? 2 : (p >= 1) ? 1 : 0, sb = p - (tb * (tb + 1)) / 2;
            lp Am = (X & 1) ? KtM : BtM; lp Bm = (X & 2) ? RtM : AtM; lp Om = L + A_RAW + X * TL;
            f32x4 acc = (f32x4){0.f, 0.f, 0.f, 0.f};
            acc = mm64(acc, Am, 16 * sb, Bm, 16 * tb, lane);
            if (sb == tb) { const int tin = lane & 15, s0 = 4 * (lane >> 4);
#pragma unroll
                for (int e = 0; e < 4; ++e) { const bool keep = (X & 2) ? (s0 + e <= tin) : (s0 + e < tin); if (!keep) acc[e] = 0.f; } }
            st_nat(Om, 16 * sb, 16 * tb, acc, lane);
        }
#pragma unroll 1
        for (int it = 0; it < 3; ++it) {
            const int n = w + 8 * it, X = n / 6, p = n % 6;
            const int tb = (p >= 5) ? 2 : (p >= 3) ? 1 : 0, sb = (tb == 0) ? p + 1 : (tb == 1) ? p - 1 : 3;
            st_nat(L + A_RAW + X * TL, 16 * sb, 16 * tb, (f32x4){0.f, 0.f, 0.f, 0.f}, lane);
        }
        LBAR();
        f32x4 rhs[4];
        if (w < 4) {
            if (lane < 16) {
                const int bb = w, r = lane; float Tr[16];
#pragma unroll
                for (int t = 0; t < 16; ++t) {
                    const u32x4 m0 = *(const LAS u32x4*)(MabT + toff(16 * bb + t, 2 * bb)), m1 = *(const LAS u32x4*)(MabT + toff(16 * bb + t, 2 * bb + 1));
                    const unsigned mw[8] = {m0.x, m0.y, m0.z, m0.w, m1.x, m1.y, m1.z, m1.w};
                    float acc = (r == t) ? 1.f : 0.f;
#pragma unroll
                    for (int s2 = 0; s2 < 16; ++s2) if (s2 < t) acc += Tr[s2] * ((s2 & 1) ? bfhi(mw[s2 >> 1]) : bflo(mw[s2 >> 1]));
                    Tr[t] = acc;
                }
#pragma unroll
                for (int t2 = 0; t2 < 16; ++t2) *(LAS bf16_t*)(TB + bb * 512 + t2 * 32 + r * 2) = (bf16_t)f2bf(Tr[t2]);
            }
#pragma unroll
            for (int bb = 0; bb < 4; ++bb) rhs[bb] = ld_nat(AtT, 16 * bb, 16 * w, lane);
        } else {
#pragma unroll
            for (int bb = 0; bb < 4; ++bb) rhs[bb] = mm64((f32x4){0.f, 0.f, 0.f, 0.f}, MkaT, 16 * bb, VT, 16 * (w - 4), lane);
        }
        { lp Xw = (w < 4 ? XP : XQ) + (16 * (w & 3)) * 128; *(LAS u32x4*)(Xw + lane * 32) = (u32x4){0u, 0u, 0u, 0u}; *(LAS u32x4*)(Xw + lane * 32 + 16) = (u32x4){0u, 0u, 0u, 0u}; }
        LBAR();
        {
            lp Xt = (w < 4) ? XP : XQ; const int r0 = 16 * (w & 3); const int q = lane >> 4, rr = lane & 15;
#pragma unroll
            for (int bb = 0; bb < 4; ++bb) {
                f32x4 acc = rhs[bb];
                if (bb > 0) acc = mm64(acc, MabT, 16 * bb, Xt, r0, lane);
                st_nat(Xt, 16 * bb, r0, acc, lane);
                asm volatile("s_waitcnt lgkmcnt(0)" ::: "memory");
                bf16x8 ta = (bf16x8){0, 0, 0, 0, 0, 0, 0, 0}, xb = ta;
                if (q < 2) { ta = *(const LAS bf16x8*)(TB + bb * 512 + rr * 32 + q * 16); xb = ldfrag(Xt, r0 + rr, 2 * bb + q); }
                const f32x4 d2 = __builtin_amdgcn_mfma_f32_16x16x32_bf16(ta, xb, (f32x4){0.f, 0.f, 0.f, 0.f}, 0, 0, 0);
                st_nat(Xt, 16 * bb, r0, d2, lane);
                asm volatile("s_waitcnt lgkmcnt(0)" ::: "memory");
            }
        }
        LBAR();
        if (mcon) mcv_store(mcd, mcv);
        const bool mcon2 = mcid + 256 * NWAVES < MCV_ITEMS;
        if (mcon2) mcd = mcv_load(A, F.ws, mcid + 256 * NWAVES, lane, mcv);
#pragma unroll 2
        for (int it = 0; it < 4; ++it) {
            const int id = 4 * w + it, nb = (id >> 2) & 3, mb = id & 3;
            if (id < 16) { f32x4 acc = ld_nat(RtM, 16 * mb, 16 * nb, lane);
                acc = mm64(acc, XP, 16 * mb, NbrT, 16 * nb, lane); st_nat(ZT, 16 * mb, 16 * nb, acc, lane); }
            else { f32x4 acc = mm64((f32x4){0.f, 0.f, 0.f, 0.f}, XP, 16 * mb, BtT, 16 * nb, lane);
                const int jn = 16 * nb + (lane & 15), jm = 16 * mb + 4 * (lane >> 4); const float dc = DCv[jn];
#pragma unroll
                for (int e = 0; e < 4; ++e) acc[e] = (acc[e] + ((jm + e == jn) ? 1.f : 0.f)) * dc;
                st_nat(GcT, 16 * mb, 16 * nb, acc, lane); }
        }
        LBAR();
#pragma unroll 2
        for (int it = 0; it < 8; ++it) {
            const int kind = it & 3, ti = (it >> 2) * 8 + w, nb = ti >> 2, mb = ti & 3;
            if (kind == 0) { f32x4 acc = mm64((f32x4){0.f, 0.f, 0.f, 0.f}, XQ, 16 * mb, NbrT, 16 * nb, lane); acc = mm64(acc, VT, 16 * mb, NkrT, 16 * nb, lane); acc = mm64(acc, SL, 16 * mb, ZT, 16 * nb, lane);
                st_nat(YT, 16 * mb, 16 * nb, acc, lane); }
            else if (kind == 1) { f32x4 acc = mm64((f32x4){0.f, 0.f, 0.f, 0.f}, BtT, 16 * mb, XQ, 16 * nb, lane); acc = mm64(acc, KtT, 16 * mb, VT, 16 * nb, lane);
                const f32x4 dc = *(const LAS f32x4*)(DCv + 16 * mb + 4 * (lane >> 4)); acc = acc * dc;
                acc = mm64(acc, GcT, 16 * mb, SL, 16 * nb, lane); st_nat(TS, 16 * mb, 16 * nb, acc, lane); }
            else if (kind == 2) { const f32x4 acc = mm64((f32x4){0.f, 0.f, 0.f, 0.f}, SG, 16 * mb, ZT, 16 * nb, lane); st_nat(ZC, 16 * mb, 16 * nb, acc, lane); }
            else { const f32x4 acc = mm64((f32x4){0.f, 0.f, 0.f, 0.f}, GcT, 16 * mb, SG, 16 * nb, lane); st_nat(TG, 16 * mb, 16 * nb, acc, lane); }
        }
        LBAR();
        {
            const int o = toff(tA, jsA);
            const u32x4 y16 = *(const LAS u32x4*)(YT + o), z16 = *(const LAS u32x4*)(ZC + o);
            const u32x4 g16 = *(const LAS u32x4*)(TG + tid * 16), s16 = *(const LAS u32x4*)(TS + tid * 16);
            const size_t go = rowbase + (size_t)c * 64 * D;
            *(u32x4*)(gYL + go) = y16; *(u32x4*)(gZC + go) = z16;
            if (jsA == 0) gBS[(trow0 + (size_t)c * 64 + tA) * NH + h] = BSC[tA];
            *(LAS u32x4*)(SG + tid * 16) = g16; *(LAS u32x4*)(SL + tid * 16) = s16;
            if (c + 1 < NCHQ) { *(LAS u32x4*)(AtM + o) = nw; *(LAS u32x4*)(RtM + o) = na; }
        }
        if (mcon2) mcv_store(mcd, mcv);
        LBAR();
    }
    { u32x4* seg = (u32x4*)(F.ws + WS_SEG) + (size_t)unit * 1024; seg[tid] = *(const LAS u32x4*)(SG + tid * 16); seg[512 + tid] = *(const LAS u32x4*)(SL + tid * 16); }
}
__device__ __forceinline__ void phase_scanB(Frame& F, const Args& A) {
    using namespace sm;
    const int unit = F.vcu, bh = unit >> 2, qq = unit & 3, b = bh / NH, h = bh % NH;
    const int tid = F.tid, lane = F.lane, w = F.wave;
    const int tA = tid >> 3, jsA = tid & 7;
    lp L = F.lds;
    LAS float* Sf = (LAS float*)L;
    LAS float* Gf = Sf + 64 * 65;
    lp SS = L + 40960, YLt = SS + TL, ZCt = YLt + TL; LAS float* LCy = (LAS float*)(ZCt + TL);
    LAS float* PRM = LCy + 64 * LCS;
    if (tid < 64) { const int ch = h * HS + tid; PRM[tid] = A.in[I_LNG][ch]; PRM[64 + tid] = A.in[I_LNB][ch]; }
    lp LgT = L + 90112, W2T = LgT + 3 * TL; LAS float* Gy = (LAS float*)(W2T + 3 * TL);
    { const bf16_t* W2 = (const bf16_t*)(F.ws + WS_WL2) + (size_t)(2 * D + h * HS + tA) * 256 + 8 * jsA;
#pragma unroll
      for (int i = 0; i < 3; ++i) *(LAS u32x4*)(W2T + i * TL + toff(tA, jsA)) = *(const u32x4*)(W2 + 64 * i); }
    const bf16_t* gL = (const bf16_t*)A.out;
    const int ci = tid >> 3, cj0 = (tid & 7) * 8;
    float sv[8];
#pragma unroll
    for (int p = 0; p < 8; ++p) sv[p] = 0.f;
    for (int q2 = 0; q2 < qq; ++q2) {
        const unsigned char* seg = (const unsigned char*)(F.ws + WS_SEG) + (size_t)(bh * 4 + q2) * 16384;
        const u32x4 g16 = *(const u32x4*)(seg + toff(ci, cj0 >> 3)), h16 = *(const u32x4*)(seg + 8192 + toff(ci, cj0 >> 3));
#pragma unroll
        for (int p = 0; p < 8; ++p) Sf[ci * 65 + cj0 + p] = sv[p];
        { const unsigned gw[4] = {g16.x, g16.y, g16.z, g16.w};
#pragma unroll
          for (int p = 0; p < 4; ++p) { Gf[ci * 64 + cj0 + 2 * p] = bflo(gw[p]); Gf[ci * 64 + cj0 + 2 * p + 1] = bfhi(gw[p]); } }
        LBAR();
        const unsigned hw[4] = {h16.x, h16.y, h16.z, h16.w};
        float o[8] = {bflo(hw[0]), bfhi(hw[0]), bflo(hw[1]), bfhi(hw[1]), bflo(hw[2]), bfhi(hw[2]), bflo(hw[3]), bfhi(hw[3])};
#pragma unroll 8
        for (int k = 0; k < 64; ++k) { const float sk = Sf[ci * 65 + k]; const f32x4 g0 = *(const LAS f32x4*)(Gf + k * 64 + cj0), g1 = *(const LAS f32x4*)(Gf + k * 64 + cj0 + 4);
            o[0] += sk * g0[0]; o[1] += sk * g0[1]; o[2] += sk * g0[2]; o[3] += sk * g0[3]; o[4] += sk * g1[0]; o[5] += sk * g1[1]; o[6] += sk * g1[2]; o[7] += sk * g1[3]; }
#pragma unroll
        for (int p = 0; p < 8; ++p) sv[p] = o[p];
        LBAR();
    }
    *(LAS u32x4*)(SS + toff(ci, cj0 >> 3)) = (u32x4){pk2(sv[0], sv[1]), pk2(sv[2], sv[3]), pk2(sv[4], sv[5]), pk2(sv[6], sv[7])};
    const bf16_t* gYL = (const bf16_t*)(F.ws + WS_R); const bf16_t* gZC = (const bf16_t*)(F.ws + WS_K); const bf16_t* gV = (const bf16_t*)(F.ws + WS_V); const bf16_t* gG = (const bf16_t*)(F.ws + WS_GG);
    const float* gBS = (const float*)(F.ws + WS_BSC); bf16_t* gO = (bf16_t*)(F.ws + WS_R);
    const size_t trow0 = (size_t)b * SEQ + (size_t)qq * SEQQ;
    const size_t rowbase = (trow0 + tA) * D + h * HS + jsA * 8;
    u32x4 ny = *(const u32x4*)(gYL + rowbase), nz = *(const u32x4*)(gZC + rowbase), nv = *(const u32x4*)(gV + rowbase), ng0, ng1, ng2; float nbs = gBS[(trow0 + tA) * NH + h];
    const size_t lbase = (trow0 + tA) * LACT_LD + 128 + jsA * 8;
    ng0 = *(const u32x4*)(gL + lbase); ng1 = *(const u32x4*)(gL + lbase + 64); ng2 = *(const u32x4*)(gL + lbase + 128);
    LBAR();
#pragma unroll 1
    for (int c = 0; c < NCHQ; ++c) {
        const u32x4 cy = ny, cz = nz, cv = nv; const float bs = nbs;
        { const int o = toff(tA, jsA); *(LAS u32x4*)(YLt + o) = cy; *(LAS u32x4*)(ZCt + o) = cz; *(LAS u32x4*)(LgT + o) = ng0; *(LAS u32x4*)(LgT + TL + o) = ng1; *(LAS u32x4*)(LgT + 2 * TL + o) = ng2; }
        if (c + 1 < NCHQ) { const size_t o = rowbase + (size_t)(c + 1) * 64 * D; ny = *(const u32x4*)(gYL + o); nz = *(const u32x4*)(gZC + o); nv = *(const u32x4*)(gV + o); nbs = gBS[(trow0 + (size_t)(c + 1) * 64 + tA) * NH + h];
            const size_t lo = lbase + (size_t)(c + 1) * 64 * LACT_LD; ng0 = *(const u32x4*)(gL + lo); ng1 = *(const u32x4*)(gL + lo + 64); ng2 = *(const u32x4*)(gL + lo + 128); }
        LBAR();
#pragma unroll
        for (int it = 0; it < 2; ++it) { const int mb = w & 3, nb = 2 * (w >> 2) + it;
            f32x4 acc = ld_nat(YLt, 16 * mb, 16 * nb, lane); acc = mm64(acc, SS, 16 * mb, ZCt, 16 * nb, lane);
            *(LAS f32x4*)(LCy + (16 * nb + (lane & 15)) * LCS + 16 * mb + 4 * (lane >> 4)) = acc;
            f32x4 ga = (f32x4){0.f, 0.f, 0.f, 0.f};
#pragma unroll
            for (int i = 0; i < 3; ++i) ga = mm64(ga, W2T + i * TL, 16 * mb, LgT + i * TL, 16 * nb, lane);
            *(LAS f32x4*)(Gy + (16 * nb + (lane & 15)) * LCS + 16 * mb + 4 * (lane >> 4)) = ga; }
        LBAR();
        {
            const f32x4 y0 = *(const LAS f32x4*)(LCy + tA * LCS + 8 * jsA), y1 = *(const LAS f32x4*)(LCy + tA * LCS + 8 * jsA + 4);
            float yv[8] = {y0[0], y0[1], y0[2], y0[3], y1[0], y1[1], y1[2], y1[3]};
            float s1 = 0.f;
#pragma unroll
            for (int p = 0; p < 8; ++p) s1 += yv[p];
            const float mean = red8(s1) * (1.0f / 64.0f); float s2 = 0.f;
#pragma unroll
            for (int p = 0; p < 8; ++p) { yv[p] -= mean; s2 += yv[p] * yv[p]; }
            const float rstd = rsqrtf(red8(s2) * (1.0f / 64.0f) + LNX_EPS);
            const f32x4 g0 = *(const LAS f32x4*)(PRM + 8 * jsA), g1 = *(const LAS f32x4*)(PRM + 8 * jsA + 4), b0 = *(const LAS f32x4*)(PRM + 64 + 8 * jsA), b1 = *(const LAS f32x4*)(PRM + 64 + 8 * jsA + 4);
            const unsigned vw[4] = {cv.x, cv.y, cv.z, cv.w};
            const f32x4 gq0 = *(const LAS f32x4*)(Gy + tA * LCS + 8 * jsA), gq1 = *(const LAS f32x4*)(Gy + tA * LCS + 8 * jsA + 4);
            float ov[8];
#pragma unroll
            for (int p = 0; p < 8; ++p) { const float lg = p < 4 ? g0[p & 3] : g1[p & 3], lb = p < 4 ? b0[p & 3] : b1[p & 3];
                const float vv = (p & 1) ? bfhi(vw[p >> 1]) : bflo(vw[p >> 1]), gg = p < 4 ? gq0[p & 3] : gq1[p & 3];
                ov[p] = (yv[p] * rstd * lg + lb + bs * vv) * gg; }
            *(u32x4*)(gO + rowbase + (size_t)c * 64 * D) = (u32x4){pk2(ov[0], ov[1]), pk2(ov[2], ov[3]), pk2(ov[4], ov[5]), pk2(ov[6], ov[7])};
        }
    }
}

__device__ __forceinline__ void phase_post3(Frame& F, const Args& A, const RowP& P) {
    LAS float* rt = (LAS float*)F.lds;
    LAS int* sel = (LAS int*)(F.lds + 32768);
    LAS int* cnts = (LAS int*)(F.lds + 32768 + 1024);
    LAS int* bef = (LAS int*)(F.lds + 32768 + 2048);
    for (int i = F.tid; i < D * NE / 4; i += NTHREADS) ((LAS f32x4*)rt)[i] = ((const f32x4*)A.in[I_ROUTER])[i];
    __syncthreads();
    int* toke = (int*)(F.ws + WS_TOKE); float* tokw = (float*)(F.ws + WS_TOKW); int* tokli = (int*)(F.ws + WS_TOKLI); int* cnt = (int*)(F.ws + WS_CNT);
    const int wgi = blockIdx.x;
    RowIn cur, nxt; row_load(P, wgi * 128 + F.wave * 16, F.lane, cur);
    for (int s = 0; s < 16; ++s) {
        const int tl = F.wave * 16 + s, t = wgi * 128 + tl;
        if (s + 1 < 16) row_load(P, t + 1, F.lane, nxt);
        f32x4 hv[4]; row_compute(P, t, F.lane, cur, hv, true); cur = nxt;
        float lg[8];
#pragma unroll
        for (int e = 0; e < 8; ++e) lg[e] = 0.f;
#pragma unroll
        for (int j = 0; j < 4; ++j)
#pragma unroll
            for (int q = 0; q < 4; ++q) { const int c = 4 * F.lane + 256 * j + q; const f32x4 r0 = *(const LAS f32x4*)(rt + c * 8), r1 = *(const LAS f32x4*)(rt + c * 8 + 4); const float hvv = hv[j][q];
                lg[0] += hvv * r0[0]; lg[1] += hvv * r0[1]; lg[2] += hvv * r0[2]; lg[3] += hvv * r0[3]; lg[4] += hvv * r1[0]; lg[5] += hvv * r1[1]; lg[6] += hvv * r1[2]; lg[7] += hvv * r1[3]; }
        {
            const bool h5 = F.lane & 32, h4 = F.lane & 16, h3 = F.lane & 8;
            float a4[4];
#pragma unroll
            for (int i = 0; i < 4; ++i) { const float mine = h5 ? lg[i + 4] : lg[i], send = h5 ? lg[i] : lg[i + 4]; a4[i] = mine + __shfl_xor(send, 32); }
            float a2[2];
#pragma unroll
            for (int i = 0; i < 2; ++i) { const float mine = h4 ? a4[i + 2] : a4[i], send = h4 ? a4[i] : a4[i + 2]; a2[i] = mine + __shfl_xor(send, 16); }
            float a1 = (h3 ? a2[1] : a2[0]) + __shfl_xor(h3 ? a2[0] : a2[1], 8);
            a1 += __shfl_xor(a1, 1); a1 += __shfl_xor(a1, 2); a1 += __shfl_xor(a1, 4);
#pragma unroll
            for (int e = 0; e < 8; ++e) lg[e] = __builtin_bit_cast(float, __builtin_amdgcn_readlane(__builtin_bit_cast(int, a1), e * 8));
        }
        int e0 = 0; float m0 = lg[0];
#pragma unroll
        for (int e = 1; e < 8; ++e) if (lg[e] > m0) { m0 = lg[e]; e0 = e; }
        int e1 = -1; float m1 = -3.0e38f;
#pragma unroll
        for (int e = 0; e < 8; ++e) if (e != e0 && lg[e] > m1) { m1 = lg[e]; e1 = e; }
        const float w1 = 1.0f / (1.0f + __expf(m0 - m1)), w0 = 1.0f - w1;
        if (F.lane == 0) { toke[2 * t] = e0; toke[2 * t + 1] = e1; tokw[2 * t] = w0; tokw[2 * t + 1] = w1; sel[2 * tl] = e0; sel[2 * tl + 1] = e1; }
    }
    __syncthreads();
    if (F.tid < 256) {
        const int e = sel[F.tid];
        int before = 0;
#pragma unroll
        for (int q = 0; q < 8; ++q) { const unsigned long long mk = __ballot(e == q); if (e == q) before = __popcll(mk & ((1ull << F.lane) - 1ull)); if (F.lane == 0) cnts[F.wave * 8 + q] = __popcll(mk); }
        bef[F.tid] = before;
    }
    __syncthreads();
    if (F.tid < 256) {
        const int p = F.tid, tl = p >> 1, t = wgi * 128 + tl; const int e = sel[p];
        int base = 0; for (int w = 0; w < F.wave; ++w) base += cnts[w * 8 + e];
        tokli[2 * t + (p & 1)] = base + bef[p];
    }
    if (F.tid < 8) cnt[wgi * 8 + F.tid] = cnts[F.tid] + cnts[8 + F.tid] + cnts[16 + F.tid] + cnts[24 + F.tid];
}
__device__ __forceinline__ void phase_route(Frame& F) {
    LAS int* tot = (LAS int*)F.lds;
    const int* cnt = (const int*)(F.ws + WS_CNT); const int wgi = blockIdx.x;
    { const int e = F.wave; int s = 0, pre = 0;
      for (int v = F.lane; v < 256; v += 64) { const int c = cnt[v * 8 + e]; s += c; if (v < wgi) pre += c; }
      s = (int)wave_sum((float)s); pre = (int)wave_sum((float)pre);
      if (F.lane == 0) { tot[e] = s; tot[8 + e] = pre; } }
    __syncthreads();
    if (F.tid == 0) { int st = 0; for (int e = 0; e < 8; ++e) { tot[16 + e] = st; st += ((tot[e] + 255) >> 8) << 8; } tot[24] = st; }
    __syncthreads();
    const int* toke = (const int*)(F.ws + WS_TOKE); const int* tokli = (const int*)(F.ws + WS_TOKLI); int* tokslot = (int*)(F.ws + WS_TOKSLOT); int* rowidx = (int*)(F.ws + WS_ROWIDX); int* tilee = (int*)(F.ws + WS_TILEE);
    if (F.tid < 256) { const int p = F.tid, t = wgi * 128 + (p >> 1), e = toke[2 * t + (p & 1)]; const int slot = tot[16 + e] + tot[8 + e] + tokli[2 * t + (p & 1)];
        tokslot[2 * t + (p & 1)] = slot; rowidx[slot] = t; }
    if (wgi < 8) { const int e = wgi; const int s0 = tot[16 + e] + tot[e], s1 = tot[16 + e] + (((tot[e] + 255) >> 8) << 8); for (int s = s0 + F.tid; s < s1; s += NTHREADS) rowidx[s] = 0; }
    if (wgi == 8) { const int nt = tot[24] >> 8; for (int i = F.tid; i < nt; i += NTHREADS) { int e = 0; for (int q = 1; q < 8; ++q) if (i * 256 >= tot[16 + q]) e = q; tilee[i] = e; }
        if (F.tid == 0) ((unsigned*)(F.ws + WS_CTL))[CW_MOE_NM] = (unsigned)nt; }
}
struct FinIn { u32x2 xw[4]; u32x2 a[4]; u32x2 c[4]; };
__device__ __forceinline__ void fin_load(FinIn& in, const float* out, const bf16_t* Y2, int t, int s0, int s1, int lane) {
    const GAS u32x2* xb = (const GAS u32x2*)((const bf16_t*)out + (size_t)t * 2048 + 1024) + lane;
    const GAS u32x2* y0 = (const GAS u32x2*)(Y2 + (size_t)s0 * D) + lane; const GAS u32x2* y1 = (const GAS u32x2*)(Y2 + (size_t)s1 * D) + lane;
#pragma unroll
    for (int j = 0; j < 4; ++j) in.xw[j] = xb[64 * j];
#pragma unroll
    for (int j = 0; j < 4; ++j) { in.a[j] = y0[64 * j]; in.c[j] = y1[64 * j]; }
}
__device__ __forceinline__ void phase_final(Frame& F, float* out, const float* gate, const float* gpost) {
    const int gw = F.vcu * NWAVES + F.wave, NGW = F.G * NWAVES; const int lane = F.lane;
    const int* tokslot = (const int*)(F.ws + WS_TOKSLOT); const float* tokw = (const float*)(F.ws + WS_TOKW); const bf16_t* Y2 = (const bf16_t*)(F.ws + WS_Y2);
    int t = gw; if (t >= T) return;
    FinIn cur, nxt;
    float w0 = tokw[2 * t], w1 = tokw[2 * t + 1];
    fin_load(cur, out, Y2, t, tokslot[2 * t], tokslot[2 * t + 1], lane);
    int tn = t + NGW;
    int s0n = 0, s1n = 0; float w0n = 0.f, w1n = 0.f;
    if (tn < T) { s0n = tokslot[2 * tn]; s1n = tokslot[2 * tn + 1]; w0n = tokw[2 * tn]; w1n = tokw[2 * tn + 1]; }
#pragma unroll 1
    for (; t < T; t = tn, tn += NGW) {
        int s0f = 0, s1f = 0; float w0f = 0.f, w1f = 0.f;
        if (tn < T) fin_load(nxt, out, Y2, tn, s0n, s1n, lane);
        { const int tf = tn + NGW; if (tf < T) { s0f = tokslot[2 * tf]; s1f = tokslot[2 * tf + 1]; w0f = tokw[2 * tf]; w1f = tokw[2 * tf + 1]; } }
        const int b = t / SEQ;
        f32x4 yv[4]; float ss = 0.f;
#pragma unroll
        for (int j = 0; j < 4; ++j) { const u32x2 a = cur.a[j], c = cur.c[j];
            yv[j] = (f32x4){w0 * bflo(a.x) + w1 * bflo(c.x), w0 * bfhi(a.x) + w1 * bfhi(c.x), w0 * bflo(a.y) + w1 * bflo(c.y), w0 * bfhi(a.y) + w1 * bfhi(c.y)};
            ss += (yv[j].x * yv[j].x + yv[j].y * yv[j].y) + (yv[j].z * yv[j].z + yv[j].w * yv[j].w); }
        const float rs = rsqrtf(wave_sum(ss) * (1.0f / D) + RMS_EPS);
        GAS f32x4* xo = (GAS f32x4*)(out + (size_t)t * D) + lane;
        asm volatile("" :: "v"(cur.xw[0].x), "v"(cur.xw[0].y), "v"(cur.xw[1].x), "v"(cur.xw[1].y), "v"(cur.xw[2].x), "v"(cur.xw[2].y), "v"(cur.xw[3].x), "v"(cur.xw[3].y) : "memory");
#pragma unroll
        for (int j = 0; j < 4; ++j) { const f32x4 gt = *((const f32x4*)(gate + (size_t)b * 6144) + lane + 64 * j); const f32x4 gp = *((const f32x4*)gpost + lane + 64 * j);
            const f32x4 xv = (f32x4){bflo(cur.xw[j].x), bfhi(cur.xw[j].x), bflo(cur.xw[j].y), bfhi(cur.xw[j].y)};
            xo[64 * j] = xv + gt * gp * yv[j] * rs; }
        cur = nxt; w0 = w0n; w1 = w1n; s0n = s0f; s1n = s1f; w0n = w0f; w1n = w1f;
    }
}
__device__ __forceinline__ void zero_h2_rows(Frame& F) {
    bf16_t* H2 = (bf16_t*)(F.ws + WS_H2);
    if (F.vcu < BATCH && F.tid < 128) ((u32x4*)(H2 + (size_t)F.vcu * (SEQ + 1) * D))[F.tid] = (u32x4){0u, 0u, 0u, 0u};
}

__device__ __forceinline__ bool launder(Frame& F) { int t = F.tid; asm volatile("" : "+v"(t)); F.tid = t; F.lane = t & 63; return true; }
constexpr int NPHASE = 22;
__device__ __forceinline__ pg8::GemmDesc mkdesc(const bf16_t* A, int lda, const bf16_t* Bt, int K, int nM, int nN, int mode, bf16_t* o0, int ldc) {
    pg8::GemmDesc g; g.A = A; g.Bt = Bt; g.lda = lda; g.K = K; g.nM = nM; g.nN = nN; g.a_bt = 0; g.a_bx = 0; g.a_pn_split = 1 << 30; g.a_pn_coloff = 0; g.a_pn_div = 1 << 30; g.a_pn_stride = 0; g.pn_bias = 0; g.rowidx = nullptr; g.tile_e = nullptr; g.b_estride = 0;
    g.mode = mode; g.o0 = o0; g.o1 = nullptr; g.o2 = nullptr; g.ldc = ldc; g.p0 = nullptr; g.p1 = nullptr; g.flag = 0; return g;
}

__global__ void __launch_bounds__(NTHREADS, 2) fwd_kernel(Args args) {
    extern __shared__ __attribute__((aligned(16))) unsigned char lds_raw[];
    Frame F;
    F.lds = (LAS unsigned char*)lds_raw;
    F.tid = threadIdx.x; F.lane = F.tid & 63; F.wave = __builtin_amdgcn_readfirstlane(F.tid >> 6);
    F.G = gridDim.x; { const int bx = blockIdx.x; F.vcu = (F.G % 8 == 0) ? (bx % 8) * (F.G / 8) + bx / 8 : bx; }
    F.ws = args.ws;
    volatile LAS unsigned* MISC = (volatile LAS unsigned*)(F.lds + MISC_OFF);
    if (F.tid < 16) MISC[F.tid] = 0u;
    __syncthreads();
    unsigned* ctl = (unsigned*)(F.ws + WS_CTL);
    XcdBarrier bar; bar.bar = ctl + CW_BAR; bar.x = 0; bar.st = nullptr;
#if N_LAUNCH_MODE == 0
    bar = xcd_barrier_post(ctl + CW_BAR, MISC + 8);
#endif
    unsigned char* ws = F.ws;
    const float* mod = (const float*)(ws + WS_MOD);
    const float* ng = args.in[I_NORMG];
    const int lo = args.ph_lo, hi = args.ph_hi;
    const int cid = (int)blockIdx.x;
#define MODP(l, ch) (mod + (size_t)(l) * 4 * 6144 + (ch) * D)
    bf16_t* H = (bf16_t*)(ws + WS_H);

#define PHASE(k) if (lo <= (k) && (k) < hi && launder(F))
#define INP(k) (lo <= (k) && (k) < hi)
#define SEAM(k) do { if (INP(k) && INP((k) + 1)) xcd_barrier(bar); } while (0)
#define GEMM(GATH, g) pg8::gemm_phase<GATH>(F.lds, g, F.G, cid, F.tid)
    PHASE(0) { phase_prologue(F, args); } SEAM(0);
    PHASE(1) { RowP P{args.in[I_X], nullptr, nullptr, nullptr, nullptr, ng + 0 * D, MODP(0, 1), MODP(0, 0), H, 0, nullptr, 0, 0}; phase_rows(F, P); } SEAM(1);
    PHASE(2) { pg8::GemmDesc g = mkdesc(H, D, (const bf16_t*)(ws + WS_WIN), D, T / 256, MIXIN / 256, pg8::EM_MIXIN, (bf16_t*)(ws + WS_Z), ZLD); GEMM(false, g); } SEAM(2);
    PHASE(3) { phase_mix(F, args); } SEAM(3);
    PHASE(4) { pg8::GemmDesc g = mkdesc((const bf16_t*)(ws + WS_A2), D, (const bf16_t*)(ws + WS_WOUTE), D, T / 256, D / 256, pg8::EM_BF16, (bf16_t*)(ws + WS_Y0), D); GEMM(false, g); } SEAM(4);
    PHASE(5) { RowP P{args.in[I_X], args.out, (const bf16_t*)(ws + WS_Y0), MODP(0, 2), ng + 1 * D, ng + 2 * D, MODP(0, 4), MODP(0, 3), H, 0, (float*)(ws + WS_XH), 0, 1}; phase_rows(F, P); } SEAM(5);
    PHASE(6) { pg8::GemmDesc g = mkdesc(H, D, (const bf16_t*)(ws + WS_WFGU), D, T / 256, 2 * FF / 256, pg8::EM_SWIGLU, (bf16_t*)(ws + WS_HFF), FF); GEMM(false, g); } SEAM(6);
    PHASE(7) { pg8::GemmDesc g = mkdesc((const bf16_t*)(ws + WS_HFF), FF, (const bf16_t*)(ws + WS_WFD), FF, T / 256, D / 256, pg8::EM_BF16, (bf16_t*)(ws + WS_Y0), D); GEMM(false, g); } SEAM(7);
    PHASE(8) { RowP P{args.out, args.out, (const bf16_t*)(ws + WS_Y0), MODP(0, 5), ng + 3 * D, ng + 4 * D, MODP(1, 1), MODP(1, 0), (bf16_t*)(ws + WS_H2), 1, nullptr, 1, 1}; phase_post2(F, args, P); zero_h2_rows(F); } SEAM(8);
    PHASE(9) {
        { pg8::GemmDesc g = mkdesc((const bf16_t*)(ws + WS_XR), D, (const bf16_t*)(ws + WS_WRKV), D, T / 256, 12, pg8::EM_RKVL, (bf16_t*)(ws + WS_R), D);
          g.a_pn_div = 4; g.a_pn_stride = (long)T * D; GEMM(false, g); }
        { pg8::GemmDesc g = mkdesc((const bf16_t*)(ws + WS_H2), D, (const bf16_t*)(ws + WS_WLOR), 2 * D, T / 256, 2, pg8::EM_RKVL, (bf16_t*)(ws + WS_R), D);
          g.a_bt = SEQ / 256; g.a_bx = 1; g.o1 = (bf16_t*)args.out; g.pn_bias = 12; GEMM(false, g); } } SEAM(9);
    PHASE(11) { phase_scanA(F, args); } SEAM(11);
    PHASE(12) { phase_scanB(F, args); } SEAM(12);
    PHASE(14) { pg8::GemmDesc g = mkdesc((const bf16_t*)(ws + WS_R), D, (const bf16_t*)(ws + WS_WO), D, T / 256, D / 256, pg8::EM_BF16, (bf16_t*)(ws + WS_Y1), D); GEMM(false, g);
        } SEAM(14);
    PHASE(15) { RowP P{args.out, args.out, (const bf16_t*)(ws + WS_Y1), MODP(1, 2), ng + 5 * D, ng + 6 * D, MODP(1, 4), MODP(1, 3), (bf16_t*)(ws + WS_H3), 0, nullptr, 1, 1}; phase_post3(F, args, P); } SEAM(15);
    PHASE(16) { phase_route(F); } SEAM(16);
#define MOE1(p1) PHASE(p1) { const int moe_nm = (int)__hip_atomic_load(ctl + CW_MOE_NM, __ATOMIC_RELAXED, __HIP_MEMORY_SCOPE_AGENT); \
        pg8::GemmDesc g = mkdesc((const bf16_t*)(ws + WS_H3), D, (const bf16_t*)(ws + WS_WMGU), D, moe_nm, 2 * FH / 256, pg8::EM_SWIGLU, (bf16_t*)(ws + WS_HM), FH); \
        g.rowidx = (const int*)(ws + WS_ROWIDX); g.tile_e = (const int*)(ws + WS_TILEE); g.b_estride = (long)FF * D; GEMM(true, g); } SEAM(p1)
#define MOE2(p2, half) PHASE(p2) { const int moe_nm = (int)__hip_atomic_load(ctl + CW_MOE_NM, __ATOMIC_RELAXED, __HIP_MEMORY_SCOPE_AGENT); \
        pg8::GemmDesc g = mkdesc((const bf16_t*)(ws + WS_HM), FH, (const bf16_t*)(ws + (half ? WS_WMD1 : WS_WMD0)), FH, moe_nm, D / 256, pg8::EM_MOE2, (bf16_t*)(ws + WS_Y2), D); \
        g.tile_e = (const int*)(ws + WS_TILEE); g.b_estride = (long)D * FH; g.flag = half; GEMM(false, g); \
        if (half == 0) { __syncthreads();     \
            const int nbusy = (moe_nm * (D / 256)) % F.G; const bool excl = nbusy > 0 && nbusy <= 64; \
            if (!(excl && cid < nbusy)) moe_convert(F, args, 0, 1, (bf16_t*)(ws + WS_WMGU), excl ? cid - nbusy : F.vcu, excl ? F.G - nbusy : F.G); \
            __syncthreads(); } } SEAM(p2)
    MOE1(17); MOE2(18, 0); MOE1(19); MOE2(20, 1);
#undef MOE1
#undef MOE2
    PHASE(21) { phase_final(F, args.out, MODP(1, 5), ng + 7 * D); }
#undef PHASE
#undef INP
#undef SEAM
#undef GEMM
#undef MODP
}

extern "C" void kernel_launch(void* const* d_in, const int* in_sizes, int n_in, void* d_out, int out_size, void* d_ws, size_t ws_size, hipStream_t stream) {
    static int grid = 0;
    if (grid == 0) {
        if (n_in != 35 || in_sizes[0] != T * D || out_size != T * D || ws_size < WS_END) { fprintf(stderr, "kernel_launch: unexpected shapes: n_in %d in0 %d out %d ws %zu (need %zu)\n", n_in, n_in > 0 ? in_sizes[0] : -1, out_size, ws_size, (size_t)WS_END); grid = -1; return; }
        int dev = 0, cus = 0, per_cu = 0;
        if (hipGetDevice(&dev) != hipSuccess || hipDeviceGetAttribute(&cus, hipDeviceAttributeMultiprocessorCount, dev) != hipSuccess) { grid = -1; return; }
        if (hipFuncSetAttribute((const void*)fwd_kernel, hipFuncAttributeMaxDynamicSharedMemorySize, LDS_BYTES) != hipSuccess) { fprintf(stderr, "kernel_launch: hipFuncSetAttribute failed\n"); grid = -1; return; }
        if (hipOccupancyMaxActiveBlocksPerMultiprocessor(&per_cu, (const void*)fwd_kernel, NTHREADS, LDS_BYTES) != hipSuccess || per_cu < 1) fprintf(stderr, "kernel_launch: occupancy query reports %d\n", per_cu);
        (void)hipGetLastError();
        grid = cus;
        if (grid != 256) fprintf(stderr, "kernel_launch: %d CUs (built for 256)\n", grid);
    }
    if (grid < 0) return;
    (void)hipMemsetAsync((char*)d_ws + WS_CTL, 0, CTL_ZERO_BYTES, stream);
    Args a{};
    for (int i = 0; i < 35; ++i) a.in[i] = (const float*)d_in[i];
    a.out = (float*)d_out; a.ws = (unsigned char*)d_ws;
#if N_LAUNCH_MODE == 0
    a.ph_lo = 0; a.ph_hi = NPHASE;
    hipLaunchKernelGGL(fwd_kernel, dim3(grid), dim3(NTHREADS), LDS_BYTES, stream, a);
#else
    for (int p = 0; p < NPHASE; ++p) { a.ph_lo = p; a.ph_hi = p + 1; hipLaunchKernelGGL(fwd_kernel, dim3(grid), dim3(NTHREADS), LDS_BYTES, stream, a); }
#endif
}
```
